# Optimizing an MI355X kernel written in HIP

```python
import jax, jax.numpy as jnp
from jax import lax
import numpy as np

D_MODEL = 1024
BATCH = 16
SEQ = 2048
DEPTH = 1

HEAD_DIM = 64
RWKV_HEADS = 16
RWKV_W = RWKV_HEADS * HEAD_DIM
ATT_HEADS = 16
ATT_W = ATT_HEADS * HEAD_DIM
MIX_W = RWKV_W + ATT_W
DECAY_RANK = 64
ICLR_RANK = 64
SHIFT_COLS = 3 * RWKV_W + DECAY_RANK + ICLR_RANK
RWKV_GATE0 = SHIFT_COLS
ATT0 = RWKV_GATE0 + RWKV_W
ATT_GATE0 = ATT0 + 3 * ATT_W
N_IN = ATT_GATE0 + ATT_W
DILATED_PATTERNS = ((128, 1), (512, 4), (2048, 16))
BLK = 128
RMS_EPS = 1e-5
GN_EPS = 64e-5

kernel_name = 'hybrid_rwkv7_dilated_attn'


def rms_norm(x, w):
    xf = x.astype(jnp.float32)
    y = xf * lax.rsqrt(jnp.mean(xf * xf, axis=-1, keepdims=True) + RMS_EPS)
    return y * w.astype(jnp.float32)


def rwkv7_time_mix(p_shift, gate, w0, w_up, a0, a_up, k_k, k_a, r_k, ln_x_w, ln_x_b):
    B, S, _ = p_shift.shape
    r, k, v, w_lo, a_lo = jnp.split(
        p_shift, [RWKV_W, 2 * RWKV_W, 3 * RWKV_W, 3 * RWKV_W + DECAY_RANK], axis=-1)
    w = -jax.nn.softplus(-(w0 + jnp.tanh(w_lo) @ w_up)) - 0.5
    decay = jnp.exp(-jnp.exp(w))
    a = jax.nn.sigmoid(a0 + a_lo @ a_up)
    heads = lambda t: t.reshape(B, S, RWKV_HEADS, HEAD_DIM)
    kk = heads(k * k_k)
    kk = kk / jnp.maximum(jnp.linalg.norm(kk, axis=-1, keepdims=True), 1e-12)
    k = k * (1.0 + (a - 1.0) * k_a)
    r_h, k_h, v_h, w_h, a_h = heads(r), heads(k), heads(v), heads(decay), heads(a)

    def step(state, inp):
        r_t, w_t, k_t, v_t, av_t, bv_t = inp
        sa = jnp.einsum('bhvk,bhk->bhv', state, av_t)
        state = (state * w_t[:, :, None, :] + sa[..., None] * bv_t[:, :, None, :]
                 + v_t[..., None] * k_t[:, :, None, :])
        return state, jnp.einsum('bhvk,bhk->bhv', state, r_t)

    xs = tuple(t.astype(jnp.float32).transpose(1, 0, 2, 3)
               for t in (r_h, w_h, k_h, v_h, -kk, kk * a_h))
    s0 = jnp.zeros((B, RWKV_HEADS, HEAD_DIM, HEAD_DIM), jnp.float32)
    _, y = lax.scan(step, s0, xs)
    y = y.transpose(1, 0, 2, 3)
    mu = jnp.mean(y, axis=-1, keepdims=True)
    var = jnp.mean(jnp.square(y - mu), axis=-1, keepdims=True)
    y = ((y - mu) * lax.rsqrt(var + GN_EPS)).reshape(B, S, RWKV_W) * ln_x_w + ln_x_b
    bonus = jnp.sum(r_h * k_h * r_k, axis=-1, keepdims=True) * v_h
    return (y + bonus.reshape(B, S, RWKV_W)) * jax.nn.silu(gate)


def dilated_window_attention(q, k, v, window, dilation):
    B, S, H, E = q.shape
    L = S // dilation
    steps = window // dilation
    nb = -(-L // BLK)
    Lp = nb * BLK

    def to_sub(t):
        t = t.reshape(B, L, dilation, H, E).transpose(0, 2, 3, 1, 4)
        t = jnp.pad(t, ((0, 0), (0, 0), (0, 0), (0, Lp - L), (0, 0)))
        return t.reshape(B, dilation, H, nb, BLK, E)

    def band(t):
        prev = jnp.pad(t, ((0, 0), (0, 0), (0, 0), (1, 0), (0, 0), (0, 0)))[:, :, :, :-1]
        return jnp.concatenate([prev, t], axis=4)

    qb = to_sub(q)
    kc, vc = band(to_sub(k)), band(to_sub(v))
    s = jnp.einsum('bdhnqe,bdhnke->bdhnqk', qb, kc) * (E ** -0.5)
    qi = jnp.arange(nb)[:, None, None] * BLK + jnp.arange(BLK)[None, :, None]
    ki = (jnp.arange(nb)[:, None, None] - 1) * BLK + jnp.arange(2 * BLK)[None, None, :]
    dist = qi - ki
    valid = (dist >= 0) & (dist <= steps) & (ki >= 0)
    s = jnp.where(valid, s, -jnp.inf)
    m = jnp.max(s, axis=-1, keepdims=True)
    pexp = jnp.exp(s - m)
    l = jnp.sum(pexp, axis=-1, keepdims=True)
    o = jnp.einsum('bdhnqk,bdhnke->bdhnqe', pexp, vc) / l
    lse = (m + jnp.log(l))[..., 0]
    o = o.reshape(B, dilation, H, Lp, E)[:, :, :, :L].transpose(0, 3, 1, 2, 4).reshape(B, S, H, E)
    lse = lse.reshape(B, dilation, H, Lp)[..., :L].transpose(0, 3, 1, 2).reshape(B, S, H)
    return o, lse


def mixed_dilated_attention(p_att, gate):
    B, S, _ = p_att.shape
    q, k, v = (t.reshape(B, S, ATT_HEADS, HEAD_DIM) for t in jnp.split(p_att, 3, axis=-1))
    outs, lses = [], []
    for window, dilation in DILATED_PATTERNS:
        o, lse = dilated_window_attention(q, k, v, window, dilation)
        outs.append(o)
        lses.append(lse)
    wts = jax.nn.softmax(jnp.stack(lses, axis=0), axis=0)
    o = jnp.sum(wts[..., None] * jnp.stack(outs, axis=0), axis=0)
    return o.reshape(B, S, ATT_W) * jax.nn.silu(gate)


def setup_inputs(seed: int = 0) -> dict:
    key = jax.random.key(seed)
    ks = jax.random.split(key, 15)
    nrm = lambda k, shape: jax.random.normal(k, shape, jnp.float32)
    return {
        'x': nrm(ks[0], (BATCH, SEQ, D_MODEL)),
        'norm_w': 1.0 + 0.02 * nrm(ks[1], (D_MODEL,)),
        'w_in': nrm(ks[2], (D_MODEL, N_IN)) * D_MODEL ** -0.5,
        'mu_shift': jax.random.uniform(ks[3], (SHIFT_COLS,), jnp.float32),
        'w0': jax.random.uniform(ks[4], (RWKV_W,), jnp.float32, minval=-6.0, maxval=-1.0),
        'w_up': 0.1 * nrm(ks[5], (DECAY_RANK, RWKV_W)),
        'a0': 0.1 * nrm(ks[6], (RWKV_W,)),
        'a_up': 0.1 * nrm(ks[7], (ICLR_RANK, RWKV_W)),
        'k_k': 0.85 + 0.02 * nrm(ks[8], (RWKV_W,)),
        'k_a': 1.0 + 0.02 * nrm(ks[9], (RWKV_W,)),
        'r_k': 0.1 * nrm(ks[10], (RWKV_HEADS, HEAD_DIM)),
        'ln_x_w': 1.0 + 0.02 * nrm(ks[11], (RWKV_W,)),
        'ln_x_b': 0.02 * nrm(ks[12], (RWKV_W,)),
        'w_out': nrm(ks[13], (MIX_W, D_MODEL)) * MIX_W ** -0.5,
        'final_norm_w': 1.0 + 0.02 * nrm(ks[14], (D_MODEL,)),
    }


def reference(x, norm_w, w_in, mu_shift, w0, w_up, a0, a_up, k_k, k_a, r_k,
              ln_x_w, ln_x_b, w_out, final_norm_w):
    h = x.astype(jnp.float32)
    for _ in range(DEPTH):
        xn = rms_norm(h, norm_w)
        p = jnp.einsum('bsd,dn->bsn', xn, w_in.astype(jnp.float32))
        p_tm = p[..., :SHIFT_COLS]
        prev = jnp.pad(p_tm, ((0, 0), (1, 0), (0, 0)))[:, :-1]
        p_tm = p_tm + (prev - p_tm) * mu_shift
        y_rwkv = rwkv7_time_mix(p_tm, p[..., RWKV_GATE0:ATT0], w0, w_up, a0, a_up,
                                k_k, k_a, r_k, ln_x_w, ln_x_b)
        y_att = mixed_dilated_attention(p[..., ATT0:ATT_GATE0], p[..., ATT_GATE0:])
        mix = jnp.concatenate([y_rwkv, y_att], axis=-1)
        h = h + jnp.einsum('bsm,md->bsd', mix, w_out.astype(jnp.float32))
    return rms_norm(h, final_norm_w).astype(x.dtype)
```

```cpp
#include <hip/hip_runtime.h>
#include <hip/hip_cooperative_groups.h>
#include <cstdio>
#include <cstdint>
namespace cg = cooperative_groups;
#define MK_MULTI 1
#define MK_MASK 0x7f
namespace pg8 {
#define PG8_LAS __attribute__((address_space(3)))
typedef unsigned short bf16_t;
typedef short bf16x8 __attribute__((ext_vector_type(8)));
typedef float f32x4 __attribute__((ext_vector_type(4)));
typedef unsigned u32x4 __attribute__((ext_vector_type(4)));
constexpr int BM = 256, BK = 64, HALF = 128, HTB = HALF * BK * 2  , STAGE_BYTES = 8 * HTB, NXCD = 8, WGM = 8;

__host__ __device__ __forceinline__ int lds_byte(int r, int c) { const int st = (r >> 4) * 2 + (c >> 5), rr = r & 15, cc = c & 31, ob = rr * 64 + cc * 2; return st * 1024 + (ob ^ (((ob >> 9) & 1) << 5)); }
__host__ __device__ __forceinline__ void stage_rc(int b, int& R, int& C) { const int st = b / 1024, sb = b % 1024, swz = sb ^ (((sb >> 9) & 1) << 5); R = (st >> 1) * 16 + swz / 64; C = (st & 1) * 32 + (swz % 64) / 2; }
__host__ __device__ __forceinline__ int perm32(int rho) { const int n = rho >> 4, i = rho & 15; return 8 * (i >> 2) + 4 * n + (i & 3); }

struct Unit { int pm, pn; };
struct Gemm { const bf16_t* A; const bf16_t* Bt; int M, N, K; };

struct StaticOrder {
    int nM, nN, nwg, G, c;
    __host__ __device__ void init(int M, int N, int G_, int c_) { nM = M / BM; nN = N / BM; nwg = nM * nN; G = G_; c = c_; }
    __host__ __device__ bool next(int i, Unit& u) const {
        const long L = (long)i * G + c; if (L >= nwg) return false;
        int wgid = (int)L; { const int q = nwg / NXCD, r = nwg % NXCD, xcd = wgid % NXCD, off = wgid / NXCD; wgid = (xcd < r ? xcd * (q + 1) : r * (q + 1) + (xcd - r) * q) + off; }
        const int nig = WGM * nN, gid = wgid / nig, fm = gid * WGM, gsz = (nM - fm) < WGM ? (nM - fm) : WGM;
        u.pm = fm + ((wgid % nig) % gsz); u.pn = (wgid % nig) / gsz; return true;
    }
    __device__ __forceinline__ void a_ready(const Unit&) const {}
    __device__ __forceinline__ void done(const Unit&) const {}
};

__device__ __forceinline__ unsigned cvt_pk_bf16(float lo, float hi) { unsigned r; asm volatile("v_cvt_pk_bf16_f32 %0, %1, %2" : "=v"(r) : "v"(lo), "v"(hi)); return r; }
typedef float f32x2 __attribute__((ext_vector_type(2)));
__device__ __forceinline__ f32x2 gelu_pk(f32x2 v) {
    const f32x2 av = __builtin_elementwise_abs(v), d = av * 0.2316418882f + 1.0f;
    f32x2 t; t.x = __builtin_amdgcn_rcpf(d.x); t.y = __builtin_amdgcn_rcpf(d.y);
    f32x2 q = t * 0.5307027145f + (-0.7265760135f); q = q * t + 0.7107068705f; q = q * t + (-0.142248368f); q = q * t + 0.127414796f; q = q * t;
    const f32x2 s = (v * v) * (-0.72134752044f);
    f32x2 e; e.x = __builtin_amdgcn_exp2f(s.x); e.y = __builtin_amdgcn_exp2f(s.y);
    const f32x2 m = v * (q * e), r = v - m;
    f32x2 o; o.x = v.x < 0.f ? m.x : r.x; o.y = v.y < 0.f ? m.y : r.y; return o;
}

template <int ACT  > struct EpiBf16 {
    static constexpr bool PERM = true, AFTER_DRAIN = false; static_assert(ACT == 0 || ACT == 1, "EpiBf16: ACT is 0 (none) or 1 (gelu_pk)");
    bf16_t* O; int ldc; const float* bias; int split_cols; size_t split_stride; float scale0;
    __device__ __forceinline__ void operator()(const f32x4 (&acc)[2][2][4][2], const Unit& u, int wr, int wc, int fr, int fq) const {
        const int row0 = u.pm * BM + wr * 64 + fr; int colt = u.pn * BM; bf16_t* base = O;
        float sc = 1.f; if (split_cols) { const int t = colt / split_cols; base += (size_t)t * split_stride; colt -= t * split_cols; if (t == 0) sc = scale0; }
        const int col0 = colt + wc * 32 + 8 * fq, bcol0 = u.pn * BM + wc * 32 + 8 * fq;
        f32x4 bv[2][2];
#pragma unroll
        for (int bj = 0; bj < 2; ++bj)
#pragma unroll
            for (int n = 0; n < 2; ++n) bv[bj][n] = bias ? *(const f32x4*)(bias + bcol0 + bj * HALF + 4 * n) : (f32x4){0.f, 0.f, 0.f, 0.f};
#pragma unroll
        for (int ai = 0; ai < 2; ++ai)
#pragma unroll
            for (int m = 0; m < 4; ++m) { bf16_t* rowp = base + (size_t)(row0 + ai * HALF + m * 16) * ldc + col0;
#pragma unroll
                for (int bj = 0; bj < 2; ++bj) { f32x4 v0 = acc[ai][bj][m][0] + bv[bj][0], v1 = acc[ai][bj][m][1] + bv[bj][1];
                    if (ACT == 1) { f32x2 a = gelu_pk((f32x2){v0[0], v0[1]}), b = gelu_pk((f32x2){v0[2], v0[3]}), c = gelu_pk((f32x2){v1[0], v1[1]}), d = gelu_pk((f32x2){v1[2], v1[3]});
                        v0 = (f32x4){a.x, a.y, b.x, b.y}; v1 = (f32x4){c.x, c.y, d.x, d.y}; }
                    v0 = v0 * sc; v1 = v1 * sc; u32x4 w; w.x = cvt_pk_bf16(v0[0], v0[1]); w.y = cvt_pk_bf16(v0[2], v0[3]); w.z = cvt_pk_bf16(v1[0], v1[1]); w.w = cvt_pk_bf16(v1[2], v1[3]);
                    *(u32x4*)(rowp + bj * HALF) = w; } }
    }
};
struct EpiResF32 {
    static constexpr bool PERM = false, AFTER_DRAIN = false;
    const float* base; float* out; float* part; int ldc;
    __device__ __forceinline__ void operator()(const f32x4 (&acc)[2][2][4][2], const Unit& u, int wr, int wc, int fr, int fq) const {
        const int col0 = u.pn * BM + wc * 32 + 4 * fq;
#pragma unroll
        for (int ai = 0; ai < 2; ++ai)
#pragma unroll
            for (int m = 0; m < 4; ++m) {
                const int row = u.pm * BM + ai * HALF + wr * 64 + m * 16 + fr;
                const size_t off = (size_t)row * ldc + col0;
                float ss = 0.f;
#pragma unroll
                for (int bj = 0; bj < 2; ++bj)
#pragma unroll
                    for (int n = 0; n < 2; ++n) {
                        const f32x4 b = *(const f32x4*)(base + off + bj * HALF + n * 16);
                        const f32x4 h = b + acc[ai][bj][m][n];
                        *(f32x4*)(out + off + bj * HALF + n * 16) = h;
                        ss += (h[0] * h[0] + h[1] * h[1]) + (h[2] * h[2] + h[3] * h[3]);
                    }
                ss += __shfl_xor(ss, 16); ss += __shfl_xor(ss, 32);
                if (fq == 0) part[(size_t)row * 16 + u.pn * 4 + wc] = ss;
            }
    }
};
template <class Epi, class Sched, bool ALIGN_EPI = false, bool SP2 = false>
__device__ __forceinline__ void gemm_phase(PG8_LAS unsigned char* lds, const Gemm g, const Sched& S, const Epi& E) {
    const int tid = threadIdx.x, wid = __builtin_amdgcn_readfirstlane(tid >> 6), lane = tid & 63, wr = wid >> 2, wc = wid & 3, fr = lane & 15, fq = lane >> 4;
    const int K = g.K, nt = K / BK;
    unsigned voffA[2], voffB[2];
#pragma unroll
    for (int i = 0; i < 2; ++i) { int R, C; stage_rc(tid * 16 + i * 8192, R, C); const int Rb = Epi::PERM ? ((R & ~31) + perm32(R & 31)) : R;
        voffA[i] = (unsigned)(R * K + C) * 2u; voffB[i] = (unsigned)(Rb * K + C) * 2u; }
    const size_t kstep = (size_t)(BK * 2);
    const size_t hstep = (size_t)HALF * K * 2;
    const size_t tstep = 2 * hstep;
    const unsigned ldsw = (unsigned)wid * 1024u;
    const int aoff = lds_byte(wr * 64 + fr, fq * 8), boff = lds_byte(wc * 32 + fr, fq * 8);
#define PG8_SA(b, h) (((b) * 2 + (h)) * HTB)
#define PG8_SB(b, h) ((4 + (b) * 2 + (h)) * HTB)
#define PG8_STAGE(bufoff, gbase, voff) do { _Pragma("unroll") for (int _i = 0; _i < 2; ++_i) \
        __builtin_amdgcn_global_load_lds((const unsigned*)((const char*)(gbase) + (voff)[_i]), (PG8_LAS unsigned*)(lds + (bufoff) + ldsw + _i * 8192), 16, 0, 0); } while (0)
#define PG8_LDA(dst, b, h) do { _Pragma("unroll") for (int m = 0; m < 4; ++m) _Pragma("unroll") for (int k = 0; k < 2; ++k) dst[m][k] = *(const PG8_LAS bf16x8*)(lds + PG8_SA(b, h) + aoff + m * 2048 + k * 1024); } while (0)
#define PG8_LDB(dst, b, h) do { _Pragma("unroll") for (int n = 0; n < 2; ++n) _Pragma("unroll") for (int k = 0; k < 2; ++k) dst[n][k] = *(const PG8_LAS bf16x8*)(lds + PG8_SB(b, h) + boff + n * 2048 + k * 1024); } while (0)
#define PG8_MMA(ai, bj, At, Bt) do { __builtin_amdgcn_s_setprio(1); _Pragma("unroll") for (int m = 0; m < 4; ++m) _Pragma("unroll") for (int n = 0; n < 2; ++n) _Pragma("unroll") for (int k = 0; k < 2; ++k) \
        acc[ai][bj][m][n] = __builtin_amdgcn_mfma_f32_16x16x32_bf16(Bt[n][k], At[m][k], acc[ai][bj][m][n], 0, 0, 0); __builtin_amdgcn_s_setprio(0); } while (0)
#define PG8_WAIT_V(n) asm volatile("s_waitcnt vmcnt(" #n ")" ::: "memory")
#define PG8_WAIT_L(n) asm volatile("s_waitcnt lgkmcnt(" #n ")" ::: "memory")
#define PG8_BAR __builtin_amdgcn_s_barrier()
#define PG8_SCHED __builtin_amdgcn_sched_barrier(0)
    Unit cur, nxt; int ui = 0;
    if (!S.next(0, cur)) return;
    f32x4 acc[2][2][4][2];
#pragma unroll
    for (int a = 0; a < 2; ++a)
#pragma unroll
        for (int b = 0; b < 2; ++b)
#pragma unroll
            for (int m = 0; m < 4; ++m)
#pragma unroll
                for (int n = 0; n < 2; ++n) acc[a][b][m][n] = (f32x4){0.f, 0.f, 0.f, 0.f};
    bf16x8 At[4][2], B0[2][2], B1[2][2];
    const char* cA = (const char*)g.A + (size_t)cur.pm * tstep; const char* cB = (const char*)g.Bt + (size_t)cur.pn * tstep;
    S.a_ready(cur);
    if constexpr (SP2) {
        PG8_STAGE(PG8_SB(0, 0), cB, voffB); PG8_STAGE(PG8_SB(0, 1), cB + hstep, voffB); PG8_STAGE(PG8_SA(0, 0), cA, voffA); PG8_STAGE(PG8_SA(0, 1), cA + hstep, voffA);
        if (wr == 1) PG8_BAR;
        PG8_WAIT_V(2); PG8_BAR;
        PG8_STAGE(PG8_SB(1, 0), cB + kstep, voffB); PG8_STAGE(PG8_SA(1, 0), cA + kstep, voffA); PG8_STAGE(PG8_SB(1, 1), cB + hstep + kstep, voffB);
        PG8_WAIT_V(6); PG8_BAR;
    } else {
        PG8_STAGE(PG8_SB(0, 0), cB, voffB); PG8_STAGE(PG8_SA(0, 0), cA, voffA); PG8_STAGE(PG8_SB(0, 1), cB + hstep, voffB); PG8_STAGE(PG8_SA(0, 1), cA + hstep, voffA);
        if (wr == 1) PG8_BAR;
        PG8_WAIT_V(4); PG8_BAR;
        PG8_STAGE(PG8_SB(1, 0), cB + kstep, voffB); PG8_STAGE(PG8_SA(1, 0), cA + kstep, voffA); PG8_STAGE(PG8_SB(1, 1), cB + hstep + kstep, voffB);
        PG8_WAIT_V(6); PG8_BAR;
    }
    for (;;) {
        const bool has_next = S.next(ui + 1, nxt);
        const char* nA = has_next ? (const char*)g.A + (size_t)nxt.pm * tstep : cA; const char* nB = has_next ? (const char*)g.Bt + (size_t)nxt.pn * tstep : cB;
        for (int t = 0; t < nt; t += 2) {
            const bool last = (t == nt - 2);
            const char* a1 = cA + (size_t)(t + 1) * kstep;
            const char* a2 = last ? nA : cA + (size_t)(t + 2) * kstep; const char* b2 = last ? nB : cB + (size_t)(t + 2) * kstep;
            const char* a3 = a2 + kstep; const char* b3 = b2 + kstep;
            if (last && has_next) S.a_ready(nxt);
            if constexpr (SP2) {
            PG8_LDB(B0, 0, 0); PG8_LDB(B1, 0, 1); PG8_SCHED; PG8_LDA(At, 0, 0); PG8_STAGE(PG8_SA(1, 1), a1 + hstep, voffA);
            PG8_WAIT_V(8); PG8_WAIT_L(0); PG8_BAR; PG8_MMA(0, 0, At, B0); PG8_MMA(0, 1, At, B1); PG8_BAR; PG8_SCHED;
            PG8_LDA(At, 0, 1); PG8_STAGE(PG8_SB(0, 0), b2, voffB); PG8_STAGE(PG8_SB(0, 1), b2 + hstep, voffB); PG8_STAGE(PG8_SA(0, 0), a2, voffA);
            PG8_WAIT_V(8); PG8_WAIT_L(0); PG8_BAR; PG8_MMA(1, 0, At, B0); PG8_MMA(1, 1, At, B1); PG8_BAR; PG8_SCHED;
            PG8_LDB(B0, 1, 0); PG8_LDB(B1, 1, 1); PG8_SCHED; PG8_LDA(At, 1, 0); PG8_STAGE(PG8_SA(0, 1), a2 + hstep, voffA);
            PG8_WAIT_V(8); PG8_WAIT_L(0); PG8_BAR; PG8_MMA(0, 0, At, B0); PG8_MMA(0, 1, At, B1); PG8_BAR; PG8_SCHED;
            PG8_LDA(At, 1, 1); PG8_STAGE(PG8_SB(1, 0), b3, voffB); PG8_STAGE(PG8_SB(1, 1), b3 + hstep, voffB); PG8_STAGE(PG8_SA(1, 0), a3, voffA);
            PG8_WAIT_V(8); PG8_WAIT_L(0); PG8_BAR; PG8_MMA(1, 0, At, B0); PG8_MMA(1, 1, At, B1); PG8_BAR; PG8_SCHED;
            } else {
            PG8_LDB(B0, 0, 0); PG8_SCHED; PG8_LDA(At, 0, 0); PG8_STAGE(PG8_SA(1, 1), a1 + hstep, voffA);
            PG8_WAIT_L(8); PG8_BAR; PG8_WAIT_L(0); PG8_MMA(0, 0, At, B0); PG8_BAR; PG8_SCHED;
            PG8_LDB(B1, 0, 1); PG8_STAGE(PG8_SB(0, 0), b2, voffB);
            PG8_BAR; PG8_WAIT_L(0); PG8_MMA(0, 1, At, B1); PG8_BAR;
            PG8_LDA(At, 0, 1); PG8_STAGE(PG8_SA(0, 0), a2, voffA);
            PG8_BAR; PG8_WAIT_L(0); PG8_MMA(1, 0, At, B0); PG8_BAR; PG8_SCHED;
            PG8_STAGE(PG8_SB(0, 1), b2 + hstep, voffB);
            PG8_WAIT_V(6); PG8_BAR; PG8_MMA(1, 1, At, B1); PG8_BAR;
            PG8_LDB(B0, 1, 0); PG8_SCHED; PG8_LDA(At, 1, 0); PG8_STAGE(PG8_SA(0, 1), a2 + hstep, voffA);
            PG8_WAIT_L(8); PG8_BAR; PG8_WAIT_L(0); PG8_MMA(0, 0, At, B0); PG8_BAR; PG8_SCHED;
            PG8_LDB(B1, 1, 1); PG8_STAGE(PG8_SB(1, 0), b3, voffB);
            PG8_BAR; PG8_WAIT_L(0); PG8_MMA(0, 1, At, B1); PG8_BAR;
            PG8_LDA(At, 1, 1); PG8_STAGE(PG8_SA(1, 0), a3, voffA);
            PG8_BAR; PG8_WAIT_L(0); PG8_MMA(1, 0, At, B0); PG8_BAR; PG8_SCHED;
            PG8_STAGE(PG8_SB(1, 1), b3 + hstep, voffB);
            PG8_WAIT_V(6); PG8_BAR; PG8_MMA(1, 1, At, B1); PG8_BAR;
            }
        }
        if constexpr (ALIGN_EPI) { if (wr == 0) PG8_BAR; }
        if constexpr (!Epi::AFTER_DRAIN) { E(acc, cur, wr, wc, fr, fq); S.done(cur); }
        if (!has_next) break;
#pragma unroll
        for (int a = 0; a < 2; ++a)
#pragma unroll
            for (int b = 0; b < 2; ++b)
#pragma unroll
                for (int m = 0; m < 4; ++m)
#pragma unroll
                    for (int n = 0; n < 2; ++n) acc[a][b][m][n] = (f32x4){0.f, 0.f, 0.f, 0.f};
        cur = nxt; cA = nA; cB = nB; ++ui;
        if constexpr (ALIGN_EPI) { if (wr == 1) PG8_BAR; }
    }
    PG8_WAIT_V(0);
    if constexpr (!ALIGN_EPI) { if (wr == 0) PG8_BAR; }
    PG8_BAR;
    if constexpr (Epi::AFTER_DRAIN) { E.fused(acc, cur, wr, wc, fr, fq, lds, wid, lane); S.done(cur); }
#undef PG8_SA
#undef PG8_SB
#undef PG8_STAGE
#undef PG8_LDA
#undef PG8_LDB
#undef PG8_MMA
#undef PG8_WAIT_V
#undef PG8_WAIT_L
#undef PG8_BAR
#undef PG8_SCHED
}
}

#define LAS __attribute__((address_space(3)))
typedef unsigned short bf16;
typedef unsigned u32x4 __attribute__((ext_vector_type(4)));
typedef unsigned u32x2 __attribute__((ext_vector_type(2)));
typedef float f32x4 __attribute__((ext_vector_type(4)));
typedef short bf16x8 __attribute__((ext_vector_type(8)));
constexpr int DM = 1024, NBATCH = 16, SEQ = 2048, MTOK = NBATCH * SEQ, NH = 16;
constexpr int N_IN = 8320, RW_COLS = 4224, PA = 4352, PB = 4096, MIXW = 2048;
constexpr float RMS_EPS = 1e-5f, GN_EPS = 64e-5f;
constexpr size_t MiB = 1u << 20;
constexpr size_t WS_PART = 1 * MiB, WS_WTIN = 3 * MiB, WS_WTOUT = 20 * MiB, WS_WUPT = 24 * MiB, WS_AUPT = 24 * MiB + 256 * 1024, WS_LSE = 25 * MiB,
                 WS_MIX = 32 * MiB, WS_P = 160 * MiB, WS_XB = 432 * MiB, WS_END = 496 * MiB;
constexpr int LDS_BYTES = 147456;
constexpr int NWAVES = 8, NTHR = 512;

struct Ptrs {
    const float *x, *norm_w, *w_in, *mu, *w0, *w_up, *a0, *a_up, *k_k, *k_a, *r_k, *ln_w, *ln_b, *w_out, *fin_w;
    float* out; float* part; float* lse;
    bf16 *wtin, *wtout, *wupT, *aupT, *mix, *P, *xb, *o1, *o2, *o3;
};

__device__ __forceinline__ unsigned f2bf(float f) { unsigned u = __builtin_bit_cast(unsigned, f); return (u + 0x7fffu + ((u >> 16) & 1u)) >> 16; }
__device__ __forceinline__ unsigned pk2(float lo, float hi) { return f2bf(lo) | (f2bf(hi) << 16); }
__device__ __forceinline__ float bflo(unsigned w) { return __builtin_bit_cast(float, w << 16); }
__device__ __forceinline__ float bfhi(unsigned w) { return __builtin_bit_cast(float, w & 0xffff0000u); }
__device__ __forceinline__ float wave_sum(float v) {
#pragma unroll
    for (int o = 1; o < 64; o <<= 1) v += __shfl_xor(v, o);
    return v;
}
__device__ __forceinline__ float silu(float g) { return g / (1.f + __expf(-g)); }

__device__ __forceinline__ void p0_transpose_item(const float* W, int K, int N, bf16* WT, int split, LAS float* scr, int item, int lane) {
    const int nblk = N / 32, kb = item / nblk, nb = item % nblk, k0 = 64 * kb, n0 = 32 * nb;
    const int row_off = (n0 >= split) ? 128 : 0;
#pragma unroll 8
    for (int i = 0; i < 32; ++i) { const int kk = 2 * i + (lane >> 5); scr[kk * 33 + (lane & 31)] = W[(size_t)(k0 + kk) * N + n0 + (lane & 31)]; }
    asm volatile("s_waitcnt lgkmcnt(0)" ::: "memory");
    const int c = lane & 7;
#pragma unroll
    for (int j = 0; j < 4; ++j) { const int n = (lane >> 3) + 8 * j; const LAS float* s = scr + (8 * c) * 33 + n;
        u32x4 o; o.x = pk2(s[0 * 33], s[1 * 33]); o.y = pk2(s[2 * 33], s[3 * 33]); o.z = pk2(s[4 * 33], s[5 * 33]); o.w = pk2(s[6 * 33], s[7 * 33]);
        *(u32x4*)(WT + (size_t)(row_off + n0 + n) * K + k0 + 8 * c) = o; }
    asm volatile("s_waitcnt lgkmcnt(0)" ::: "memory");
}
__device__ __forceinline__ void p0_prologue(LAS unsigned char* lds, const Ptrs& P, int tid, bool zero_mix) {
    const int wave = __builtin_amdgcn_readfirstlane(tid >> 6), lane = tid & 63;
    LAS float* scr = (LAS float*)(lds + wave * 16384);
    const int gw = blockIdx.x * NWAVES + wave, NGW = gridDim.x * NWAVES;
    constexpr int I_IN = (DM / 64) * (N_IN / 32), I_OUT = (MIXW / 64) * (DM / 32), I_UP = DM / 32;
    constexpr int NITEMS = I_IN + I_OUT + 2 * I_UP;
    for (int it = gw; it < NITEMS; it += NGW) {
        int r = it;
        if (r < I_IN) { p0_transpose_item(P.w_in, DM, N_IN, P.wtin, RW_COLS, scr, r, lane); continue; } r -= I_IN;
        if (r < I_OUT) { p0_transpose_item(P.w_out, MIXW, DM, P.wtout, 1 << 30, scr, r, lane); continue; } r -= I_OUT;
        if (r < I_UP) { p0_transpose_item(P.w_up, 64, DM, P.wupT, 1 << 30, scr, r, lane); continue; } r -= I_UP;
        p0_transpose_item(P.a_up, 64, DM, P.aupT, 1 << 30, scr, r, lane);
    }
    { const int gt = blockIdx.x * NTHR + tid, NGT = gridDim.x * NTHR; u32x4* z = (u32x4*)(P.wtin + (size_t)RW_COLS * DM);
      for (int i = gt; i < 128 * DM * 2 / 16; i += NGT) z[i] = (u32x4){0u, 0u, 0u, 0u};
      if (zero_mix) { u32x4* zm = (u32x4*)P.mix; for (size_t i = gt; i < (size_t)MTOK * MIXW * 2 / 16; i += NGT) zm[i] = (u32x4){0u, 0u, 0u, 0u}; } }
    for (int m = gw; m < MTOK; m += NGW) {
        const f32x4* xr = (const f32x4*)(P.x + (size_t)m * DM) + lane; const f32x4* wr = (const f32x4*)P.norm_w + lane;
        f32x4 v[4]; float s = 0.f;
#pragma unroll
        for (int j = 0; j < 4; ++j) { v[j] = xr[64 * j]; s += (v[j].x * v[j].x + v[j].y * v[j].y) + (v[j].z * v[j].z + v[j].w * v[j].w); }
        const float rstd = 1.f / sqrtf(wave_sum(s) * (1.f / DM) + RMS_EPS);
        unsigned long long* o8 = (unsigned long long*)(P.xb + (size_t)m * DM) + lane;
#pragma unroll
        for (int j = 0; j < 4; ++j) { const f32x4 w = wr[64 * j];
            o8[64 * j] = (unsigned long long)pk2(v[j].x * rstd * w.x, v[j].y * rstd * w.y) | ((unsigned long long)pk2(v[j].z * rstd * w.z, v[j].w * rstd * w.w) << 32); }
    }
}

namespace rw {
constexpr int T = 64;
constexpr int A_DEC = 0, A_BV = 16384, A_K = 32768, A_R = 49152, A_AV = 65536, A_V = 81920, A_Y = 98304, A_WL = 114688, WLS = 144, A_AL = A_WL + T * WLS, A_BON = A_AL + T * WLS;
static_assert(A_BON + T * 4 <= LDS_BYTES, "rwkv LDS");
template <int CTRL> __device__ __forceinline__ float dpp_add(float x) {
    const int y = __builtin_amdgcn_update_dpp(0, __builtin_bit_cast(int, x), CTRL, 0xf, 0xf, false);
    return x + __builtin_bit_cast(float, y);
}
__device__ __forceinline__ float allreduce16(float x) {
    x = dpp_add<0xB1>(x);
    x = dpp_add<0x4E>(x);
    x = dpp_add<0x141>(x);
    x = dpp_add<0x140>(x);
    return x;
}
}

__device__ __forceinline__ void rwkv_phase(LAS unsigned char* lds, const Ptrs& P, int tid) {
    using namespace rw;
    const int wv = __builtin_amdgcn_readfirstlane(tid >> 6), lane = tid & 63, fr = lane & 15, fq = lane >> 4;
    const bf16* Pp = P.P;
    LAS float* aDEC = (LAS float*)(lds + A_DEC); LAS float* aBV = (LAS float*)(lds + A_BV); LAS float* aK = (LAS float*)(lds + A_K); LAS float* aR = (LAS float*)(lds + A_R);
    LAS float* aAV = (LAS float*)(lds + A_AV); LAS float* aV = (LAS float*)(lds + A_V); LAS float* aY = (LAS float*)(lds + A_Y); LAS float* aBON = (LAS float*)(lds + A_BON);
    for (int bh = blockIdx.x; bh < NBATCH * NH; bh += gridDim.x) {
        const int b = bh >> 4, h = bh & 15; const size_t rowb = (size_t)b * SEQ;
        const int nt = wv & 3, mt0 = (wv >> 2) * 2;
        bf16x8 bw[2], ba[2];
#pragma unroll
        for (int ks = 0; ks < 2; ++ks) { bw[ks] = *(const bf16x8*)(P.wupT + (size_t)(h * 64 + nt * 16 + fr) * 64 + ks * 32 + fq * 8);
                                         ba[ks] = *(const bf16x8*)(P.aupT + (size_t)(h * 64 + nt * 16 + fr) * 64 + ks * 32 + fq * 8); }
        const float w0c = P.w0[h * 64 + nt * 16 + fr], a0c = P.a0[h * 64 + nt * 16 + fr];
        float S[4][4];
#pragma unroll
        for (int i = 0; i < 4; ++i)
#pragma unroll
            for (int c = 0; c < 4; ++c) S[i][c] = 0.f;
        for (int ch = 0; ch < SEQ / T; ++ch) {
            const int t0 = ch * T;
            for (int it = tid; it < T * 40; it += NTHR) {
                const int tt = it / 40, rem = it - tt * 40, seg = rem >> 3, pc = rem & 7;
                const int col = (seg < 3) ? seg * 1024 + h * 64 + pc * 8 : 3072 + (seg - 3) * 64 + pc * 8;
                const int t = t0 + tt;
                const bf16* src = Pp + (rowb + t) * PA + col;
                const u32x4 cur = *(const u32x4*)src;
                u32x4 prv = (u32x4){0u, 0u, 0u, 0u};
                if (t > 0) prv = *(const u32x4*)(src - PA);
                const f32x4 mu0 = *(const f32x4*)(P.mu + col), mu1 = *(const f32x4*)(P.mu + col + 4);
                float v[8];
#pragma unroll
                for (int i = 0; i < 4; ++i) { const float cl = bflo(cur[i]), chh = bfhi(cur[i]), pl = bflo(prv[i]), ph = bfhi(prv[i]);
                    const float m0 = (i < 2) ? mu0[2 * i] : mu1[2 * i - 4], m1 = (i < 2) ? mu0[2 * i + 1] : mu1[2 * i - 3];
                    v[2 * i] = cl + (pl - cl) * m0; v[2 * i + 1] = chh + (ph - chh) * m1; }
                if (seg < 3) {
                    LAS float* dst = ((seg == 0) ? aR : (seg == 1) ? aK : aV) + tt * 64 + pc * 8;
                    *(LAS f32x4*)dst = (f32x4){v[0], v[1], v[2], v[3]}; *(LAS f32x4*)(dst + 4) = (f32x4){v[4], v[5], v[6], v[7]};
                } else {
                    if (seg == 3) {
#pragma unroll
                        for (int i = 0; i < 8; ++i) v[i] = tanhf(v[i]);
                    }
                    u32x4 o; o.x = pk2(v[0], v[1]); o.y = pk2(v[2], v[3]); o.z = pk2(v[4], v[5]); o.w = pk2(v[6], v[7]);
                    *(LAS u32x4*)(lds + ((seg == 3) ? A_WL : A_AL) + tt * WLS + pc * 16) = o;
                }
            }
            __syncthreads();
            {
#pragma unroll
                for (int mi = 0; mi < 2; ++mi) {
                    const int mt = mt0 + mi;
                    f32x4 accw = (f32x4){0.f, 0.f, 0.f, 0.f}, acca = (f32x4){0.f, 0.f, 0.f, 0.f};
#pragma unroll
                    for (int ks = 0; ks < 2; ++ks) {
                        const bf16x8 aw = *(const LAS bf16x8*)(lds + A_WL + (mt * 16 + fr) * WLS + (ks * 32 + fq * 8) * 2);
                        const bf16x8 aa = *(const LAS bf16x8*)(lds + A_AL + (mt * 16 + fr) * WLS + (ks * 32 + fq * 8) * 2);
                        accw = __builtin_amdgcn_mfma_f32_16x16x32_bf16(aw, bw[ks], accw, 0, 0, 0);
                        acca = __builtin_amdgcn_mfma_f32_16x16x32_bf16(aa, ba[ks], acca, 0, 0, 0);
                    }
#pragma unroll
                    for (int j = 0; j < 4; ++j) {
                        const int tt = mt * 16 + fq * 4 + j, c = nt * 16 + fr;
                        const float z = -(w0c + accw[j]);
                        const float sp = fmaxf(z, 0.f) + log1pf(expf(-fabsf(z)));
                        const float dec = expf(-expf(-sp - 0.5f));
                        const float a = 1.f / (1.f + expf(-(a0c + acca[j])));
                        aDEC[tt * 64 + c] = dec; aBV[tt * 64 + c] = a;
                    }
                }
            }
            __syncthreads();
            {
                const int tt = tid >> 3, c8 = (tid & 7) * 8, o = tt * 64 + c8;
                const f32x4 k0 = *(LAS f32x4*)(aK + o), k1 = *(LAS f32x4*)(aK + o + 4), a0v = *(LAS f32x4*)(aBV + o), a1v = *(LAS f32x4*)(aBV + o + 4);
                const f32x4 r0 = *(LAS f32x4*)(aR + o), r1 = *(LAS f32x4*)(aR + o + 4);
                const f32x4 kk0 = *(const f32x4*)(P.k_k + h * 64 + c8), kk1 = *(const f32x4*)(P.k_k + h * 64 + c8 + 4);
                const f32x4 ka0 = *(const f32x4*)(P.k_a + h * 64 + c8), ka1 = *(const f32x4*)(P.k_a + h * 64 + c8 + 4);
                const f32x4 rk0 = *(const f32x4*)(P.r_k + h * 64 + c8), rk1 = *(const f32x4*)(P.r_k + h * 64 + c8 + 4);
                f32x4 n0 = k0 * kk0, n1 = k1 * kk1;
                float ss = (n0.x * n0.x + n0.y * n0.y) + (n0.z * n0.z + n0.w * n0.w) + (n1.x * n1.x + n1.y * n1.y) + (n1.z * n1.z + n1.w * n1.w);
                ss += __shfl_xor(ss, 1); ss += __shfl_xor(ss, 2); ss += __shfl_xor(ss, 4);
                const float inv = 1.f / fmaxf(sqrtf(ss), 1e-12f);
                n0 = n0 * inv; n1 = n1 * inv;
                const f32x4 kp0 = k0 * (1.f + (a0v - 1.f) * ka0), kp1 = k1 * (1.f + (a1v - 1.f) * ka1);
                const f32x4 bq0 = r0 * kp0 * rk0, bq1 = r1 * kp1 * rk1;
                float bon = (bq0.x + bq0.y) + (bq0.z + bq0.w) + (bq1.x + bq1.y) + (bq1.z + bq1.w);
                bon += __shfl_xor(bon, 1); bon += __shfl_xor(bon, 2); bon += __shfl_xor(bon, 4);
                *(LAS f32x4*)(aK + o) = kp0; *(LAS f32x4*)(aK + o + 4) = kp1;
                *(LAS f32x4*)(aAV + o) = -n0; *(LAS f32x4*)(aAV + o + 4) = -n1;
                *(LAS f32x4*)(aBV + o) = n0 * a0v; *(LAS f32x4*)(aBV + o + 4) = n1 * a1v;
                if ((tid & 7) == 0) aBON[tt] = bon;
            }
            __syncthreads();
            if (wv < 4) {
                const int rg = lane >> 4, kg = lane & 15;
                const LAS float* pd = aDEC + kg * 4; const LAS float* pb = aBV + kg * 4; const LAS float* pk = aK + kg * 4;
                const LAS float* pr = aR + kg * 4; const LAS float* pa = aAV + kg * 4; const LAS float* pv = aV + wv * 16 + rg * 4;
                LAS float* py = aY + wv * 16 + rg * 4;
#pragma unroll 2
                for (int t = 0; t < T; ++t) {
                    const f32x4 dec = *(const LAS f32x4*)(pd + t * 64), bv = *(const LAS f32x4*)(pb + t * 64), kk = *(const LAS f32x4*)(pk + t * 64);
                    const f32x4 rr = *(const LAS f32x4*)(pr + t * 64), av = *(const LAS f32x4*)(pa + t * 64), vv = *(const LAS f32x4*)(pv + t * 64);
                    float sa[4];
#pragma unroll
                    for (int i = 0; i < 4; ++i) sa[i] = (S[i][0] * av[0] + S[i][1] * av[1]) + (S[i][2] * av[2] + S[i][3] * av[3]);
#pragma unroll
                    for (int i = 0; i < 4; ++i) sa[i] = allreduce16(sa[i]);
#pragma unroll
                    for (int i = 0; i < 4; ++i)
#pragma unroll
                        for (int c = 0; c < 4; ++c) S[i][c] = S[i][c] * dec[c] + sa[i] * bv[c] + vv[i] * kk[c];
                    float y[4];
#pragma unroll
                    for (int i = 0; i < 4; ++i) y[i] = (S[i][0] * rr[0] + S[i][1] * rr[1]) + (S[i][2] * rr[2] + S[i][3] * rr[3]);
#pragma unroll
                    for (int i = 0; i < 4; ++i) y[i] = allreduce16(y[i]);
                    if (kg == 0) *(LAS f32x4*)(py + t * 64) = (f32x4){y[0], y[1], y[2], y[3]};
                }
            }
            __syncthreads();
            {
                const int tt = tid >> 3, c8 = (tid & 7) * 8, o = tt * 64 + c8, t = t0 + tt;
                const f32x4 y0 = *(LAS f32x4*)(aY + o), y1 = *(LAS f32x4*)(aY + o + 4), v0 = *(LAS f32x4*)(aV + o), v1 = *(LAS f32x4*)(aV + o + 4);
                const float bon = aBON[tt];
                const u32x4 g = *(const u32x4*)(Pp + (rowb + t) * PA + 3200 + h * 64 + c8);
                const f32x4 lw0 = *(const f32x4*)(P.ln_w + h * 64 + c8), lw1 = *(const f32x4*)(P.ln_w + h * 64 + c8 + 4);
                const f32x4 lb0 = *(const f32x4*)(P.ln_b + h * 64 + c8), lb1 = *(const f32x4*)(P.ln_b + h * 64 + c8 + 4);
                float s = (y0.x + y0.y) + (y0.z + y0.w) + (y1.x + y1.y) + (y1.z + y1.w);
                s += __shfl_xor(s, 1); s += __shfl_xor(s, 2); s += __shfl_xor(s, 4);
                const float mean = s * (1.f / 64.f);
                const f32x4 d0 = y0 - mean, d1 = y1 - mean;
                float q = (d0.x * d0.x + d0.y * d0.y) + (d0.z * d0.z + d0.w * d0.w) + (d1.x * d1.x + d1.y * d1.y) + (d1.z * d1.z + d1.w * d1.w);
                q += __shfl_xor(q, 1); q += __shfl_xor(q, 2); q += __shfl_xor(q, 4);
                const float rstd = 1.f / sqrtf(q * (1.f / 64.f) + GN_EPS);
                const f32x4 e0 = d0 * rstd * lw0 + lb0 + bon * v0, e1 = d1 * rstd * lw1 + lb1 + bon * v1;
                u32x4 ov;
                ov.x = pk2(e0.x * silu(bflo(g.x)), e0.y * silu(bfhi(g.x))); ov.y = pk2(e0.z * silu(bflo(g.y)), e0.w * silu(bfhi(g.y)));
                ov.z = pk2(e1.x * silu(bflo(g.z)), e1.y * silu(bfhi(g.z))); ov.w = pk2(e1.z * silu(bflo(g.w)), e1.w * silu(bfhi(g.w)));
                *(u32x4*)(P.mix + (rowb + t) * MIXW + h * 64 + c8) = ov;
            }
            __syncthreads();
        }
    }
}

namespace att { constexpr int KST = 144, VST = 528, L_K = 0, L_V = 256 * KST; static_assert(L_V + 64 * VST <= LDS_BYTES, "att LDS"); }

__device__ __forceinline__ void attn_phase(LAS unsigned char* lds, const Ptrs& P, int tid) {
    using namespace att;
    const int wv = __builtin_amdgcn_readfirstlane(tid >> 6), lane = tid & 63, fr = lane & 15, fq = lane >> 4;
    const bf16* Pp = P.P;
    const float NEG = -__builtin_inff();
    bf16* const po1 = P.o1; bf16* const po2 = P.o2; bf16* const po3 = P.o3; float* const plse = P.lse;
    for (int bh = blockIdx.x; bh < NBATCH * NH; bh += gridDim.x) {
        const int b = bh >> 4, h = bh & 15; const size_t rowb = (size_t)b * SEQ;
        for (int p = 0; p < 3; ++p) {
            const int dil = (p == 0) ? 1 : (p == 1 ? 4 : 16), nbq = 16 / dil;
            bf16* OP = (p == 0) ? po1 : (p == 1 ? po2 : po3);
            float* LSE = plse + (size_t)p * MTOK * 16;
            for (int u = 0; u < 16; ++u) {
                const int r = u / nbq, n = u - r * nbq;
#pragma unroll
                for (int ps = 0; ps < 4; ++ps) {
                    const int key = ps * 64 + (tid >> 3), pc = tid & 7;
                    int l = (n - 1) * 128 + key; l = l < 0 ? 0 : l;
                    const size_t tok = rowb + (size_t)(l * dil + r);
                    const u32x4 kv = *(const u32x4*)(Pp + tok * PB + 1024 + h * 64 + pc * 8);
                    *(LAS u32x4*)(lds + L_K + key * KST + pc * 16) = kv;
                }
#pragma unroll
                for (int j = 0; j < 2; ++j) {
                    const int item = tid + NTHR * j, pc = item >> 7, kp = item & 127;
                    int l0 = (n - 1) * 128 + 2 * kp, l1 = l0 + 1; l0 = l0 < 0 ? 0 : l0; l1 = l1 < 0 ? 0 : l1;
                    const u32x4 v0 = *(const u32x4*)(Pp + (rowb + (size_t)(l0 * dil + r)) * PB + 2048 + h * 64 + pc * 8);
                    const u32x4 v1 = *(const u32x4*)(Pp + (rowb + (size_t)(l1 * dil + r)) * PB + 2048 + h * 64 + pc * 8);
#pragma unroll
                    for (int m = 0; m < 4; ++m) {
                        const unsigned lo = (v0[m] & 0xffffu) | (v1[m] << 16), hi = (v0[m] >> 16) | (v1[m] & 0xffff0000u);
                        *(LAS unsigned*)(lds + L_V + (pc * 8 + 2 * m) * VST + kp * 4) = lo;
                        *(LAS unsigned*)(lds + L_V + (pc * 8 + 2 * m + 1) * VST + kp * 4) = hi;
                    }
                }
                const int i0 = wv * 16, qi = i0 + fr;
                const size_t tokq = rowb + (size_t)((n * 128 + qi) * dil + r);
                bf16x8 qf[2];
#pragma unroll
                for (int s = 0; s < 2; ++s) qf[s] = *(const bf16x8*)(Pp + tokq * PB + h * 64 + s * 32 + fq * 8);
                __syncthreads();
                const int ks0 = i0 < 96 ? i0 : 96;
                f32x4 st[10];
#pragma unroll
                for (int kt = 0; kt < 10; ++kt) {
                    f32x4 acc = (f32x4){0.f, 0.f, 0.f, 0.f};
#pragma unroll
                    for (int s = 0; s < 2; ++s) {
                        const bf16x8 a = *(const LAS bf16x8*)(lds + L_K + (ks0 + kt * 16 + fr) * KST + (s * 32 + fq * 8) * 2);
                        acc = __builtin_amdgcn_mfma_f32_16x16x32_bf16(a, qf[s], acc, 0, 0, 0);
                    }
                    st[kt] = acc;
                }
                float m = NEG;
#pragma unroll
                for (int kt = 0; kt < 10; ++kt)
#pragma unroll
                    for (int j = 0; j < 4; ++j) {
                        const int kk = ks0 + kt * 16 + fq * 4 + j;
                        const bool valid = (kk >= qi) && (kk <= qi + 128) && (n > 0 || kk >= 128);
                        const float s = valid ? st[kt][j] * 0.125f : NEG;
                        st[kt][j] = s; m = fmaxf(m, s);
                    }
                m = fmaxf(m, __shfl_xor(m, 16)); m = fmaxf(m, __shfl_xor(m, 32));
                float ls = 0.f;
#pragma unroll
                for (int kt = 0; kt < 10; ++kt)
#pragma unroll
                    for (int j = 0; j < 4; ++j) { const float pe = __expf(st[kt][j] - m); st[kt][j] = pe; ls += pe; }
                ls += __shfl_xor(ls, 16); ls += __shfl_xor(ls, 32);
                f32x4 oacc[4];
#pragma unroll
                for (int dt = 0; dt < 4; ++dt) oacc[dt] = (f32x4){0.f, 0.f, 0.f, 0.f};
#pragma unroll
                for (int s5 = 0; s5 < 5; ++s5) {
                    u32x4 pw; pw.x = pk2(st[2 * s5][0], st[2 * s5][1]); pw.y = pk2(st[2 * s5][2], st[2 * s5][3]);
                    pw.z = pk2(st[2 * s5 + 1][0], st[2 * s5 + 1][1]); pw.w = pk2(st[2 * s5 + 1][2], st[2 * s5 + 1][3]);
                    const bf16x8 pb = __builtin_bit_cast(bf16x8, pw);
#pragma unroll
                    for (int dt = 0; dt < 4; ++dt) {
                        const LAS unsigned char* vp = lds + L_V + (dt * 16 + fr) * VST + (ks0 + 32 * s5 + 4 * fq) * 2;
                        const u32x2 lo = *(const LAS u32x2*)vp, hi = *(const LAS u32x2*)(vp + 32);
                        const u32x4 aw = (u32x4){lo.x, lo.y, hi.x, hi.y};
                        oacc[dt] = __builtin_amdgcn_mfma_f32_16x16x32_bf16(__builtin_bit_cast(bf16x8, aw), pb, oacc[dt], 0, 0, 0);
                    }
                }
                const float inv = 1.f / ls;
#pragma unroll
                for (int dt = 0; dt < 4; ++dt) {
                    u32x2 ow; ow.x = pk2(oacc[dt][0] * inv, oacc[dt][1] * inv); ow.y = pk2(oacc[dt][2] * inv, oacc[dt][3] * inv);
                    *(u32x2*)(OP + tokq * DM + h * 64 + dt * 16 + 4 * fq) = ow;
                }
                if (fq == 0) LSE[tokq * 16 + h] = m + logf(ls);
                __syncthreads();
            }
        }
        for (int pass = 0; pass < SEQ / 64; ++pass) {
            const int t = pass * 64 + (tid >> 3), pc = tid & 7; const size_t row = rowb + t;
            const float l1 = P.lse[row * 16 + h], l2 = P.lse[(size_t)MTOK * 16 + row * 16 + h], l3 = P.lse[(size_t)2 * MTOK * 16 + row * 16 + h];
            const float mx = fmaxf(l1, fmaxf(l2, l3));
            float e1 = __expf(l1 - mx), e2 = __expf(l2 - mx), e3 = __expf(l3 - mx);
            const float inv = 1.f / (e1 + e2 + e3); e1 *= inv; e2 *= inv; e3 *= inv;
            const u32x4 a = *(const u32x4*)(P.o1 + row * DM + h * 64 + pc * 8), bb = *(const u32x4*)(P.o2 + row * DM + h * 64 + pc * 8), c = *(const u32x4*)(P.o3 + row * DM + h * 64 + pc * 8);
            const u32x4 g = *(const u32x4*)(Pp + row * PB + 3072 + h * 64 + pc * 8);
            u32x4 ov;
#pragma unroll
            for (int i = 0; i < 4; ++i) {
                const float lo = (e1 * bflo(a[i]) + e2 * bflo(bb[i]) + e3 * bflo(c[i])) * silu(bflo(g[i]));
                const float hi = (e1 * bfhi(a[i]) + e2 * bfhi(bb[i]) + e3 * bfhi(c[i])) * silu(bfhi(g[i]));
                ov[i] = pk2(lo, hi);
            }
            *(u32x4*)(P.mix + row * MIXW + 1024 + h * 64 + pc * 8) = ov;
        }
        __syncthreads();
    }
}

__device__ __forceinline__ void final_norm(const Ptrs& P, int tid) {
    const int wave = tid >> 6, lane = tid & 63;
    const int gw = blockIdx.x * NWAVES + wave, NGW = gridDim.x * NWAVES;
    for (int m = gw; m < MTOK; m += NGW) {
        float ps = (lane < 16) ? P.part[(size_t)m * 16 + lane] : 0.f;
        ps += __shfl_xor(ps, 1); ps += __shfl_xor(ps, 2); ps += __shfl_xor(ps, 4); ps += __shfl_xor(ps, 8);
        const float ss = __shfl(ps, 0);
        const float rstd = 1.f / sqrtf(ss * (1.f / DM) + RMS_EPS);
        f32x4* o = (f32x4*)(P.out + (size_t)m * DM) + lane; const f32x4* w = (const f32x4*)P.fin_w + lane;
#pragma unroll
        for (int j = 0; j < 4; ++j) { const f32x4 v = o[64 * j]; o[64 * j] = v * rstd * w[64 * j]; }
    }
}

struct Args { const float* in[15]; float* out; unsigned char* ws; int mask; int sync; };
#ifndef MK_MULTI
#define MK_MULTI 0
#endif
#ifndef MK_MASK
#define MK_MASK 0x7f
#endif
__global__ void __launch_bounds__(NTHR, 2) fwd_kernel(Args a) {
    extern __shared__ __attribute__((aligned(16))) unsigned char lds_[];
    LAS unsigned char* lds = (LAS unsigned char*)lds_;
    cg::grid_group grid = cg::this_grid();
    const int tid = threadIdx.x;
    Ptrs P;
    P.x = a.in[0]; P.norm_w = a.in[1]; P.w_in = a.in[2]; P.mu = a.in[3]; P.w0 = a.in[4]; P.w_up = a.in[5]; P.a0 = a.in[6]; P.a_up = a.in[7];
    P.k_k = a.in[8]; P.k_a = a.in[9]; P.r_k = a.in[10]; P.ln_w = a.in[11]; P.ln_b = a.in[12]; P.w_out = a.in[13]; P.fin_w = a.in[14];
    P.out = a.out; unsigned char* ws = a.ws;
    P.part = (float*)(ws + WS_PART); P.lse = (float*)(ws + WS_LSE);
    P.wtin = (bf16*)(ws + WS_WTIN); P.wtout = (bf16*)(ws + WS_WTOUT); P.wupT = (bf16*)(ws + WS_WUPT); P.aupT = (bf16*)(ws + WS_AUPT);
    P.mix = (bf16*)(ws + WS_MIX); P.P = (bf16*)(ws + WS_P); P.xb = (bf16*)(ws + WS_XB);
    P.o1 = (bf16*)a.out; P.o2 = (bf16*)a.out + (size_t)MTOK * DM; P.o3 = (bf16*)(ws + WS_XB);
    const int mask = a.mask;
#define SEAM() do { if (a.sync) grid.sync(); } while (0)
    if (mask & 1) p0_prologue(lds, P, tid, (mask & 0x80) != 0);
    SEAM();
    if (mask & 2) {
        pg8::Gemm g{P.xb, P.wtin, MTOK, PA, DM}; pg8::StaticOrder S; S.init(MTOK, PA, gridDim.x, (int)blockIdx.x);
        pg8::EpiBf16<0> E{P.P, PA, nullptr, 0, 0, 1.f};
        pg8::gemm_phase<pg8::EpiBf16<0>, pg8::StaticOrder, true, true>(lds, g, S, E);
    }
    SEAM();
    if (mask & 4) rwkv_phase(lds, P, tid);
    SEAM();
    if (mask & 8) {
        pg8::Gemm g{P.xb, P.wtin + (size_t)PA * DM, MTOK, PB, DM}; pg8::StaticOrder S; S.init(MTOK, PB, gridDim.x, (int)blockIdx.x);
        pg8::EpiBf16<0> E{P.P, PB, nullptr, 0, 0, 1.f};
        pg8::gemm_phase<pg8::EpiBf16<0>, pg8::StaticOrder, true, true>(lds, g, S, E);
    }
    SEAM();
    if (mask & 16) attn_phase(lds, P, tid);
    SEAM();
    if (mask & 32) {
        pg8::Gemm g{P.mix, P.wtout, MTOK, DM, MIXW}; pg8::StaticOrder S; S.init(MTOK, DM, gridDim.x, (int)blockIdx.x);
        pg8::EpiResF32 E{P.x, P.out, P.part, DM};
        pg8::gemm_phase<pg8::EpiResF32, pg8::StaticOrder, true, true>(lds, g, S, E);
    }
    SEAM();
    if (mask & 64) final_norm(P, tid);
}

extern "C" void kernel_launch(void* const* d_in, const int* in_sizes, int n_in, void* d_out, int out_size, void* d_ws, size_t ws_size, hipStream_t stream) {
    static int grid = 0;
    if (grid == 0) {
        if (n_in != 15 || in_sizes[0] != MTOK * DM || out_size != MTOK * DM || ws_size < WS_END) {
            fprintf(stderr, "kernel_launch: unexpected shapes / workspace (n_in %d, ws %zu, need %zu); nothing launched\n", n_in, ws_size, (size_t)WS_END); grid = -1; return; }
        int dev = 0, cus = 0, per_cu = 0;
        if (hipGetDevice(&dev) != hipSuccess || hipDeviceGetAttribute(&cus, hipDeviceAttributeMultiprocessorCount, dev) != hipSuccess) { grid = -1; return; }
        if (hipFuncSetAttribute((const void*)fwd_kernel, hipFuncAttributeMaxDynamicSharedMemorySize, LDS_BYTES) != hipSuccess) { fprintf(stderr, "kernel_launch: hipFuncSetAttribute failed\n"); grid = -1; return; }
        if (hipOccupancyMaxActiveBlocksPerMultiprocessor(&per_cu, (const void*)fwd_kernel, NTHR, LDS_BYTES) != hipSuccess || per_cu < 1) { fprintf(stderr, "kernel_launch: occupancy query says %d blocks per CU\n", per_cu); grid = -1; return; }
        grid = cus;
    }
    if (grid < 0) return;
    Args a{};
    for (int i = 0; i < 15; ++i) a.in[i] = (const float*)d_in[i];
    a.out = (float*)d_out; a.ws = (unsigned char*)d_ws;
#if MK_MULTI
    for (int ph = 0; ph < 7; ++ph) {
        a.mask = (1 << ph) & (MK_MASK); if (ph == 0) a.mask |= (MK_MASK & 0x80); a.sync = 0;
        if (!(a.mask & 0x7f)) continue;
        hipLaunchKernelGGL(fwd_kernel, dim3(grid), dim3(NTHR), LDS_BYTES, stream, a);
    }
#else
    a.mask = MK_MASK; a.sync = 1;
    void* args[] = {&a};
    hipError_t e = hipLaunchCooperativeKernel((void*)fwd_kernel, dim3(grid), dim3(NTHR), args, LDS_BYTES, stream);
    if (e != hipSuccess) fprintf(stderr, "cooperative launch failed: %s (grid %d)\n", hipGetErrorString(e), grid);
#endif
}
```

```cpp
#include <hip/hip_runtime.h>
#include <hip/hip_cooperative_groups.h>
#include <cstdio>
#include <cstdint>
namespace cg = cooperative_groups;
#define MK_MULTI 0
#define MK_MASK 0x7f
namespace pg8 {
#define PG8_LAS __attribute__((address_space(3)))
typedef unsigned short bf16_t;
typedef short bf16x8 __attribute__((ext_vector_type(8)));
typedef float f32x4 __attribute__((ext_vector_type(4)));
typedef unsigned u32x4 __attribute__((ext_vector_type(4)));
constexpr int BM = 256, BK = 64, HALF = 128, HTB = HALF * BK * 2  , STAGE_BYTES = 8 * HTB, NXCD = 8, WGM = 8;

__host__ __device__ __forceinline__ int lds_byte(int r, int c) { const int st = (r >> 4) * 2 + (c >> 5), rr = r & 15, cc = c & 31, ob = rr * 64 + cc * 2; return st * 1024 + (ob ^ (((ob >> 9) & 1) << 5)); }
__host__ __device__ __forceinline__ void stage_rc(int b, int& R, int& C) { const int st = b / 1024, sb = b % 1024, swz = sb ^ (((sb >> 9) & 1) << 5); R = (st >> 1) * 16 + swz / 64; C = (st & 1) * 32 + (swz % 64) / 2; }
__host__ __device__ __forceinline__ int perm32(int rho) { const int n = rho >> 4, i = rho & 15; return 8 * (i >> 2) + 4 * n + (i & 3); }

struct Unit { int pm, pn; };
struct Gemm { const bf16_t* A; const bf16_t* Bt; int M, N, K; };

struct StaticOrder {
    int nM, nN, nwg, G, c;
    __host__ __device__ void init(int M, int N, int G_, int c_) { nM = M / BM; nN = N / BM; nwg = nM * nN; G = G_; c = c_; }
    __host__ __device__ bool next(int i, Unit& u) const {
        const long L = (long)i * G + c; if (L >= nwg) return false;
        int wgid = (int)L; { const int q = nwg / NXCD, r = nwg % NXCD, xcd = wgid % NXCD, off = wgid / NXCD; wgid = (xcd < r ? xcd * (q + 1) : r * (q + 1) + (xcd - r) * q) + off; }
        const int nig = WGM * nN, gid = wgid / nig, fm = gid * WGM, gsz = (nM - fm) < WGM ? (nM - fm) : WGM;
        u.pm = fm + ((wgid % nig) % gsz); u.pn = (wgid % nig) / gsz; return true;
    }
    __device__ __forceinline__ void a_ready(const Unit&) const {}
    __device__ __forceinline__ void done(const Unit&) const {}
};

__device__ __forceinline__ unsigned cvt_pk_bf16(float lo, float hi) { unsigned r; asm volatile("v_cvt_pk_bf16_f32 %0, %1, %2" : "=v"(r) : "v"(lo), "v"(hi)); return r; }
typedef float f32x2 __attribute__((ext_vector_type(2)));
__device__ __forceinline__ f32x2 gelu_pk(f32x2 v) {
    const f32x2 av = __builtin_elementwise_abs(v), d = av * 0.2316418882f + 1.0f;
    f32x2 t; t.x = __builtin_amdgcn_rcpf(d.x); t.y = __builtin_amdgcn_rcpf(d.y);
    f32x2 q = t * 0.5307027145f + (-0.7265760135f); q = q * t + 0.7107068705f; q = q * t + (-0.142248368f); q = q * t + 0.127414796f; q = q * t;
    const f32x2 s = (v * v) * (-0.72134752044f);
    f32x2 e; e.x = __builtin_amdgcn_exp2f(s.x); e.y = __builtin_amdgcn_exp2f(s.y);
    const f32x2 m = v * (q * e), r = v - m;
    f32x2 o; o.x = v.x < 0.f ? m.x : r.x; o.y = v.y < 0.f ? m.y : r.y; return o;
}

template <int ACT  > struct EpiBf16 {
    static constexpr bool PERM = true, AFTER_DRAIN = false; static_assert(ACT == 0 || ACT == 1, "EpiBf16: ACT is 0 (none) or 1 (gelu_pk)");
    bf16_t* O; int ldc; const float* bias; int split_cols; size_t split_stride; float scale0;
    __device__ __forceinline__ void operator()(const f32x4 (&acc)[2][2][4][2], const Unit& u, int wr, int wc, int fr, int fq) const {
        const int row0 = u.pm * BM + wr * 64 + fr; int colt = u.pn * BM; bf16_t* base = O;
        float sc = 1.f; if (split_cols) { const int t = colt / split_cols; base += (size_t)t * split_stride; colt -= t * split_cols; if (t == 0) sc = scale0; }
        const int col0 = colt + wc * 32 + 8 * fq, bcol0 = u.pn * BM + wc * 32 + 8 * fq;
        f32x4 bv[2][2];
#pragma unroll
        for (int bj = 0; bj < 2; ++bj)
#pragma unroll
            for (int n = 0; n < 2; ++n) bv[bj][n] = bias ? *(const f32x4*)(bias + bcol0 + bj * HALF + 4 * n) : (f32x4){0.f, 0.f, 0.f, 0.f};
#pragma unroll
        for (int ai = 0; ai < 2; ++ai)
#pragma unroll
            for (int m = 0; m < 4; ++m) { bf16_t* rowp = base + (size_t)(row0 + ai * HALF + m * 16) * ldc + col0;
#pragma unroll
                for (int bj = 0; bj < 2; ++bj) { f32x4 v0 = acc[ai][bj][m][0] + bv[bj][0], v1 = acc[ai][bj][m][1] + bv[bj][1];
                    if (ACT == 1) { f32x2 a = gelu_pk((f32x2){v0[0], v0[1]}), b = gelu_pk((f32x2){v0[2], v0[3]}), c = gelu_pk((f32x2){v1[0], v1[1]}), d = gelu_pk((f32x2){v1[2], v1[3]});
                        v0 = (f32x4){a.x, a.y, b.x, b.y}; v1 = (f32x4){c.x, c.y, d.x, d.y}; }
                    v0 = v0 * sc; v1 = v1 * sc; u32x4 w; w.x = cvt_pk_bf16(v0[0], v0[1]); w.y = cvt_pk_bf16(v0[2], v0[3]); w.z = cvt_pk_bf16(v1[0], v1[1]); w.w = cvt_pk_bf16(v1[2], v1[3]);
                    *(u32x4*)(rowp + bj * HALF) = w; } }
    }
};
struct EpiResF32 {
    static constexpr bool PERM = false, AFTER_DRAIN = false;
    const float* base; float* out; float* part; int ldc;
    __device__ __forceinline__ void operator()(const f32x4 (&acc)[2][2][4][2], const Unit& u, int wr, int wc, int fr, int fq) const {
        const int col0 = u.pn * BM + wc * 32 + 4 * fq;
#pragma unroll
        for (int ai = 0; ai < 2; ++ai)
#pragma unroll
            for (int m = 0; m < 4; ++m) {
                const int row = u.pm * BM + ai * HALF + wr * 64 + m * 16 + fr;
                const size_t off = (size_t)row * ldc + col0;
                float ss = 0.f;
#pragma unroll
                for (int bj = 0; bj < 2; ++bj)
#pragma unroll
                    for (int n = 0; n < 2; ++n) {
                        const f32x4 b = *(const f32x4*)(base + off + bj * HALF + n * 16);
                        const f32x4 h = b + acc[ai][bj][m][n];
                        *(f32x4*)(out + off + bj * HALF + n * 16) = h;
                        ss += (h[0] * h[0] + h[1] * h[1]) + (h[2] * h[2] + h[3] * h[3]);
                    }
                ss += __shfl_xor(ss, 16); ss += __shfl_xor(ss, 32);
                if (fq == 0) part[(size_t)row * 16 + u.pn * 4 + wc] = ss;
            }
    }
};
template <class Epi, class Sched, bool ALIGN_EPI = false, bool SP2 = false>
__device__ __forceinline__ void gemm_phase(PG8_LAS unsigned char* lds, const Gemm g, const Sched& S, const Epi& E) {
    const int tid = threadIdx.x, wid = __builtin_amdgcn_readfirstlane(tid >> 6), lane = tid & 63, wr = wid >> 2, wc = wid & 3, fr = lane & 15, fq = lane >> 4;
    const int K = g.K, nt = K / BK;
    unsigned voffA[2], voffB[2];
#pragma unroll
    for (int i = 0; i < 2; ++i) { int R, C; stage_rc(tid * 16 + i * 8192, R, C); const int Rb = Epi::PERM ? ((R & ~31) + perm32(R & 31)) : R;
        voffA[i] = (unsigned)(R * K + C) * 2u; voffB[i] = (unsigned)(Rb * K + C) * 2u; }
    const size_t kstep = (size_t)(BK * 2);
    const size_t hstep = (size_t)HALF * K * 2;
    const size_t tstep = 2 * hstep;
    const unsigned ldsw = (unsigned)wid * 1024u;
    const int aoff = lds_byte(wr * 64 + fr, fq * 8), boff = lds_byte(wc * 32 + fr, fq * 8);
#define PG8_SA(b, h) (((b) * 2 + (h)) * HTB)
#define PG8_SB(b, h) ((4 + (b) * 2 + (h)) * HTB)
#define PG8_STAGE(bufoff, gbase, voff) do { _Pragma("unroll") for (int _i = 0; _i < 2; ++_i) \
        __builtin_amdgcn_global_load_lds((const unsigned*)((const char*)(gbase) + (voff)[_i]), (PG8_LAS unsigned*)(lds + (bufoff) + ldsw + _i * 8192), 16, 0, 0); } while (0)
#define PG8_LDA(dst, b, h) do { _Pragma("unroll") for (int m = 0; m < 4; ++m) _Pragma("unroll") for (int k = 0; k < 2; ++k) dst[m][k] = *(const PG8_LAS bf16x8*)(lds + PG8_SA(b, h) + aoff + m * 2048 + k * 1024); } while (0)
#define PG8_LDB(dst, b, h) do { _Pragma("unroll") for (int n = 0; n < 2; ++n) _Pragma("unroll") for (int k = 0; k < 2; ++k) dst[n][k] = *(const PG8_LAS bf16x8*)(lds + PG8_SB(b, h) + boff + n * 2048 + k * 1024); } while (0)
#define PG8_MMA(ai, bj, At, Bt) do { __builtin_amdgcn_s_setprio(1); _Pragma("unroll") for (int m = 0; m < 4; ++m) _Pragma("unroll") for (int n = 0; n < 2; ++n) _Pragma("unroll") for (int k = 0; k < 2; ++k) \
        acc[ai][bj][m][n] = __builtin_amdgcn_mfma_f32_16x16x32_bf16(Bt[n][k], At[m][k], acc[ai][bj][m][n], 0, 0, 0); __builtin_amdgcn_s_setprio(0); } while (0)
#define PG8_WAIT_V(n) asm volatile("s_waitcnt vmcnt(" #n ")" ::: "memory")
#define PG8_WAIT_L(n) asm volatile("s_waitcnt lgkmcnt(" #n ")" ::: "memory")
#define PG8_BAR __builtin_amdgcn_s_barrier()
#define PG8_SCHED __builtin_amdgcn_sched_barrier(0)
    Unit cur, nxt; int ui = 0;
    if (!S.next(0, cur)) return;
    f32x4 acc[2][2][4][2];
#pragma unroll
    for (int a = 0; a < 2; ++a)
#pragma unroll
        for (int b = 0; b < 2; ++b)
#pragma unroll
            for (int m = 0; m < 4; ++m)
#pragma unroll
                for (int n = 0; n < 2; ++n) acc[a][b][m][n] = (f32x4){0.f, 0.f, 0.f, 0.f};
    bf16x8 At[4][2], B0[2][2], B1[2][2];
    const char* cA = (const char*)g.A + (size_t)cur.pm * tstep; const char* cB = (const char*)g.Bt + (size_t)cur.pn * tstep;
    S.a_ready(cur);
    if constexpr (SP2) {
        PG8_STAGE(PG8_SB(0, 0), cB, voffB); PG8_STAGE(PG8_SB(0, 1), cB + hstep, voffB); PG8_STAGE(PG8_SA(0, 0), cA, voffA); PG8_STAGE(PG8_SA(0, 1), cA + hstep, voffA);
        if (wr == 1) PG8_BAR;
        PG8_WAIT_V(2); PG8_BAR;
        PG8_STAGE(PG8_SB(1, 0), cB + kstep, voffB); PG8_STAGE(PG8_SA(1, 0), cA + kstep, voffA); PG8_STAGE(PG8_SB(1, 1), cB + hstep + kstep, voffB);
        PG8_WAIT_V(6); PG8_BAR;
    } else {
        PG8_STAGE(PG8_SB(0, 0), cB, voffB); PG8_STAGE(PG8_SA(0, 0), cA, voffA); PG8_STAGE(PG8_SB(0, 1), cB + hstep, voffB); PG8_STAGE(PG8_SA(0, 1), cA + hstep, voffA);
        if (wr == 1) PG8_BAR;
        PG8_WAIT_V(4); PG8_BAR;
        PG8_STAGE(PG8_SB(1, 0), cB + kstep, voffB); PG8_STAGE(PG8_SA(1, 0), cA + kstep, voffA); PG8_STAGE(PG8_SB(1, 1), cB + hstep + kstep, voffB);
        PG8_WAIT_V(6); PG8_BAR;
    }
    for (;;) {
        const bool has_next = S.next(ui + 1, nxt);
        const char* nA = has_next ? (const char*)g.A + (size_t)nxt.pm * tstep : cA; const char* nB = has_next ? (const char*)g.Bt + (size_t)nxt.pn * tstep : cB;
        for (int t = 0; t < nt; t += 2) {
            const bool last = (t == nt - 2);
            const char* a1 = cA + (size_t)(t + 1) * kstep;
            const char* a2 = last ? nA : cA + (size_t)(t + 2) * kstep; const char* b2 = last ? nB : cB + (size_t)(t + 2) * kstep;
            const char* a3 = a2 + kstep; const char* b3 = b2 + kstep;
            if (last && has_next) S.a_ready(nxt);
            if constexpr (SP2) {
            PG8_LDB(B0, 0, 0); PG8_LDB(B1, 0, 1); PG8_SCHED; PG8_LDA(At, 0, 0); PG8_STAGE(PG8_SA(1, 1), a1 + hstep, voffA);
            PG8_WAIT_V(8); PG8_WAIT_L(0); PG8_BAR; PG8_MMA(0, 0, At, B0); PG8_MMA(0, 1, At, B1); PG8_BAR; PG8_SCHED;
            PG8_LDA(At, 0, 1); PG8_STAGE(PG8_SB(0, 0), b2, voffB); PG8_STAGE(PG8_SB(0, 1), b2 + hstep, voffB); PG8_STAGE(PG8_SA(0, 0), a2, voffA);
            PG8_WAIT_V(8); PG8_WAIT_L(0); PG8_BAR; PG8_MMA(1, 0, At, B0); PG8_MMA(1, 1, At, B1); PG8_BAR; PG8_SCHED;
            PG8_LDB(B0, 1, 0); PG8_LDB(B1, 1, 1); PG8_SCHED; PG8_LDA(At, 1, 0); PG8_STAGE(PG8_SA(0, 1), a2 + hstep, voffA);
            PG8_WAIT_V(8); PG8_WAIT_L(0); PG8_BAR; PG8_MMA(0, 0, At, B0); PG8_MMA(0, 1, At, B1); PG8_BAR; PG8_SCHED;
            PG8_LDA(At, 1, 1); PG8_STAGE(PG8_SB(1, 0), b3, voffB); PG8_STAGE(PG8_SB(1, 1), b3 + hstep, voffB); PG8_STAGE(PG8_SA(1, 0), a3, voffA);
            PG8_WAIT_V(8); PG8_WAIT_L(0); PG8_BAR; PG8_MMA(1, 0, At, B0); PG8_MMA(1, 1, At, B1); PG8_BAR; PG8_SCHED;
            } else {
            PG8_LDB(B0, 0, 0); PG8_SCHED; PG8_LDA(At, 0, 0); PG8_STAGE(PG8_SA(1, 1), a1 + hstep, voffA);
            PG8_WAIT_L(8); PG8_BAR; PG8_WAIT_L(0); PG8_MMA(0, 0, At, B0); PG8_BAR; PG8_SCHED;
            PG8_LDB(B1, 0, 1); PG8_STAGE(PG8_SB(0, 0), b2, voffB);
            PG8_BAR; PG8_WAIT_L(0); PG8_MMA(0, 1, At, B1); PG8_BAR;
            PG8_LDA(At, 0, 1); PG8_STAGE(PG8_SA(0, 0), a2, voffA);
            PG8_BAR; PG8_WAIT_L(0); PG8_MMA(1, 0, At, B0); PG8_BAR; PG8_SCHED;
            PG8_STAGE(PG8_SB(0, 1), b2 + hstep, voffB);
            PG8_WAIT_V(6); PG8_BAR; PG8_MMA(1, 1, At, B1); PG8_BAR;
            PG8_LDB(B0, 1, 0); PG8_SCHED; PG8_LDA(At, 1, 0); PG8_STAGE(PG8_SA(0, 1), a2 + hstep, voffA);
            PG8_WAIT_L(8); PG8_BAR; PG8_WAIT_L(0); PG8_MMA(0, 0, At, B0); PG8_BAR; PG8_SCHED;
            PG8_LDB(B1, 1, 1); PG8_STAGE(PG8_SB(1, 0), b3, voffB);
            PG8_BAR; PG8_WAIT_L(0); PG8_MMA(0, 1, At, B1); PG8_BAR;
            PG8_LDA(At, 1, 1); PG8_STAGE(PG8_SA(1, 0), a3, voffA);
            PG8_BAR; PG8_WAIT_L(0); PG8_MMA(1, 0, At, B0); PG8_BAR; PG8_SCHED;
            PG8_STAGE(PG8_SB(1, 1), b3 + hstep, voffB);
            PG8_WAIT_V(6); PG8_BAR; PG8_MMA(1, 1, At, B1); PG8_BAR;
            }
        }
        if constexpr (ALIGN_EPI) { if (wr == 0) PG8_BAR; }
        if constexpr (!Epi::AFTER_DRAIN) { E(acc, cur, wr, wc, fr, fq); S.done(cur); }
        if (!has_next) break;
#pragma unroll
        for (int a = 0; a < 2; ++a)
#pragma unroll
            for (int b = 0; b < 2; ++b)
#pragma unroll
                for (int m = 0; m < 4; ++m)
#pragma unroll
                    for (int n = 0; n < 2; ++n) acc[a][b][m][n] = (f32x4){0.f, 0.f, 0.f, 0.f};
        cur = nxt; cA = nA; cB = nB; ++ui;
        if constexpr (ALIGN_EPI) { if (wr == 1) PG8_BAR; }
    }
    PG8_WAIT_V(0);
    if constexpr (!ALIGN_EPI) { if (wr == 0) PG8_BAR; }
    PG8_BAR;
    if constexpr (Epi::AFTER_DRAIN) { E.fused(acc, cur, wr, wc, fr, fq, lds, wid, lane); S.done(cur); }
#undef PG8_SA
#undef PG8_SB
#undef PG8_STAGE
#undef PG8_LDA
#undef PG8_LDB
#undef PG8_MMA
#undef PG8_WAIT_V
#undef PG8_WAIT_L
#undef PG8_BAR
#undef PG8_SCHED
}
}

#define LAS __attribute__((address_space(3)))
typedef unsigned short bf16;
typedef unsigned u32x4 __attribute__((ext_vector_type(4)));
typedef unsigned u32x2 __attribute__((ext_vector_type(2)));
typedef float f32x4 __attribute__((ext_vector_type(4)));
typedef short bf16x8 __attribute__((ext_vector_type(8)));
constexpr int DM = 1024, NBATCH = 16, SEQ = 2048, MTOK = NBATCH * SEQ, NH = 16;
constexpr int N_IN = 8320, RW_COLS = 4224, PA = 4352, PB = 4096, MIXW = 2048;
constexpr float RMS_EPS = 1e-5f, GN_EPS = 64e-5f;
constexpr size_t MiB = 1u << 20;
constexpr size_t WS_PART = 1 * MiB, WS_WTIN = 3 * MiB, WS_WTOUT = 20 * MiB, WS_WUPT = 24 * MiB, WS_AUPT = 24 * MiB + 256 * 1024, WS_LSE = 25 * MiB,
                 WS_MIX = 32 * MiB, WS_P = 160 * MiB, WS_XB = 432 * MiB, WS_END = 496 * MiB;
constexpr int LDS_BYTES = 147456;
constexpr int NWAVES = 8, NTHR = 512;

struct Ptrs {
    const float *x, *norm_w, *w_in, *mu, *w0, *w_up, *a0, *a_up, *k_k, *k_a, *r_k, *ln_w, *ln_b, *w_out, *fin_w;
    float* out; float* part; float* lse;
    bf16 *wtin, *wtout, *wupT, *aupT, *mix, *P, *xb, *o1, *o2, *o3;
};

__device__ __forceinline__ unsigned f2bf(float f) { unsigned u = __builtin_bit_cast(unsigned, f); return (u + 0x7fffu + ((u >> 16) & 1u)) >> 16; }
__device__ __forceinline__ unsigned pk2(float lo, float hi) { return f2bf(lo) | (f2bf(hi) << 16); }
__device__ __forceinline__ float bflo(unsigned w) { return __builtin_bit_cast(float, w << 16); }
__device__ __forceinline__ float bfhi(unsigned w) { return __builtin_bit_cast(float, w & 0xffff0000u); }
__device__ __forceinline__ float wave_sum(float v) {
#pragma unroll
    for (int o = 1; o < 64; o <<= 1) v += __shfl_xor(v, o);
    return v;
}
__device__ __forceinline__ float silu(float g) { return g / (1.f + __expf(-g)); }

__device__ __forceinline__ void p0_transpose_item(const float* W, int K, int N, bf16* WT, int split, LAS float* scr, int item, int lane) {
    const int nblk = N / 32, kb = item / nblk, nb = item % nblk, k0 = 64 * kb, n0 = 32 * nb;
    const int row_off = (n0 >= split) ? 128 : 0;
#pragma unroll 8
    for (int i = 0; i < 32; ++i) { const int kk = 2 * i + (lane >> 5); scr[kk * 33 + (lane & 31)] = W[(size_t)(k0 + kk) * N + n0 + (lane & 31)]; }
    asm volatile("s_waitcnt lgkmcnt(0)" ::: "memory");
    const int c = lane & 7;
#pragma unroll
    for (int j = 0; j < 4; ++j) { const int n = (lane >> 3) + 8 * j; const LAS float* s = scr + (8 * c) * 33 + n;
        u32x4 o; o.x = pk2(s[0 * 33], s[1 * 33]); o.y = pk2(s[2 * 33], s[3 * 33]); o.z = pk2(s[4 * 33], s[5 * 33]); o.w = pk2(s[6 * 33], s[7 * 33]);
        *(u32x4*)(WT + (size_t)(row_off + n0 + n) * K + k0 + 8 * c) = o; }
    asm volatile("s_waitcnt lgkmcnt(0)" ::: "memory");
}
__device__ __forceinline__ void p0_prologue(LAS unsigned char* lds, const Ptrs& P, int tid, bool zero_mix) {
    const int wave = __builtin_amdgcn_readfirstlane(tid >> 6), lane = tid & 63;
    LAS float* scr = (LAS float*)(lds + wave * 16384);
    const int gw = blockIdx.x * NWAVES + wave, NGW = gridDim.x * NWAVES;
    constexpr int I_IN = (DM / 64) * (N_IN / 32), I_OUT = (MIXW / 64) * (DM / 32), I_UP = DM / 32;
    constexpr int NITEMS = I_IN + I_OUT + 2 * I_UP;
    for (int it = gw; it < NITEMS; it += NGW) {
        int r = it;
        if (r < I_IN) { p0_transpose_item(P.w_in, DM, N_IN, P.wtin, RW_COLS, scr, r, lane); continue; } r -= I_IN;
        if (r < I_OUT) { p0_transpose_item(P.w_out, MIXW, DM, P.wtout, 1 << 30, scr, r, lane); continue; } r -= I_OUT;
        if (r < I_UP) { p0_transpose_item(P.w_up, 64, DM, P.wupT, 1 << 30, scr, r, lane); continue; } r -= I_UP;
        p0_transpose_item(P.a_up, 64, DM, P.aupT, 1 << 30, scr, r, lane);
    }
    { const int gt = blockIdx.x * NTHR + tid, NGT = gridDim.x * NTHR; u32x4* z = (u32x4*)(P.wtin + (size_t)RW_COLS * DM);
      for (int i = gt; i < 128 * DM * 2 / 16; i += NGT) z[i] = (u32x4){0u, 0u, 0u, 0u};
      if (zero_mix) { u32x4* zm = (u32x4*)P.mix; for (size_t i = gt; i < (size_t)MTOK * MIXW * 2 / 16; i += NGT) zm[i] = (u32x4){0u, 0u, 0u, 0u}; } }
    for (int m = gw; m < MTOK; m += NGW) {
        const f32x4* xr = (const f32x4*)(P.x + (size_t)m * DM) + lane; const f32x4* wr = (const f32x4*)P.norm_w + lane;
        f32x4 v[4]; float s = 0.f;
#pragma unroll
        for (int j = 0; j < 4; ++j) { v[j] = xr[64 * j]; s += (v[j].x * v[j].x + v[j].y * v[j].y) + (v[j].z * v[j].z + v[j].w * v[j].w); }
        const float rstd = 1.f / sqrtf(wave_sum(s) * (1.f / DM) + RMS_EPS);
        unsigned long long* o8 = (unsigned long long*)(P.xb + (size_t)m * DM) + lane;
#pragma unroll
        for (int j = 0; j < 4; ++j) { const f32x4 w = wr[64 * j];
            o8[64 * j] = (unsigned long long)pk2(v[j].x * rstd * w.x, v[j].y * rstd * w.y) | ((unsigned long long)pk2(v[j].z * rstd * w.z, v[j].w * rstd * w.w) << 32); }
    }
}

namespace rw {
constexpr int T = 64;
constexpr int A_DEC = 0, A_BV = 16384, A_K = 32768, A_R = 49152, A_AV = 65536, A_V = 81920, A_Y = 98304, A_WL = 114688, WLS = 144, A_AL = A_WL + T * WLS, A_BON = A_AL + T * WLS;
static_assert(A_BON + T * 4 <= LDS_BYTES, "rwkv LDS");
template <int CTRL> __device__ __forceinline__ float dpp_add(float x) {
    const int y = __builtin_amdgcn_update_dpp(0, __builtin_bit_cast(int, x), CTRL, 0xf, 0xf, false);
    return x + __builtin_bit_cast(float, y);
}
__device__ __forceinline__ float allreduce16(float x) {
    x = dpp_add<0xB1>(x);
    x = dpp_add<0x4E>(x);
    x = dpp_add<0x141>(x);
    x = dpp_add<0x140>(x);
    return x;
}
}

__device__ __forceinline__ void rwkv_phase(LAS unsigned char* lds, const Ptrs& P, int tid) {
    using namespace rw;
    const int wv = __builtin_amdgcn_readfirstlane(tid >> 6), lane = tid & 63, fr = lane & 15, fq = lane >> 4;
    const bf16* Pp = P.P;
    LAS float* aDEC = (LAS float*)(lds + A_DEC); LAS float* aBV = (LAS float*)(lds + A_BV); LAS float* aK = (LAS float*)(lds + A_K); LAS float* aR = (LAS float*)(lds + A_R);
    LAS float* aAV = (LAS float*)(lds + A_AV); LAS float* aV = (LAS float*)(lds + A_V); LAS float* aY = (LAS float*)(lds + A_Y); LAS float* aBON = (LAS float*)(lds + A_BON);
    for (int bh = blockIdx.x; bh < NBATCH * NH; bh += gridDim.x) {
        const int b = bh >> 4, h = bh & 15; const size_t rowb = (size_t)b * SEQ;
        const int nt = wv & 3, mt0 = (wv >> 2) * 2;
        bf16x8 bw[2], ba[2];
#pragma unroll
        for (int ks = 0; ks < 2; ++ks) { bw[ks] = *(const bf16x8*)(P.wupT + (size_t)(h * 64 + nt * 16 + fr) * 64 + ks * 32 + fq * 8);
                                         ba[ks] = *(const bf16x8*)(P.aupT + (size_t)(h * 64 + nt * 16 + fr) * 64 + ks * 32 + fq * 8); }
        const float w0c = P.w0[h * 64 + nt * 16 + fr], a0c = P.a0[h * 64 + nt * 16 + fr];
        float S[4][4];
#pragma unroll
        for (int i = 0; i < 4; ++i)
#pragma unroll
            for (int c = 0; c < 4; ++c) S[i][c] = 0.f;
        for (int ch = 0; ch < SEQ / T; ++ch) {
            const int t0 = ch * T;
            for (int it = tid; it < T * 40; it += NTHR) {
                const int tt = it / 40, rem = it - tt * 40, seg = rem >> 3, pc = rem & 7;
                const int col = (seg < 3) ? seg * 1024 + h * 64 + pc * 8 : 3072 + (seg - 3) * 64 + pc * 8;
                const int t = t0 + tt;
                const bf16* src = Pp + (rowb + t) * PA + col;
                const u32x4 cur = *(const u32x4*)src;
                u32x4 prv = (u32x4){0u, 0u, 0u, 0u};
                if (t > 0) prv = *(const u32x4*)(src - PA);
                const f32x4 mu0 = *(const f32x4*)(P.mu + col), mu1 = *(const f32x4*)(P.mu + col + 4);
                float v[8];
#pragma unroll
                for (int i = 0; i < 4; ++i) { const float cl = bflo(cur[i]), chh = bfhi(cur[i]), pl = bflo(prv[i]), ph = bfhi(prv[i]);
                    const float m0 = (i < 2) ? mu0[2 * i] : mu1[2 * i - 4], m1 = (i < 2) ? mu0[2 * i + 1] : mu1[2 * i - 3];
                    v[2 * i] = cl + (pl - cl) * m0; v[2 * i + 1] = chh + (ph - chh) * m1; }
                if (seg < 3) {
                    LAS float* dst = ((seg == 0) ? aR : (seg == 1) ? aK : aV) + tt * 64 + pc * 8;
                    *(LAS f32x4*)dst = (f32x4){v[0], v[1], v[2], v[3]}; *(LAS f32x4*)(dst + 4) = (f32x4){v[4], v[5], v[6], v[7]};
                } else {
                    if (seg == 3) {
#pragma unroll
                        for (int i = 0; i < 8; ++i) v[i] = tanhf(v[i]);
                    }
                    u32x4 o; o.x = pk2(v[0], v[1]); o.y = pk2(v[2], v[3]); o.z = pk2(v[4], v[5]); o.w = pk2(v[6], v[7]);
                    *(LAS u32x4*)(lds + ((seg == 3) ? A_WL : A_AL) + tt * WLS + pc * 16) = o;
                }
            }
            __syncthreads();
            {
#pragma unroll
                for (int mi = 0; mi < 2; ++mi) {
                    const int mt = mt0 + mi;
                    f32x4 accw = (f32x4){0.f, 0.f, 0.f, 0.f}, acca = (f32x4){0.f, 0.f, 0.f, 0.f};
#pragma unroll
                    for (int ks = 0; ks < 2; ++ks) {
                        const bf16x8 aw = *(const LAS bf16x8*)(lds + A_WL + (mt * 16 + fr) * WLS + (ks * 32 + fq * 8) * 2);
                        const bf16x8 aa = *(const LAS bf16x8*)(lds + A_AL + (mt * 16 + fr) * WLS + (ks * 32 + fq * 8) * 2);
                        accw = __builtin_amdgcn_mfma_f32_16x16x32_bf16(aw, bw[ks], accw, 0, 0, 0);
                        acca = __builtin_amdgcn_mfma_f32_16x16x32_bf16(aa, ba[ks], acca, 0, 0, 0);
                    }
#pragma unroll
                    for (int j = 0; j < 4; ++j) {
                        const int tt = mt * 16 + fq * 4 + j, c = nt * 16 + fr;
                        const float z = -(w0c + accw[j]);
                        const float sp = fmaxf(z, 0.f) + log1pf(expf(-fabsf(z)));
                        const float dec = expf(-expf(-sp - 0.5f));
                        const float a = 1.f / (1.f + expf(-(a0c + acca[j])));
                        aDEC[tt * 64 + c] = dec; aBV[tt * 64 + c] = a;
                    }
                }
            }
            __syncthreads();
            {
                const int tt = tid >> 3, c8 = (tid & 7) * 8, o = tt * 64 + c8;
                const f32x4 k0 = *(LAS f32x4*)(aK + o), k1 = *(LAS f32x4*)(aK + o + 4), a0v = *(LAS f32x4*)(aBV + o), a1v = *(LAS f32x4*)(aBV + o + 4);
                const f32x4 r0 = *(LAS f32x4*)(aR + o), r1 = *(LAS f32x4*)(aR + o + 4);
                const f32x4 kk0 = *(const f32x4*)(P.k_k + h * 64 + c8), kk1 = *(const f32x4*)(P.k_k + h * 64 + c8 + 4);
                const f32x4 ka0 = *(const f32x4*)(P.k_a + h * 64 + c8), ka1 = *(const f32x4*)(P.k_a + h * 64 + c8 + 4);
                const f32x4 rk0 = *(const f32x4*)(P.r_k + h * 64 + c8), rk1 = *(const f32x4*)(P.r_k + h * 64 + c8 + 4);
                f32x4 n0 = k0 * kk0, n1 = k1 * kk1;
                float ss = (n0.x * n0.x + n0.y * n0.y) + (n0.z * n0.z + n0.w * n0.w) + (n1.x * n1.x + n1.y * n1.y) + (n1.z * n1.z + n1.w * n1.w);
                ss += __shfl_xor(ss, 1); ss += __shfl_xor(ss, 2); ss += __shfl_xor(ss, 4);
                const float inv = 1.f / fmaxf(sqrtf(ss), 1e-12f);
                n0 = n0 * inv; n1 = n1 * inv;
                const f32x4 kp0 = k0 * (1.f + (a0v - 1.f) * ka0), kp1 = k1 * (1.f + (a1v - 1.f) * ka1);
                const f32x4 bq0 = r0 * kp0 * rk0, bq1 = r1 * kp1 * rk1;
                float bon = (bq0.x + bq0.y) + (bq0.z + bq0.w) + (bq1.x + bq1.y) + (bq1.z + bq1.w);
                bon += __shfl_xor(bon, 1); bon += __shfl_xor(bon, 2); bon += __shfl_xor(bon, 4);
                *(LAS f32x4*)(aK + o) = kp0; *(LAS f32x4*)(aK + o + 4) = kp1;
                *(LAS f32x4*)(aAV + o) = -n0; *(LAS f32x4*)(aAV + o + 4) = -n1;
                *(LAS f32x4*)(aBV + o) = n0 * a0v; *(LAS f32x4*)(aBV + o + 4) = n1 * a1v;
                if ((tid & 7) == 0) aBON[tt] = bon;
            }
            __syncthreads();
            if (wv < 4) {
                const int rg = lane >> 4, kg = lane & 15;
                const LAS float* pd = aDEC + kg * 4; const LAS float* pb = aBV + kg * 4; const LAS float* pk = aK + kg * 4;
                const LAS float* pr = aR + kg * 4; const LAS float* pa = aAV + kg * 4; const LAS float* pv = aV + wv * 16 + rg * 4;
                LAS float* py = aY + wv * 16 + rg * 4;
#pragma unroll 2
                for (int t = 0; t < T; ++t) {
                    const f32x4 dec = *(const LAS f32x4*)(pd + t * 64), bv = *(const LAS f32x4*)(pb + t * 64), kk = *(const LAS f32x4*)(pk + t * 64);
                    const f32x4 rr = *(const LAS f32x4*)(pr + t * 64), av = *(const LAS f32x4*)(pa + t * 64), vv = *(const LAS f32x4*)(pv + t * 64);
                    float sa[4];
#pragma unroll
                    for (int i = 0; i < 4; ++i) sa[i] = (S[i][0] * av[0] + S[i][1] * av[1]) + (S[i][2] * av[2] + S[i][3] * av[3]);
#pragma unroll
                    for (int i = 0; i < 4; ++i) sa[i] = allreduce16(sa[i]);
#pragma unroll
                    for (int i = 0; i < 4; ++i)
#pragma unroll
                        for (int c = 0; c < 4; ++c) S[i][c] = S[i][c] * dec[c] + sa[i] * bv[c] + vv[i] * kk[c];
                    float y[4];
#pragma unroll
                    for (int i = 0; i < 4; ++i) y[i] = (S[i][0] * rr[0] + S[i][1] * rr[1]) + (S[i][2] * rr[2] + S[i][3] * rr[3]);
#pragma unroll
                    for (int i = 0; i < 4; ++i) y[i] = allreduce16(y[i]);
                    if (kg == 0) *(LAS f32x4*)(py + t * 64) = (f32x4){y[0], y[1], y[2], y[3]};
                }
            }
            __syncthreads();
            {
                const int tt = tid >> 3, c8 = (tid & 7) * 8, o = tt * 64 + c8, t = t0 + tt;
                const f32x4 y0 = *(LAS f32x4*)(aY + o), y1 = *(LAS f32x4*)(aY + o + 4), v0 = *(LAS f32x4*)(aV + o), v1 = *(LAS f32x4*)(aV + o + 4);
                const float bon = aBON[tt];
                const u32x4 g = *(const u32x4*)(Pp + (rowb + t) * PA + 3200 + h * 64 + c8);
                const f32x4 lw0 = *(const f32x4*)(P.ln_w + h * 64 + c8), lw1 = *(const f32x4*)(P.ln_w + h * 64 + c8 + 4);
                const f32x4 lb0 = *(const f32x4*)(P.ln_b + h * 64 + c8), lb1 = *(const f32x4*)(P.ln_b + h * 64 + c8 + 4);
                float s = (y0.x + y0.y) + (y0.z + y0.w) + (y1.x + y1.y) + (y1.z + y1.w);
                s += __shfl_xor(s, 1); s += __shfl_xor(s, 2); s += __shfl_xor(s, 4);
                const float mean = s * (1.f / 64.f);
                const f32x4 d0 = y0 - mean, d1 = y1 - mean;
                float q = (d0.x * d0.x + d0.y * d0.y) + (d0.z * d0.z + d0.w * d0.w) + (d1.x * d1.x + d1.y * d1.y) + (d1.z * d1.z + d1.w * d1.w);
                q += __shfl_xor(q, 1); q += __shfl_xor(q, 2); q += __shfl_xor(q, 4);
                const float rstd = 1.f / sqrtf(q * (1.f / 64.f) + GN_EPS);
                const f32x4 e0 = d0 * rstd * lw0 + lb0 + bon * v0, e1 = d1 * rstd * lw1 + lb1 + bon * v1;
                u32x4 ov;
                ov.x = pk2(e0.x * silu(bflo(g.x)), e0.y * silu(bfhi(g.x))); ov.y = pk2(e0.z * silu(bflo(g.y)), e0.w * silu(bfhi(g.y)));
                ov.z = pk2(e1.x * silu(bflo(g.z)), e1.y * silu(bfhi(g.z))); ov.w = pk2(e1.z * silu(bflo(g.w)), e1.w * silu(bfhi(g.w)));
                *(u32x4*)(P.mix + (rowb + t) * MIXW + h * 64 + c8) = ov;
            }
            __syncthreads();
        }
    }
}

namespace att { constexpr int KST = 144, VST = 528, L_K = 0, L_V = 256 * KST; static_assert(L_V + 64 * VST <= LDS_BYTES, "att LDS"); }

__device__ __forceinline__ void attn_phase(LAS unsigned char* lds, const Ptrs& P, int tid) {
    using namespace att;
    const int wv = __builtin_amdgcn_readfirstlane(tid >> 6), lane = tid & 63, fr = lane & 15, fq = lane >> 4;
    const bf16* Pp = P.P;
    const float NEG = -__builtin_inff();
    bf16* const po1 = P.o1; bf16* const po2 = P.o2; bf16* const po3 = P.o3; float* const plse = P.lse;
    for (int bh = blockIdx.x; bh < NBATCH * NH; bh += gridDim.x) {
        const int b = bh >> 4, h = bh & 15; const size_t rowb = (size_t)b * SEQ;
        for (int p = 0; p < 3; ++p) {
            const int dil = (p == 0) ? 1 : (p == 1 ? 4 : 16), nbq = 16 / dil;
            bf16* OP = (p == 0) ? po1 : (p == 1 ? po2 : po3);
            float* LSE = plse + (size_t)p * MTOK * 16;
            for (int u = 0; u < 16; ++u) {
                const int r = u / nbq, n = u - r * nbq;
#pragma unroll
                for (int ps = 0; ps < 4; ++ps) {
                    const int key = ps * 64 + (tid >> 3), pc = tid & 7;
                    int l = (n - 1) * 128 + key; l = l < 0 ? 0 : l;
                    const size_t tok = rowb + (size_t)(l * dil + r);
                    const u32x4 kv = *(const u32x4*)(Pp + tok * PB + 1024 + h * 64 + pc * 8);
                    *(LAS u32x4*)(lds + L_K + key * KST + pc * 16) = kv;
                }
#pragma unroll
                for (int j = 0; j < 2; ++j) {
                    const int item = tid + NTHR * j, pc = item >> 7, kp = item & 127;
                    int l0 = (n - 1) * 128 + 2 * kp, l1 = l0 + 1; l0 = l0 < 0 ? 0 : l0; l1 = l1 < 0 ? 0 : l1;
                    const u32x4 v0 = *(const u32x4*)(Pp + (rowb + (size_t)(l0 * dil + r)) * PB + 2048 + h * 64 + pc * 8);
                    const u32x4 v1 = *(const u32x4*)(Pp + (rowb + (size_t)(l1 * dil + r)) * PB + 2048 + h * 64 + pc * 8);
#pragma unroll
                    for (int m = 0; m < 4; ++m) {
                        const unsigned lo = (v0[m] & 0xffffu) | (v1[m] << 16), hi = (v0[m] >> 16) | (v1[m] & 0xffff0000u);
                        *(LAS unsigned*)(lds + L_V + (pc * 8 + 2 * m) * VST + kp * 4) = lo;
                        *(LAS unsigned*)(lds + L_V + (pc * 8 + 2 * m + 1) * VST + kp * 4) = hi;
                    }
                }
                const int i0 = wv * 16, qi = i0 + fr;
                const size_t tokq = rowb + (size_t)((n * 128 + qi) * dil + r);
                bf16x8 qf[2];
#pragma unroll
                for (int s = 0; s < 2; ++s) qf[s] = *(const bf16x8*)(Pp + tokq * PB + h * 64 + s * 32 + fq * 8);
                __syncthreads();
                const int ks0 = i0 < 96 ? i0 : 96;
                f32x4 st[10];
#pragma unroll
                for (int kt = 0; kt < 10; ++kt) {
                    f32x4 acc = (f32x4){0.f, 0.f, 0.f, 0.f};
#pragma unroll
                    for (int s = 0; s < 2; ++s) {
                        const bf16x8 a = *(const LAS bf16x8*)(lds + L_K + (ks0 + kt * 16 + fr) * KST + (s * 32 + fq * 8) * 2);
                        acc = __builtin_amdgcn_mfma_f32_16x16x32_bf16(a, qf[s], acc, 0, 0, 0);
                    }
                    st[kt] = acc;
                }
                float m = NEG;
#pragma unroll
                for (int kt = 0; kt < 10; ++kt)
#pragma unroll
                    for (int j = 0; j < 4; ++j) {
                        const int kk = ks0 + kt * 16 + fq * 4 + j;
                        const bool valid = (kk >= qi) && (kk <= qi + 128) && (n > 0 || kk >= 128);
                        const float s = valid ? st[kt][j] * 0.125f : NEG;
                        st[kt][j] = s; m = fmaxf(m, s);
                    }
                m = fmaxf(m, __shfl_xor(m, 16)); m = fmaxf(m, __shfl_xor(m, 32));
                float ls = 0.f;
#pragma unroll
                for (int kt = 0; kt < 10; ++kt)
#pragma unroll
                    for (int j = 0; j < 4; ++j) { const float pe = __expf(st[kt][j] - m); st[kt][j] = pe; ls += pe; }
                ls += __shfl_xor(ls, 16); ls += __shfl_xor(ls, 32);
                f32x4 oacc[4];
#pragma unroll
                for (int dt = 0; dt < 4; ++dt) oacc[dt] = (f32x4){0.f, 0.f, 0.f, 0.f};
#pragma unroll
                for (int s5 = 0; s5 < 5; ++s5) {
                    u32x4 pw; pw.x = pk2(st[2 * s5][0], st[2 * s5][1]); pw.y = pk2(st[2 * s5][2], st[2 * s5][3]);
                    pw.z = pk2(st[2 * s5 + 1][0], st[2 * s5 + 1][1]); pw.w = pk2(st[2 * s5 + 1][2], st[2 * s5 + 1][3]);
                    const bf16x8 pb = __builtin_bit_cast(bf16x8, pw);
#pragma unroll
                    for (int dt = 0; dt < 4; ++dt) {
                        const LAS unsigned char* vp = lds + L_V + (dt * 16 + fr) * VST + (ks0 + 32 * s5 + 4 * fq) * 2;
                        const u32x2 lo = *(const LAS u32x2*)vp, hi = *(const LAS u32x2*)(vp + 32);
                        const u32x4 aw = (u32x4){lo.x, lo.y, hi.x, hi.y};
                        oacc[dt] = __builtin_amdgcn_mfma_f32_16x16x32_bf16(__builtin_bit_cast(bf16x8, aw), pb, oacc[dt], 0, 0, 0);
                    }
                }
                const float inv = 1.f / ls;
#pragma unroll
                for (int dt = 0; dt < 4; ++dt) {
                    u32x2 ow; ow.x = pk2(oacc[dt][0] * inv, oacc[dt][1] * inv); ow.y = pk2(oacc[dt][2] * inv, oacc[dt][3] * inv);
                    *(u32x2*)(OP + tokq * DM + h * 64 + dt * 16 + 4 * fq) = ow;
                }
                if (fq == 0) LSE[tokq * 16 + h] = m + logf(ls);
                __syncthreads();
            }
        }
        for (int pass = 0; pass < SEQ / 64; ++pass) {
            const int t = pass * 64 + (tid >> 3), pc = tid & 7; const size_t row = rowb + t;
            const float l1 = P.lse[row * 16 + h], l2 = P.lse[(size_t)MTOK * 16 + row * 16 + h], l3 = P.lse[(size_t)2 * MTOK * 16 + row * 16 + h];
            const float mx = fmaxf(l1, fmaxf(l2, l3));
            float e1 = __expf(l1 - mx), e2 = __expf(l2 - mx), e3 = __expf(l3 - mx);
            const float inv = 1.f / (e1 + e2 + e3); e1 *= inv; e2 *= inv; e3 *= inv;
            const u32x4 a = *(const u32x4*)(P.o1 + row * DM + h * 64 + pc * 8), bb = *(const u32x4*)(P.o2 + row * DM + h * 64 + pc * 8), c = *(const u32x4*)(P.o3 + row * DM + h * 64 + pc * 8);
            const u32x4 g = *(const u32x4*)(Pp + row * PB + 3072 + h * 64 + pc * 8);
            u32x4 ov;
#pragma unroll
            for (int i = 0; i < 4; ++i) {
                const float lo = (e1 * bflo(a[i]) + e2 * bflo(bb[i]) + e3 * bflo(c[i])) * silu(bflo(g[i]));
                const float hi = (e1 * bfhi(a[i]) + e2 * bfhi(bb[i]) + e3 * bfhi(c[i])) * silu(bfhi(g[i]));
                ov[i] = pk2(lo, hi);
            }
            *(u32x4*)(P.mix + row * MIXW + 1024 + h * 64 + pc * 8) = ov;
        }
        __syncthreads();
    }
}

__device__ __forceinline__ void final_norm(const Ptrs& P, int tid) {
    const int wave = tid >> 6, lane = tid & 63;
    const int gw = blockIdx.x * NWAVES + wave, NGW = gridDim.x * NWAVES;
    for (int m = gw; m < MTOK; m += NGW) {
        float ps = (lane < 16) ? P.part[(size_t)m * 16 + lane] : 0.f;
        ps += __shfl_xor(ps, 1); ps += __shfl_xor(ps, 2); ps += __shfl_xor(ps, 4); ps += __shfl_xor(ps, 8);
        const float ss = __shfl(ps, 0);
        const float rstd = 1.f / sqrtf(ss * (1.f / DM) + RMS_EPS);
        f32x4* o = (f32x4*)(P.out + (size_t)m * DM) + lane; const f32x4* w = (const f32x4*)P.fin_w + lane;
#pragma unroll
        for (int j = 0; j < 4; ++j) { const f32x4 v = o[64 * j]; o[64 * j] = v * rstd * w[64 * j]; }
    }
}

struct Args { const float* in[15]; float* out; unsigned char* ws; int mask; int sync; };
#ifndef MK_MULTI
#define MK_MULTI 0
#endif
#ifndef MK_MASK
#define MK_MASK 0x7f
#endif
__global__ void __launch_bounds__(NTHR, 2) fwd_kernel(Args a) {
    extern __shared__ __attribute__((aligned(16))) unsigned char lds_[];
    LAS unsigned char* lds = (LAS unsigned char*)lds_;
    cg::grid_group grid = cg::this_grid();
    const int tid = threadIdx.x;
    Ptrs P;
    P.x = a.in[0]; P.norm_w = a.in[1]; P.w_in = a.in[2]; P.mu = a.in[3]; P.w0 = a.in[4]; P.w_up = a.in[5]; P.a0 = a.in[6]; P.a_up = a.in[7];
    P.k_k = a.in[8]; P.k_a = a.in[9]; P.r_k = a.in[10]; P.ln_w = a.in[11]; P.ln_b = a.in[12]; P.w_out = a.in[13]; P.fin_w = a.in[14];
    P.out = a.out; unsigned char* ws = a.ws;
    P.part = (float*)(ws + WS_PART); P.lse = (float*)(ws + WS_LSE);
    P.wtin = (bf16*)(ws + WS_WTIN); P.wtout = (bf16*)(ws + WS_WTOUT); P.wupT = (bf16*)(ws + WS_WUPT); P.aupT = (bf16*)(ws + WS_AUPT);
    P.mix = (bf16*)(ws + WS_MIX); P.P = (bf16*)(ws + WS_P); P.xb = (bf16*)(ws + WS_XB);
    P.o1 = (bf16*)a.out; P.o2 = (bf16*)a.out + (size_t)MTOK * DM; P.o3 = (bf16*)(ws + WS_XB);
    const int mask = a.mask;
#define SEAM() do { if (a.sync) grid.sync(); } while (0)
    if (mask & 1) p0_prologue(lds, P, tid, (mask & 0x80) != 0);
    SEAM();
    if (mask & 2) {
        pg8::Gemm g{P.xb, P.wtin, MTOK, PA, DM}; pg8::StaticOrder S; S.init(MTOK, PA, gridDim.x, (int)blockIdx.x);
        pg8::EpiBf16<0> E{P.P, PA, nullptr, 0, 0, 1.f};
        pg8::gemm_phase<pg8::EpiBf16<0>, pg8::StaticOrder, true, true>(lds, g, S, E);
    }
    SEAM();
    if (mask & 4) rwkv_phase(lds, P, tid);
    SEAM();
    if (mask & 8) {
        pg8::Gemm g{P.xb, P.wtin + (size_t)PA * DM, MTOK, PB, DM}; pg8::StaticOrder S; S.init(MTOK, PB, gridDim.x, (int)blockIdx.x);
        pg8::EpiBf16<0> E{P.P, PB, nullptr, 0, 0, 1.f};
        pg8::gemm_phase<pg8::EpiBf16<0>, pg8::StaticOrder, true, true>(lds, g, S, E);
    }
    SEAM();
    if (mask & 16) attn_phase(lds, P, tid);
    SEAM();
    if (mask & 32) {
        pg8::Gemm g{P.mix, P.wtout, MTOK, DM, MIXW}; pg8::StaticOrder S; S.init(MTOK, DM, gridDim.x, (int)blockIdx.x);
        pg8::EpiResF32 E{P.x, P.out, P.part, DM};
        pg8::gemm_phase<pg8::EpiResF32, pg8::StaticOrder, true, true>(lds, g, S, E);
    }
    SEAM();
    if (mask & 64) final_norm(P, tid);
}

extern "C" void kernel_launch(void* const* d_in, const int* in_sizes, int n_in, void* d_out, int out_size, void* d_ws, size_t ws_size, hipStream_t stream) {
    static int grid = 0;
    if (grid == 0) {
        if (n_in != 15 || in_sizes[0] != MTOK * DM || out_size != MTOK * DM || ws_size < WS_END) {
            fprintf(stderr, "kernel_launch: unexpected shapes / workspace (n_in %d, ws %zu, need %zu); nothing launched\n", n_in, ws_size, (size_t)WS_END); grid = -1; return; }
        int dev = 0, cus = 0, per_cu = 0;
        if (hipGetDevice(&dev) != hipSuccess || hipDeviceGetAttribute(&cus, hipDeviceAttributeMultiprocessorCount, dev) != hipSuccess) { grid = -1; return; }
        if (hipFuncSetAttribute((const void*)fwd_kernel, hipFuncAttributeMaxDynamicSharedMemorySize, LDS_BYTES) != hipSuccess) { fprintf(stderr, "kernel_launch: hipFuncSetAttribute failed\n"); grid = -1; return; }
        if (hipOccupancyMaxActiveBlocksPerMultiprocessor(&per_cu, (const void*)fwd_kernel, NTHR, LDS_BYTES) != hipSuccess || per_cu < 1) { fprintf(stderr, "kernel_launch: occupancy query says %d blocks per CU\n", per_cu); grid = -1; return; }
        grid = cus;
    }
    if (grid < 0) return;
    Args a{};
    for (int i = 0; i < 15; ++i) a.in[i] = (const float*)d_in[i];
    a.out = (float*)d_out; a.ws = (unsigned char*)d_ws;
#if MK_MULTI
    for (int ph = 0; ph < 7; ++ph) {
        a.mask = (1 << ph) & (MK_MASK); if (ph == 0) a.mask |= (MK_MASK & 0x80); a.sync = 0;
        if (!(a.mask & 0x7f)) continue;
        hipLaunchKernelGGL(fwd_kernel, dim3(grid), dim3(NTHR), LDS_BYTES, stream, a);
    }
#else
    a.mask = MK_MASK; a.sync = 1;
    void* args[] = {&a};
    hipError_t e = hipLaunchCooperativeKernel((void*)fwd_kernel, dim3(grid), dim3(NTHR), args, LDS_BYTES, stream);
    if (e != hipSuccess) fprintf(stderr, "cooperative launch failed: %s (grid %d)\n", hipGetErrorString(e), grid);
#endif
}
```

```cpp
#include <hip/hip_runtime.h>
#include <hip/hip_cooperative_groups.h>
#include <cstdio>
#include <cstdint>
namespace cg = cooperative_groups;
#define MK_MULTI 0
#define MK_MASK 0x7f
#define MK_REP 0
namespace pg8 {
#define PG8_LAS __attribute__((address_space(3)))
typedef unsigned short bf16_t;
typedef short bf16x8 __attribute__((ext_vector_type(8)));
typedef float f32x4 __attribute__((ext_vector_type(4)));
typedef unsigned u32x4 __attribute__((ext_vector_type(4)));
constexpr int BM = 256, BK = 64, HALF = 128, HTB = HALF * BK * 2  , STAGE_BYTES = 8 * HTB, NXCD = 8, WGM = 8;

__host__ __device__ __forceinline__ int lds_byte(int r, int c) { const int st = (r >> 4) * 2 + (c >> 5), rr = r & 15, cc = c & 31, ob = rr * 64 + cc * 2; return st * 1024 + (ob ^ (((ob >> 9) & 1) << 5)); }
__host__ __device__ __forceinline__ void stage_rc(int b, int& R, int& C) { const int st = b / 1024, sb = b % 1024, swz = sb ^ (((sb >> 9) & 1) << 5); R = (st >> 1) * 16 + swz / 64; C = (st & 1) * 32 + (swz % 64) / 2; }
__host__ __device__ __forceinline__ int perm32(int rho) { const int n = rho >> 4, i = rho & 15; return 8 * (i >> 2) + 4 * n + (i & 3); }

struct Unit { int pm, pn; };
struct Gemm { const bf16_t* A; const bf16_t* Bt; int M, N, K; };

struct StaticOrder {
    int nM, nN, nwg, G, c;
    __host__ __device__ void init(int M, int N, int G_, int c_) { nM = M / BM; nN = N / BM; nwg = nM * nN; G = G_; c = c_; }
    __host__ __device__ bool next(int i, Unit& u) const {
        const long L = (long)i * G + c; if (L >= nwg) return false;
        int wgid = (int)L; { const int q = nwg / NXCD, r = nwg % NXCD, xcd = wgid % NXCD, off = wgid / NXCD; wgid = (xcd < r ? xcd * (q + 1) : r * (q + 1) + (xcd - r) * q) + off; }
        const int nig = WGM * nN, gid = wgid / nig, fm = gid * WGM, gsz = (nM - fm) < WGM ? (nM - fm) : WGM;
        u.pm = fm + ((wgid % nig) % gsz); u.pn = (wgid % nig) / gsz; return true;
    }
    __device__ __forceinline__ void a_ready(const Unit&) const {}
    __device__ __forceinline__ void done(const Unit&) const {}
};

__device__ __forceinline__ unsigned cvt_pk_bf16(float lo, float hi) { unsigned r; asm volatile("v_cvt_pk_bf16_f32 %0, %1, %2" : "=v"(r) : "v"(lo), "v"(hi)); return r; }
typedef float f32x2 __attribute__((ext_vector_type(2)));
__device__ __forceinline__ f32x2 gelu_pk(f32x2 v) {
    const f32x2 av = __builtin_elementwise_abs(v), d = av * 0.2316418882f + 1.0f;
    f32x2 t; t.x = __builtin_amdgcn_rcpf(d.x); t.y = __builtin_amdgcn_rcpf(d.y);
    f32x2 q = t * 0.5307027145f + (-0.7265760135f); q = q * t + 0.7107068705f; q = q * t + (-0.142248368f); q = q * t + 0.127414796f; q = q * t;
    const f32x2 s = (v * v) * (-0.72134752044f);
    f32x2 e; e.x = __builtin_amdgcn_exp2f(s.x); e.y = __builtin_amdgcn_exp2f(s.y);
    const f32x2 m = v * (q * e), r = v - m;
    f32x2 o; o.x = v.x < 0.f ? m.x : r.x; o.y = v.y < 0.f ? m.y : r.y; return o;
}

template <int ACT  > struct EpiBf16 {
    static constexpr bool PERM = true, AFTER_DRAIN = false; static_assert(ACT == 0 || ACT == 1, "EpiBf16: ACT is 0 (none) or 1 (gelu_pk)");
    bf16_t* O; int ldc; const float* bias; int split_cols; size_t split_stride; float scale0;
    __device__ __forceinline__ void operator()(const f32x4 (&acc)[2][2][4][2], const Unit& u, int wr, int wc, int fr, int fq) const {
        const int row0 = u.pm * BM + wr * 64 + fr; int colt = u.pn * BM; bf16_t* base = O;
        float sc = 1.f; if (split_cols) { const int t = colt / split_cols; base += (size_t)t * split_stride; colt -= t * split_cols; if (t == 0) sc = scale0; }
        const int col0 = colt + wc * 32 + 8 * fq, bcol0 = u.pn * BM + wc * 32 + 8 * fq;
        f32x4 bv[2][2];
#pragma unroll
        for (int bj = 0; bj < 2; ++bj)
#pragma unroll
            for (int n = 0; n < 2; ++n) bv[bj][n] = bias ? *(const f32x4*)(bias + bcol0 + bj * HALF + 4 * n) : (f32x4){0.f, 0.f, 0.f, 0.f};
#pragma unroll
        for (int ai = 0; ai < 2; ++ai)
#pragma unroll
            for (int m = 0; m < 4; ++m) { bf16_t* rowp = base + (size_t)(row0 + ai * HALF + m * 16) * ldc + col0;
#pragma unroll
                for (int bj = 0; bj < 2; ++bj) { f32x4 v0 = acc[ai][bj][m][0] + bv[bj][0], v1 = acc[ai][bj][m][1] + bv[bj][1];
                    if (ACT == 1) { f32x2 a = gelu_pk((f32x2){v0[0], v0[1]}), b = gelu_pk((f32x2){v0[2], v0[3]}), c = gelu_pk((f32x2){v1[0], v1[1]}), d = gelu_pk((f32x2){v1[2], v1[3]});
                        v0 = (f32x4){a.x, a.y, b.x, b.y}; v1 = (f32x4){c.x, c.y, d.x, d.y}; }
                    v0 = v0 * sc; v1 = v1 * sc; u32x4 w; w.x = cvt_pk_bf16(v0[0], v0[1]); w.y = cvt_pk_bf16(v0[2], v0[3]); w.z = cvt_pk_bf16(v1[0], v1[1]); w.w = cvt_pk_bf16(v1[2], v1[3]);
                    *(u32x4*)(rowp + bj * HALF) = w; } }
    }
};
struct EpiResF32 {
    static constexpr bool PERM = false, AFTER_DRAIN = false;
    const float* base; float* out; float* part; int ldc;
    __device__ __forceinline__ void operator()(const f32x4 (&acc)[2][2][4][2], const Unit& u, int wr, int wc, int fr, int fq) const {
        const int col0 = u.pn * BM + wc * 32 + 4 * fq;
#pragma unroll
        for (int ai = 0; ai < 2; ++ai)
#pragma unroll
            for (int m = 0; m < 4; ++m) {
                const int row = u.pm * BM + ai * HALF + wr * 64 + m * 16 + fr;
                const size_t off = (size_t)row * ldc + col0;
                float ss = 0.f;
#pragma unroll
                for (int bj = 0; bj < 2; ++bj)
#pragma unroll
                    for (int n = 0; n < 2; ++n) {
                        const f32x4 b = *(const f32x4*)(base + off + bj * HALF + n * 16);
                        const f32x4 h = b + acc[ai][bj][m][n];
                        *(f32x4*)(out + off + bj * HALF + n * 16) = h;
                        ss += (h[0] * h[0] + h[1] * h[1]) + (h[2] * h[2] + h[3] * h[3]);
                    }
                ss += __shfl_xor(ss, 16); ss += __shfl_xor(ss, 32);
                if (fq == 0) part[(size_t)row * 16 + u.pn * 4 + wc] = ss;
            }
    }
};
template <int MODE> struct EpiHM {
    static constexpr bool PERM = true, AFTER_DRAIN = false;
    static constexpr size_t SEC = (size_t)256 * 2048 * 64;
    bf16_t* O;
    __device__ __forceinline__ void operator()(const f32x4 (&acc)[2][2][4][2], const Unit& u, int wr, int wc, int fr, int fq) const {
        const int row0 = u.pm * BM + wr * 64 + fr;
        const size_t bterm = (size_t)(row0 >> 11) * (16 * 2048 * 64);
#pragma unroll
        for (int bj = 0; bj < 2; ++bj) {
            const int c0 = u.pn * BM + bj * HALF + wc * 32 + 8 * fq;
            bf16_t* base; bool hm = true, skip = false;
            if (MODE == 0 || c0 < 3072) { base = O + (size_t)(c0 >> 10) * SEC + (size_t)((c0 >> 6) & 15) * (2048 * 64) + (c0 & 63); }
            else if (c0 < 3200) { base = O + 4 * SEC + (c0 - 3072); hm = false; }
            else if (c0 < 4224) { const int c1 = c0 - 3200; base = O + 3 * SEC + (size_t)(c1 >> 6) * (2048 * 64) + (c1 & 63); }
            else { base = O; skip = true; }
            if (skip) continue;
#pragma unroll
            for (int ai = 0; ai < 2; ++ai)
#pragma unroll
                for (int m = 0; m < 4; ++m) {
                    const int row = row0 + ai * HALF + m * 16;
                    bf16_t* p = hm ? base + bterm + (size_t)(row & 2047) * 64 : base + (size_t)row * 128;
                    const f32x4 v0 = acc[ai][bj][m][0], v1 = acc[ai][bj][m][1];
                    u32x4 w; w.x = cvt_pk_bf16(v0[0], v0[1]); w.y = cvt_pk_bf16(v0[2], v0[3]); w.z = cvt_pk_bf16(v1[0], v1[1]); w.w = cvt_pk_bf16(v1[2], v1[3]);
                    *(u32x4*)p = w;
                }
        }
    }
};
template <class Epi, class Sched, bool ALIGN_EPI = false, bool SP2 = false>
__device__ __forceinline__ void gemm_phase(PG8_LAS unsigned char* lds, const Gemm g, const Sched& S, const Epi& E) {
    const int tid = threadIdx.x, wid = __builtin_amdgcn_readfirstlane(tid >> 6), lane = tid & 63, wr = wid >> 2, wc = wid & 3, fr = lane & 15, fq = lane >> 4;
    const int K = g.K, nt = K / BK;
    unsigned voffA[2], voffB[2];
#pragma unroll
    for (int i = 0; i < 2; ++i) { int R, C; stage_rc(tid * 16 + i * 8192, R, C); const int Rb = Epi::PERM ? ((R & ~31) + perm32(R & 31)) : R;
        voffA[i] = (unsigned)(R * K + C) * 2u; voffB[i] = (unsigned)(Rb * K + C) * 2u; }
    const size_t kstep = (size_t)(BK * 2);
    const size_t hstep = (size_t)HALF * K * 2;
    const size_t tstep = 2 * hstep;
    const unsigned ldsw = (unsigned)wid * 1024u;
    const int aoff = lds_byte(wr * 64 + fr, fq * 8), boff = lds_byte(wc * 32 + fr, fq * 8);
#define PG8_SA(b, h) (((b) * 2 + (h)) * HTB)
#define PG8_SB(b, h) ((4 + (b) * 2 + (h)) * HTB)
#define PG8_STAGE(bufoff, gbase, voff) do { _Pragma("unroll") for (int _i = 0; _i < 2; ++_i) \
        __builtin_amdgcn_global_load_lds((const unsigned*)((const char*)(gbase) + (voff)[_i]), (PG8_LAS unsigned*)(lds + (bufoff) + ldsw + _i * 8192), 16, 0, 0); } while (0)
#define PG8_LDA(dst, b, h) do { _Pragma("unroll") for (int m = 0; m < 4; ++m) _Pragma("unroll") for (int k = 0; k < 2; ++k) dst[m][k] = *(const PG8_LAS bf16x8*)(lds + PG8_SA(b, h) + aoff + m * 2048 + k * 1024); } while (0)
#define PG8_LDB(dst, b, h) do { _Pragma("unroll") for (int n = 0; n < 2; ++n) _Pragma("unroll") for (int k = 0; k < 2; ++k) dst[n][k] = *(const PG8_LAS bf16x8*)(lds + PG8_SB(b, h) + boff + n * 2048 + k * 1024); } while (0)
#define PG8_MMA(ai, bj, At, Bt) do { __builtin_amdgcn_s_setprio(1); _Pragma("unroll") for (int m = 0; m < 4; ++m) _Pragma("unroll") for (int n = 0; n < 2; ++n) _Pragma("unroll") for (int k = 0; k < 2; ++k) \
        acc[ai][bj][m][n] = __builtin_amdgcn_mfma_f32_16x16x32_bf16(Bt[n][k], At[m][k], acc[ai][bj][m][n], 0, 0, 0); __builtin_amdgcn_s_setprio(0); } while (0)
#define PG8_WAIT_V(n) asm volatile("s_waitcnt vmcnt(" #n ")" ::: "memory")
#define PG8_WAIT_L(n) asm volatile("s_waitcnt lgkmcnt(" #n ")" ::: "memory")
#define PG8_BAR __builtin_amdgcn_s_barrier()
#define PG8_SCHED __builtin_amdgcn_sched_barrier(0)
    Unit cur, nxt; int ui = 0;
    if (!S.next(0, cur)) return;
    f32x4 acc[2][2][4][2];
#pragma unroll
    for (int a = 0; a < 2; ++a)
#pragma unroll
        for (int b = 0; b < 2; ++b)
#pragma unroll
            for (int m = 0; m < 4; ++m)
#pragma unroll
                for (int n = 0; n < 2; ++n) acc[a][b][m][n] = (f32x4){0.f, 0.f, 0.f, 0.f};
    bf16x8 At[4][2], B0[2][2], B1[2][2];
    const char* cA = (const char*)g.A + (size_t)cur.pm * tstep; const char* cB = (const char*)g.Bt + (size_t)cur.pn * tstep;
    S.a_ready(cur);
    if constexpr (SP2) {
        PG8_STAGE(PG8_SB(0, 0), cB, voffB); PG8_STAGE(PG8_SB(0, 1), cB + hstep, voffB); PG8_STAGE(PG8_SA(0, 0), cA, voffA); PG8_STAGE(PG8_SA(0, 1), cA + hstep, voffA);
        if (wr == 1) PG8_BAR;
        PG8_WAIT_V(2); PG8_BAR;
        PG8_STAGE(PG8_SB(1, 0), cB + kstep, voffB); PG8_STAGE(PG8_SA(1, 0), cA + kstep, voffA); PG8_STAGE(PG8_SB(1, 1), cB + hstep + kstep, voffB);
        PG8_WAIT_V(6); PG8_BAR;
    } else {
        PG8_STAGE(PG8_SB(0, 0), cB, voffB); PG8_STAGE(PG8_SA(0, 0), cA, voffA); PG8_STAGE(PG8_SB(0, 1), cB + hstep, voffB); PG8_STAGE(PG8_SA(0, 1), cA + hstep, voffA);
        if (wr == 1) PG8_BAR;
        PG8_WAIT_V(4); PG8_BAR;
        PG8_STAGE(PG8_SB(1, 0), cB + kstep, voffB); PG8_STAGE(PG8_SA(1, 0), cA + kstep, voffA); PG8_STAGE(PG8_SB(1, 1), cB + hstep + kstep, voffB);
        PG8_WAIT_V(6); PG8_BAR;
    }
    for (;;) {
        const bool has_next = S.next(ui + 1, nxt);
        const char* nA = has_next ? (const char*)g.A + (size_t)nxt.pm * tstep : cA; const char* nB = has_next ? (const char*)g.Bt + (size_t)nxt.pn * tstep : cB;
        for (int t = 0; t < nt; t += 2) {
            const bool last = (t == nt - 2);
            const char* a1 = cA + (size_t)(t + 1) * kstep;
            const char* a2 = last ? nA : cA + (size_t)(t + 2) * kstep; const char* b2 = last ? nB : cB + (size_t)(t + 2) * kstep;
            const char* a3 = a2 + kstep; const char* b3 = b2 + kstep;
            if (last && has_next) S.a_ready(nxt);
            if constexpr (SP2) {
            PG8_LDB(B0, 0, 0); PG8_LDB(B1, 0, 1); PG8_SCHED; PG8_LDA(At, 0, 0); PG8_STAGE(PG8_SA(1, 1), a1 + hstep, voffA);
            PG8_WAIT_V(8); PG8_WAIT_L(0); PG8_BAR; PG8_MMA(0, 0, At, B0); PG8_MMA(0, 1, At, B1); PG8_BAR; PG8_SCHED;
            PG8_LDA(At, 0, 1); PG8_STAGE(PG8_SB(0, 0), b2, voffB); PG8_STAGE(PG8_SB(0, 1), b2 + hstep, voffB); PG8_STAGE(PG8_SA(0, 0), a2, voffA);
            PG8_WAIT_V(8); PG8_WAIT_L(0); PG8_BAR; PG8_MMA(1, 0, At, B0); PG8_MMA(1, 1, At, B1); PG8_BAR; PG8_SCHED;
            PG8_LDB(B0, 1, 0); PG8_LDB(B1, 1, 1); PG8_SCHED; PG8_LDA(At, 1, 0); PG8_STAGE(PG8_SA(0, 1), a2 + hstep, voffA);
            PG8_WAIT_V(8); PG8_WAIT_L(0); PG8_BAR; PG8_MMA(0, 0, At, B0); PG8_MMA(0, 1, At, B1); PG8_BAR; PG8_SCHED;
            PG8_LDA(At, 1, 1); PG8_STAGE(PG8_SB(1, 0), b3, voffB); PG8_STAGE(PG8_SB(1, 1), b3 + hstep, voffB); PG8_STAGE(PG8_SA(1, 0), a3, voffA);
            PG8_WAIT_V(8); PG8_WAIT_L(0); PG8_BAR; PG8_MMA(1, 0, At, B0); PG8_MMA(1, 1, At, B1); PG8_BAR; PG8_SCHED;
            } else {
            PG8_LDB(B0, 0, 0); PG8_SCHED; PG8_LDA(At, 0, 0); PG8_STAGE(PG8_SA(1, 1), a1 + hstep, voffA);
            PG8_WAIT_L(8); PG8_BAR; PG8_WAIT_L(0); PG8_MMA(0, 0, At, B0); PG8_BAR; PG8_SCHED;
            PG8_LDB(B1, 0, 1); PG8_STAGE(PG8_SB(0, 0), b2, voffB);
            PG8_BAR; PG8_WAIT_L(0); PG8_MMA(0, 1, At, B1); PG8_BAR;
            PG8_LDA(At, 0, 1); PG8_STAGE(PG8_SA(0, 0), a2, voffA);
            PG8_BAR; PG8_WAIT_L(0); PG8_MMA(1, 0, At, B0); PG8_BAR; PG8_SCHED;
            PG8_STAGE(PG8_SB(0, 1), b2 + hstep, voffB);
            PG8_WAIT_V(6); PG8_BAR; PG8_MMA(1, 1, At, B1); PG8_BAR;
            PG8_LDB(B0, 1, 0); PG8_SCHED; PG8_LDA(At, 1, 0); PG8_STAGE(PG8_SA(0, 1), a2 + hstep, voffA);
            PG8_WAIT_L(8); PG8_BAR; PG8_WAIT_L(0); PG8_MMA(0, 0, At, B0); PG8_BAR; PG8_SCHED;
            PG8_LDB(B1, 1, 1); PG8_STAGE(PG8_SB(1, 0), b3, voffB);
            PG8_BAR; PG8_WAIT_L(0); PG8_MMA(0, 1, At, B1); PG8_BAR;
            PG8_LDA(At, 1, 1); PG8_STAGE(PG8_SA(1, 0), a3, voffA);
            PG8_BAR; PG8_WAIT_L(0); PG8_MMA(1, 0, At, B0); PG8_BAR; PG8_SCHED;
            PG8_STAGE(PG8_SB(1, 1), b3 + hstep, voffB);
            PG8_WAIT_V(6); PG8_BAR; PG8_MMA(1, 1, At, B1); PG8_BAR;
            }
        }
        if constexpr (ALIGN_EPI) { if (wr == 0) PG8_BAR; }
        if constexpr (!Epi::AFTER_DRAIN) { E(acc, cur, wr, wc, fr, fq); S.done(cur); }
        if (!has_next) break;
#pragma unroll
        for (int a = 0; a < 2; ++a)
#pragma unroll
            for (int b = 0; b < 2; ++b)
#pragma unroll
                for (int m = 0; m < 4; ++m)
#pragma unroll
                    for (int n = 0; n < 2; ++n) acc[a][b][m][n] = (f32x4){0.f, 0.f, 0.f, 0.f};
        cur = nxt; cA = nA; cB = nB; ++ui;
        if constexpr (ALIGN_EPI) { if (wr == 1) PG8_BAR; }
    }
    PG8_WAIT_V(0);
    if constexpr (!ALIGN_EPI) { if (wr == 0) PG8_BAR; }
    PG8_BAR;
    if constexpr (Epi::AFTER_DRAIN) { E.fused(acc, cur, wr, wc, fr, fq, lds, wid, lane); S.done(cur); }
#undef PG8_SA
#undef PG8_SB
#undef PG8_STAGE
#undef PG8_LDA
#undef PG8_LDB
#undef PG8_MMA
#undef PG8_WAIT_V
#undef PG8_WAIT_L
#undef PG8_BAR
#undef PG8_SCHED
}
}

#define LAS __attribute__((address_space(3)))
typedef unsigned short bf16;
typedef unsigned u32x4 __attribute__((ext_vector_type(4)));
typedef unsigned u32x2 __attribute__((ext_vector_type(2)));
typedef float f32x4 __attribute__((ext_vector_type(4)));
typedef short bf16x8 __attribute__((ext_vector_type(8)));
typedef float f32x2 __attribute__((ext_vector_type(2)));
constexpr int DM = 1024, NBATCH = 16, SEQ = 2048, MTOK = NBATCH * SEQ, NH = 16;
constexpr int N_IN = 8320, RW_COLS = 4224, PA = 4352, PB = 4096, MIXW = 2048;
constexpr float RMS_EPS = 1e-5f, GN_EPS = 64e-5f;
constexpr size_t MiB = 1u << 20;
constexpr size_t WS_PART = 1 * MiB, WS_WTIN = 3 * MiB, WS_WTOUT = 20 * MiB, WS_WUPT = 24 * MiB, WS_AUPT = 24 * MiB + 256 * 1024, WS_LSE = 25 * MiB,
                 WS_MIX = 32 * MiB, WS_P = 160 * MiB, WS_XB = 432 * MiB, WS_END = 496 * MiB;
constexpr int LDS_BYTES = 147456;
constexpr int NWAVES = 8, NTHR = 512;

struct Ptrs {
    const float *x, *norm_w, *w_in, *mu, *w0, *w_up, *a0, *a_up, *k_k, *k_a, *r_k, *ln_w, *ln_b, *w_out, *fin_w;
    float* out; float* part; float* lse;
    bf16 *wtin, *wtout, *wupT, *aupT, *mix, *P, *xb, *o1, *o2, *o3;
};

__device__ __forceinline__ unsigned f2bf(float f) { unsigned u = __builtin_bit_cast(unsigned, f); return (u + 0x7fffu + ((u >> 16) & 1u)) >> 16; }
__device__ __forceinline__ unsigned pk2(float lo, float hi) { return f2bf(lo) | (f2bf(hi) << 16); }
__device__ __forceinline__ float bflo(unsigned w) { return __builtin_bit_cast(float, w << 16); }
__device__ __forceinline__ float bfhi(unsigned w) { return __builtin_bit_cast(float, w & 0xffff0000u); }
__device__ __forceinline__ float wave_sum(float v) {
#pragma unroll
    for (int o = 1; o < 64; o <<= 1) v += __shfl_xor(v, o);
    return v;
}
__device__ __forceinline__ float silu(float g) { return g / (1.f + __expf(-g)); }

__device__ __forceinline__ void p0_transpose_item(const float* W, int K, int N, bf16* WT, int split, LAS float* scr, int item, int lane) {
    const int nblk = N / 32, kb = item / nblk, nb = item % nblk, k0 = 64 * kb, n0 = 32 * nb;
    const int row_off = (n0 >= split) ? 128 : 0;
#pragma unroll 8
    for (int i = 0; i < 32; ++i) { const int kk = 2 * i + (lane >> 5); scr[kk * 33 + (lane & 31)] = W[(size_t)(k0 + kk) * N + n0 + (lane & 31)]; }
    asm volatile("s_waitcnt lgkmcnt(0)" ::: "memory");
    const int c = lane & 7;
#pragma unroll
    for (int j = 0; j < 4; ++j) { const int n = (lane >> 3) + 8 * j; const LAS float* s = scr + (8 * c) * 33 + n;
        u32x4 o; o.x = pk2(s[0 * 33], s[1 * 33]); o.y = pk2(s[2 * 33], s[3 * 33]); o.z = pk2(s[4 * 33], s[5 * 33]); o.w = pk2(s[6 * 33], s[7 * 33]);
        *(u32x4*)(WT + (size_t)(row_off + n0 + n) * K + k0 + 8 * c) = o; }
    asm volatile("s_waitcnt lgkmcnt(0)" ::: "memory");
}
__device__ __forceinline__ void p0_prologue(LAS unsigned char* lds, const Ptrs& P, int tid, bool zero_mix) {
    const int wave = __builtin_amdgcn_readfirstlane(tid >> 6), lane = tid & 63;
    LAS float* scr = (LAS float*)(lds + wave * 16384);
    const int gw = blockIdx.x * NWAVES + wave, NGW = gridDim.x * NWAVES;
    constexpr int I_IN = (DM / 64) * (N_IN / 32), I_OUT = (MIXW / 64) * (DM / 32), I_UP = DM / 32;
    constexpr int NITEMS = I_IN + I_OUT + 2 * I_UP;
    for (int it = gw; it < NITEMS; it += NGW) {
        int r = it;
        if (r < I_IN) { p0_transpose_item(P.w_in, DM, N_IN, P.wtin, RW_COLS, scr, r, lane); continue; } r -= I_IN;
        if (r < I_OUT) { p0_transpose_item(P.w_out, MIXW, DM, P.wtout, 1 << 30, scr, r, lane); continue; } r -= I_OUT;
        if (r < I_UP) { p0_transpose_item(P.w_up, 64, DM, P.wupT, 1 << 30, scr, r, lane); continue; } r -= I_UP;
        p0_transpose_item(P.a_up, 64, DM, P.aupT, 1 << 30, scr, r, lane);
    }
    { const int gt = blockIdx.x * NTHR + tid, NGT = gridDim.x * NTHR; u32x4* z = (u32x4*)(P.wtin + (size_t)RW_COLS * DM);
      for (int i = gt; i < 128 * DM * 2 / 16; i += NGT) z[i] = (u32x4){0u, 0u, 0u, 0u};
      if (zero_mix) { u32x4* zm = (u32x4*)P.mix; for (size_t i = gt; i < (size_t)MTOK * MIXW * 2 / 16; i += NGT) zm[i] = (u32x4){0u, 0u, 0u, 0u}; } }
    for (int m = gw; m < MTOK; m += NGW) {
        const f32x4* xr = (const f32x4*)(P.x + (size_t)m * DM) + lane; const f32x4* wr = (const f32x4*)P.norm_w + lane;
        f32x4 v[4]; float s = 0.f;
#pragma unroll
        for (int j = 0; j < 4; ++j) { v[j] = xr[64 * j]; s += (v[j].x * v[j].x + v[j].y * v[j].y) + (v[j].z * v[j].z + v[j].w * v[j].w); }
        const float rstd = 1.f / sqrtf(wave_sum(s) * (1.f / DM) + RMS_EPS);
        unsigned long long* o8 = (unsigned long long*)(P.xb + (size_t)m * DM) + lane;
#pragma unroll
        for (int j = 0; j < 4; ++j) { const f32x4 w = wr[64 * j];
            o8[64 * j] = (unsigned long long)pk2(v[j].x * rstd * w.x, v[j].y * rstd * w.y) | ((unsigned long long)pk2(v[j].z * rstd * w.z, v[j].w * rstd * w.w) << 32); }
    }
}

namespace rw {
constexpr int T = 32, NCH = SEQ / T;
constexpr size_t SEC = (size_t)256 * 2048 * 64;
constexpr int O_DEC = 0, O_BV = 8192, O_K = 16384, O_R = 24576, O_AV = 32768, BUF = 40960;
constexpr int L_B = 0, L_V = 2 * BUF, L_Y = L_V + 3 * 8192, L_ST = L_Y + 2 * 8192, WLS = 144, ST_W = 16 * WLS, L_BON = L_ST + 4 * 2 * ST_W, L_END = L_BON + 3 * T * 4;
static_assert(L_END <= LDS_BYTES, "rwkv LDS");
template <int CTRL> __device__ __forceinline__ float dpp_add(float x) {
    const int y = __builtin_amdgcn_update_dpp(0, __builtin_bit_cast(int, x), CTRL, 0xf, 0xf, false);
    return x + __builtin_bit_cast(float, y);
}
__device__ __forceinline__ float allreduce16(float x) {
    x = dpp_add<0xB1>(x);
    x = dpp_add<0x4E>(x);
    x = dpp_add<0x141>(x);
    x = dpp_add<0x140>(x);
    return x;
}
__device__ __forceinline__ float allreduce8(float x) {
    x = dpp_add<0xB1>(x); x = dpp_add<0x4E>(x); x = dpp_add<0x141>(x);
    return x;
}
__device__ __forceinline__ void lerp8(const u32x4 cur, const u32x4 prv, const f32x4 m0, const f32x4 m1, float (&v)[8]) {
#pragma unroll
    for (int i = 0; i < 4; ++i) { const float cl = bflo(cur[i]), ch = bfhi(cur[i]), pl = bflo(prv[i]), ph = bfhi(prv[i]);
        const float ma = (i < 2) ? m0[2 * i] : m1[2 * i - 4], mb = (i < 2) ? m0[2 * i + 1] : m1[2 * i - 3];
        v[2 * i] = cl + (pl - cl) * ma; v[2 * i + 1] = ch + (ph - ch) * mb; }
}
}

__device__ __forceinline__ void rwkv_phase(LAS unsigned char* lds, const Ptrs& P, int tid) {
    using namespace rw;
    const int wv = __builtin_amdgcn_readfirstlane(tid >> 6), lane = tid & 63, fr = lane & 15, fq = lane >> 4;
    const bf16* Pb = P.P;
    const float* mu = P.mu; const float* g_w0 = P.w0; const float* g_a0 = P.a0; const float* g_kk = P.k_k; const float* g_ka = P.k_a; const float* g_rk = P.r_k;
    const float* g_lw = P.ln_w; const float* g_lb = P.ln_b; bf16* mix = P.mix;
    const int pw = wv & 3;
    const int ptt = lane >> 3, c8 = (lane & 7) * 8;
    const int trow = pw * 8 + ptt;
    LAS unsigned char* stw = lds + L_ST + pw * 2 * ST_W; LAS unsigned char* sta = stw + ST_W;
    for (int bh = blockIdx.x; bh < NBATCH * NH; bh += gridDim.x) {
        const int b = bh >> 4, h = bh & 15;
        const bf16* pR = Pb + (size_t)bh * 2048 * 64; const bf16* pK = pR + SEC; const bf16* pV = pR + 2 * SEC; const bf16* pG = pR + 3 * SEC;
        const bf16* pL = Pb + 4 * SEC + (size_t)b * 2048 * 128;
        bf16x8 bw[4][2], ba[4][2];
        if (wv >= 4) {
#pragma unroll
            for (int nt = 0; nt < 4; ++nt)
#pragma unroll
                for (int ks = 0; ks < 2; ++ks) { bw[nt][ks] = *(const bf16x8*)(P.wupT + (size_t)(h * 64 + nt * 16 + fr) * 64 + ks * 32 + fq * 8);
                                                 ba[nt][ks] = *(const bf16x8*)(P.aupT + (size_t)(h * 64 + nt * 16 + fr) * 64 + ks * 32 + fq * 8); }
        }
        f32x2 S2[4][2];
#pragma unroll
        for (int i = 0; i < 4; ++i) { S2[i][0] = (f32x2){0.f, 0.f}; S2[i][1] = (f32x2){0.f, 0.f}; }
        for (int c = -1; c <= NCH; ++c) {
            if (wv < 4) {
                if (c >= 0 && c < NCH) {
                    const int rg = lane >> 4, kg = lane & 15;
                    const LAS float* bb = (const LAS float*)(lds + L_B + (c & 1) * BUF) + kg * 4;
                    const LAS float* pv = (const LAS float*)(lds + L_V + (c % 3) * 8192) + wv * 16 + rg * 4;
                    LAS float* py = (LAS float*)(lds + L_Y + (c & 1) * 8192) + wv * 16 + rg * 4;
                    const bool hi8 = (kg & 8) != 0, hi4 = (kg & 4) != 0; const int yrow = ((kg >> 3) & 1) + 2 * ((kg >> 2) & 1);
                    f32x4 n_dec = *(const LAS f32x4*)(bb + O_DEC / 4), n_bv = *(const LAS f32x4*)(bb + O_BV / 4), n_kk = *(const LAS f32x4*)(bb + O_K / 4),
                          n_rr = *(const LAS f32x4*)(bb + O_R / 4), n_av = *(const LAS f32x4*)(bb + O_AV / 4), n_vv = *(const LAS f32x4*)pv;
#pragma unroll 2
                    for (int t = 0; t < T; ++t) {
                        const f32x4 dec = n_dec, bv = n_bv, kk = n_kk, rr = n_rr, av = n_av, vv = n_vv;
                        const int tn = (t + 1 < T) ? t + 1 : t;
                        n_dec = *(const LAS f32x4*)(bb + O_DEC / 4 + tn * 64); n_bv = *(const LAS f32x4*)(bb + O_BV / 4 + tn * 64); n_kk = *(const LAS f32x4*)(bb + O_K / 4 + tn * 64);
                        n_rr = *(const LAS f32x4*)(bb + O_R / 4 + tn * 64); n_av = *(const LAS f32x4*)(bb + O_AV / 4 + tn * 64); n_vv = *(const LAS f32x4*)(pv + tn * 64);
                        const f32x2 av01 = (f32x2){av[0], av[1]}, av23 = (f32x2){av[2], av[3]}, de01 = (f32x2){dec[0], dec[1]}, de23 = (f32x2){dec[2], dec[3]};
                        const f32x2 bv01 = (f32x2){bv[0], bv[1]}, bv23 = (f32x2){bv[2], bv[3]}, kk01 = (f32x2){kk[0], kk[1]}, kk23 = (f32x2){kk[2], kk[3]};
                        const f32x2 rr01 = (f32x2){rr[0], rr[1]}, rr23 = (f32x2){rr[2], rr[3]};
                        float sa[4];
#pragma unroll
                        for (int i = 0; i < 4; ++i) { const f32x2 q = S2[i][0] * av01 + S2[i][1] * av23; sa[i] = q.x + q.y; }
#pragma unroll
                        for (int i = 0; i < 4; ++i) sa[i] = allreduce16(sa[i]);
#pragma unroll
                        for (int i = 0; i < 4; ++i) {
                            const f32x2 s2 = (f32x2){sa[i], sa[i]}, v2 = (f32x2){vv[i], vv[i]};
                            S2[i][0] = S2[i][0] * de01 + s2 * bv01 + v2 * kk01;
                            S2[i][1] = S2[i][1] * de23 + s2 * bv23 + v2 * kk23;
                        }
                        float y[4];
#pragma unroll
                        for (int i = 0; i < 4; ++i) { const f32x2 q = S2[i][0] * rr01 + S2[i][1] * rr23; y[i] = q.x + q.y; }
                        const float e0 = dpp_add<0x128>(y[0]), e1 = dpp_add<0x128>(y[1]), e2 = dpp_add<0x128>(y[2]), e3 = dpp_add<0x128>(y[3]);
                        const float z01 = hi8 ? e1 : e0, z23 = hi8 ? e3 : e2;
                        const float g0 = dpp_add<0x141>(z01), g1 = dpp_add<0x141>(z23);
                        float w = hi4 ? g1 : g0;
                        w = dpp_add<0xB1>(w); w = dpp_add<0x4E>(w);
                        if ((kg & 3) == 0) py[t * 64 + yrow] = w;
                    }
                }
            } else {
                if (c >= 1) {
                    const int cp = c - 1, t = cp * T + trow, o = trow * 64 + c8;
                    const LAS float* aY = (const LAS float*)(lds + L_Y + (cp & 1) * 8192); const LAS float* aV = (const LAS float*)(lds + L_V + (cp % 3) * 8192);
                    const u32x4 g = *(const u32x4*)(pG + (size_t)t * 64 + c8);
                    const f32x4 lw0 = *(const f32x4*)(g_lw + h * 64 + c8), lw1 = *(const f32x4*)(g_lw + h * 64 + c8 + 4);
                    const f32x4 lb0 = *(const f32x4*)(g_lb + h * 64 + c8), lb1 = *(const f32x4*)(g_lb + h * 64 + c8 + 4);
                    const f32x4 y0 = *(const LAS f32x4*)(aY + o), y1 = *(const LAS f32x4*)(aY + o + 4), v0 = *(const LAS f32x4*)(aV + o), v1 = *(const LAS f32x4*)(aV + o + 4);
                    const float bon = ((const LAS float*)(lds + L_BON))[(cp % 3) * T + trow];
                    const float s = allreduce8((y0.x + y0.y) + (y0.z + y0.w) + (y1.x + y1.y) + (y1.z + y1.w));
                    const float mean = s * (1.f / 64.f);
                    const f32x4 d0 = y0 - mean, d1 = y1 - mean;
                    const float q = allreduce8((d0.x * d0.x + d0.y * d0.y) + (d0.z * d0.z + d0.w * d0.w) + (d1.x * d1.x + d1.y * d1.y) + (d1.z * d1.z + d1.w * d1.w));
                    const float rstd = 1.f / sqrtf(q * (1.f / 64.f) + GN_EPS);
                    const f32x4 e0 = d0 * rstd * lw0 + lb0 + bon * v0, e1 = d1 * rstd * lw1 + lb1 + bon * v1;
                    u32x4 ov;
                    ov.x = pk2(e0.x * silu(bflo(g.x)), e0.y * silu(bfhi(g.x))); ov.y = pk2(e0.z * silu(bflo(g.y)), e0.w * silu(bfhi(g.y)));
                    ov.z = pk2(e1.x * silu(bflo(g.z)), e1.y * silu(bfhi(g.z))); ov.w = pk2(e1.z * silu(bflo(g.w)), e1.w * silu(bfhi(g.w)));
                    *(u32x4*)(mix + ((size_t)b * SEQ + t) * MIXW + h * 64 + c8) = ov;
                }
                if (c + 1 < NCH) {
                    const int cn = c + 1, t = cn * T + trow, o = trow * 64 + c8;
                    LAS float* B = (LAS float*)(lds + L_B + (cn & 1) * BUF);
                    LAS float* aV = (LAS float*)(lds + L_V + (cn % 3) * 8192);
                    const bf16* sR = pR + (size_t)t * 64 + c8; const bf16* sK = pK + (size_t)t * 64 + c8; const bf16* sV = pV + (size_t)t * 64 + c8;
                    const bf16* sW = pL + (size_t)t * 128 + c8; const bf16* sA = sW + 64;
                    const u32x4 zz = (u32x4){0u, 0u, 0u, 0u};
                    const u32x4 cR = *(const u32x4*)sR, cK = *(const u32x4*)sK, cV = *(const u32x4*)sV, cW = *(const u32x4*)sW, cA = *(const u32x4*)sA;
                    u32x4 qR = zz, qK = zz, qV = zz, qW = zz, qA = zz;
                    if (t > 0) { qR = *(const u32x4*)(sR - 64); qK = *(const u32x4*)(sK - 64); qV = *(const u32x4*)(sV - 64); qW = *(const u32x4*)(sW - 128); qA = *(const u32x4*)(sA - 128); }
                    const int hc = h * 64 + c8;
                    float v[8];
                    lerp8(cR, qR, *(const f32x4*)(mu + hc), *(const f32x4*)(mu + hc + 4), v);
                    *(LAS f32x4*)(B + O_R / 4 + o) = (f32x4){v[0], v[1], v[2], v[3]}; *(LAS f32x4*)(B + O_R / 4 + o + 4) = (f32x4){v[4], v[5], v[6], v[7]};
                    const f32x4 r0 = (f32x4){v[0], v[1], v[2], v[3]}, r1 = (f32x4){v[4], v[5], v[6], v[7]};
                    lerp8(cV, qV, *(const f32x4*)(mu + 2048 + hc), *(const f32x4*)(mu + 2048 + hc + 4), v);
                    *(LAS f32x4*)(aV + o) = (f32x4){v[0], v[1], v[2], v[3]}; *(LAS f32x4*)(aV + o + 4) = (f32x4){v[4], v[5], v[6], v[7]};
                    lerp8(cW, qW, *(const f32x4*)(mu + 3072 + c8), *(const f32x4*)(mu + 3072 + c8 + 4), v);
#pragma unroll
                    for (int i = 0; i < 8; ++i) v[i] = 1.f - 2.f / (1.f + __expf(2.f * v[i]));
                    { u32x4 ow; ow.x = pk2(v[0], v[1]); ow.y = pk2(v[2], v[3]); ow.z = pk2(v[4], v[5]); ow.w = pk2(v[6], v[7]); *(LAS u32x4*)(stw + ptt * WLS + c8 * 2) = ow; }
                    lerp8(cA, qA, *(const f32x4*)(mu + 3136 + c8), *(const f32x4*)(mu + 3136 + c8 + 4), v);
                    { u32x4 ow; ow.x = pk2(v[0], v[1]); ow.y = pk2(v[2], v[3]); ow.z = pk2(v[4], v[5]); ow.w = pk2(v[6], v[7]); *(LAS u32x4*)(sta + ptt * WLS + c8 * 2) = ow; }
                    lerp8(cK, qK, *(const f32x4*)(mu + 1024 + hc), *(const f32x4*)(mu + 1024 + hc + 4), v);
                    const f32x4 k0 = (f32x4){v[0], v[1], v[2], v[3]}, k1 = (f32x4){v[4], v[5], v[6], v[7]};
                    {
                        bf16x8 aw[2], aa[2];
#pragma unroll
                        for (int ks = 0; ks < 2; ++ks) { aw[ks] = *(const LAS bf16x8*)(stw + fr * WLS + (ks * 32 + fq * 8) * 2); aa[ks] = *(const LAS bf16x8*)(sta + fr * WLS + (ks * 32 + fq * 8) * 2); }
#pragma unroll
                        for (int nt = 0; nt < 4; ++nt) {
                            f32x4 accw = (f32x4){0.f, 0.f, 0.f, 0.f}, acca = (f32x4){0.f, 0.f, 0.f, 0.f};
#pragma unroll
                            for (int ks = 0; ks < 2; ++ks) { accw = __builtin_amdgcn_mfma_f32_16x16x32_bf16(aw[ks], bw[nt][ks], accw, 0, 0, 0);
                                                             acca = __builtin_amdgcn_mfma_f32_16x16x32_bf16(aa[ks], ba[nt][ks], acca, 0, 0, 0); }
                            if (fq < 2) {
#pragma unroll
                                for (int j = 0; j < 4; ++j) { const int oo = (pw * 8 + fq * 4 + j) * 64 + nt * 16 + fr; B[O_DEC / 4 + oo] = accw[j]; B[O_BV / 4 + oo] = acca[j]; }
                            }
                        }
                    }
                    {
                        const f32x4 wr0 = *(const LAS f32x4*)(B + O_DEC / 4 + o), wr1 = *(const LAS f32x4*)(B + O_DEC / 4 + o + 4), ar0 = *(const LAS f32x4*)(B + O_BV / 4 + o), ar1 = *(const LAS f32x4*)(B + O_BV / 4 + o + 4);
                        const f32x4 w00 = *(const f32x4*)(g_w0 + hc), w01 = *(const f32x4*)(g_w0 + hc + 4), a00 = *(const f32x4*)(g_a0 + hc), a01 = *(const f32x4*)(g_a0 + hc + 4);
                        const f32x4 kk0 = *(const f32x4*)(g_kk + hc), kk1 = *(const f32x4*)(g_kk + hc + 4), ka0 = *(const f32x4*)(g_ka + hc), ka1 = *(const f32x4*)(g_ka + hc + 4);
                        const f32x4 rk0 = *(const f32x4*)(g_rk + hc), rk1 = *(const f32x4*)(g_rk + hc + 4);
                        f32x4 dec0, dec1, a0v, a1v;
#pragma unroll
                        for (int i = 0; i < 4; ++i) {
                            { const float z = -(w00[i] + wr0[i]); const float sp = fmaxf(z, 0.f) + __logf(1.f + __expf(-fabsf(z))); dec0[i] = __expf(-__expf(-sp - 0.5f)); a0v[i] = 1.f / (1.f + __expf(-(a00[i] + ar0[i]))); }
                            { const float z = -(w01[i] + wr1[i]); const float sp = fmaxf(z, 0.f) + __logf(1.f + __expf(-fabsf(z))); dec1[i] = __expf(-__expf(-sp - 0.5f)); a1v[i] = 1.f / (1.f + __expf(-(a01[i] + ar1[i]))); }
                        }
                        f32x4 n0 = k0 * kk0, n1 = k1 * kk1;
                        const float ss = allreduce8((n0.x * n0.x + n0.y * n0.y) + (n0.z * n0.z + n0.w * n0.w) + (n1.x * n1.x + n1.y * n1.y) + (n1.z * n1.z + n1.w * n1.w));
                        const float inv = 1.f / fmaxf(sqrtf(ss), 1e-12f);
                        n0 = n0 * inv; n1 = n1 * inv;
                        const f32x4 kp0 = k0 * (1.f + (a0v - 1.f) * ka0), kp1 = k1 * (1.f + (a1v - 1.f) * ka1);
                        const f32x4 bq0 = r0 * kp0 * rk0, bq1 = r1 * kp1 * rk1;
                        const float bon = allreduce8((bq0.x + bq0.y) + (bq0.z + bq0.w) + (bq1.x + bq1.y) + (bq1.z + bq1.w));
                        *(LAS f32x4*)(B + O_DEC / 4 + o) = dec0; *(LAS f32x4*)(B + O_DEC / 4 + o + 4) = dec1;
                        *(LAS f32x4*)(B + O_K / 4 + o) = kp0; *(LAS f32x4*)(B + O_K / 4 + o + 4) = kp1;
                        *(LAS f32x4*)(B + O_AV / 4 + o) = -n0; *(LAS f32x4*)(B + O_AV / 4 + o + 4) = -n1;
                        *(LAS f32x4*)(B + O_BV / 4 + o) = n0 * a0v; *(LAS f32x4*)(B + O_BV / 4 + o + 4) = n1 * a1v;
                        if ((lane & 7) == 0) ((LAS float*)(lds + L_BON))[(cn % 3) * T + trow] = bon;
                    }
                }
            }
            __syncthreads();
        }
    }
}

namespace att { constexpr int KST = 144, VST = 528, L_K = 0, L_V = 256 * KST; static_assert(L_V + 64 * VST <= LDS_BYTES, "att LDS"); constexpr size_t SEC = (size_t)256 * 2048 * 64; }

__device__ __forceinline__ void attn_phase(LAS unsigned char* lds, const Ptrs& P, int tid) {
    using namespace att;
    const int wv = __builtin_amdgcn_readfirstlane(tid >> 6), lane = tid & 63, fr = lane & 15, fq = lane >> 4;
    const float NEG = -__builtin_inff();
    bf16* const po1 = P.o1; bf16* const po2 = P.o2; bf16* const po3 = P.o3; float* const plse = P.lse; bf16* const mix = P.mix;
    for (int bh = blockIdx.x; bh < NBATCH * NH; bh += gridDim.x) {
        const int b = bh >> 4, h = bh & 15;
        const bf16* pQ = P.P + (size_t)bh * 2048 * 64; const bf16* pK = pQ + SEC; const bf16* pV = pQ + 2 * SEC; const bf16* pG = pQ + 3 * SEC;
        for (int p = 0; p < 3; ++p) {
            const int dil = (p == 0) ? 1 : (p == 1 ? 4 : 16), nbq = 16 / dil;
            bf16* OP = ((p == 0) ? po1 : (p == 1 ? po2 : po3)) + (size_t)bh * 2048 * 64;
            float* LSE = plse + (size_t)p * MTOK * 16 + (size_t)bh * 2048;
            for (int u = 0; u < 16; ++u) {
                const int r = u / nbq, n = u - r * nbq;
                for (int hk = (n == 0 ? 0 : 1); hk < 2; ++hk) {
                    const int slot = (hk + n + 1) & 1, lbase = (n - 1 + hk) * 128;
#pragma unroll
                    for (int j = 0; j < 2; ++j) {
                        const int item = tid + NTHR * j, key = item >> 3, pc = item & 7;
                        int l = lbase + key; l = l < 0 ? 0 : l;
                        const u32x4 kv = *(const u32x4*)(pK + (size_t)(l * dil + r) * 64 + pc * 8);
                        *(LAS u32x4*)(lds + L_K + (slot * 128 + key) * KST + pc * 16) = kv;
                    }
                    {
                        const int pc = tid >> 6, kp = tid & 63;
                        int l0 = lbase + 2 * kp, l1 = l0 + 1; l0 = l0 < 0 ? 0 : l0; l1 = l1 < 0 ? 0 : l1;
                        const u32x4 v0 = *(const u32x4*)(pV + (size_t)(l0 * dil + r) * 64 + pc * 8);
                        const u32x4 v1 = *(const u32x4*)(pV + (size_t)(l1 * dil + r) * 64 + pc * 8);
#pragma unroll
                        for (int m = 0; m < 4; ++m) {
                            const unsigned lo = (v0[m] & 0xffffu) | (v1[m] << 16), hi = (v0[m] >> 16) | (v1[m] & 0xffff0000u);
                            *(LAS unsigned*)(lds + L_V + (pc * 8 + 2 * m) * VST + (slot * 128 + 2 * kp) * 2) = lo;
                            *(LAS unsigned*)(lds + L_V + (pc * 8 + 2 * m + 1) * VST + (slot * 128 + 2 * kp) * 2) = hi;
                        }
                    }
                }
                const int i0 = wv * 16, qi = i0 + fr;
                const size_t tokq = (size_t)((n * 128 + qi) * dil + r);
                bf16x8 qf[2];
#pragma unroll
                for (int s = 0; s < 2; ++s) qf[s] = *(const bf16x8*)(pQ + tokq * 64 + s * 32 + fq * 8);
                __syncthreads();
                const int ks0 = i0 < 96 ? i0 : 96;
                f32x4 st[10];
#pragma unroll
                for (int kt = 0; kt < 10; ++kt) {
                    const int kb = ks0 + kt * 16, pos = (((kb >> 7) + n + 1) & 1) * 128 + (kb & 127);
                    f32x4 acc = (f32x4){0.f, 0.f, 0.f, 0.f};
#pragma unroll
                    for (int s = 0; s < 2; ++s) {
                        const bf16x8 a = *(const LAS bf16x8*)(lds + L_K + (pos + fr) * KST + (s * 32 + fq * 8) * 2);
                        acc = __builtin_amdgcn_mfma_f32_16x16x32_bf16(a, qf[s], acc, 0, 0, 0);
                    }
                    st[kt] = acc;
                }
                float m = NEG;
#pragma unroll
                for (int kt = 0; kt < 10; ++kt)
#pragma unroll
                    for (int j = 0; j < 4; ++j) {
                        const int kk = ks0 + kt * 16 + fq * 4 + j;
                        const bool valid = (kk >= qi) && (kk <= qi + 128) && (n > 0 || kk >= 128);
                        const float s = valid ? st[kt][j] * 0.125f : NEG;
                        st[kt][j] = s; m = fmaxf(m, s);
                    }
                m = fmaxf(m, __shfl_xor(m, 16)); m = fmaxf(m, __shfl_xor(m, 32));
                float ls = 0.f;
#pragma unroll
                for (int kt = 0; kt < 10; ++kt)
#pragma unroll
                    for (int j = 0; j < 4; ++j) { const float pe = __expf(st[kt][j] - m); st[kt][j] = pe; ls += pe; }
                ls += __shfl_xor(ls, 16); ls += __shfl_xor(ls, 32);
                f32x4 oacc[4];
#pragma unroll
                for (int dt = 0; dt < 4; ++dt) oacc[dt] = (f32x4){0.f, 0.f, 0.f, 0.f};
#pragma unroll
                for (int s5 = 0; s5 < 5; ++s5) {
                    u32x4 pw; pw.x = pk2(st[2 * s5][0], st[2 * s5][1]); pw.y = pk2(st[2 * s5][2], st[2 * s5][3]);
                    pw.z = pk2(st[2 * s5 + 1][0], st[2 * s5 + 1][1]); pw.w = pk2(st[2 * s5 + 1][2], st[2 * s5 + 1][3]);
                    const bf16x8 pb = __builtin_bit_cast(bf16x8, pw);
                    const int kb0 = ks0 + 32 * s5, kb1 = kb0 + 16;
                    const int pos0 = (((kb0 >> 7) + n + 1) & 1) * 128 + (kb0 & 127) + 4 * fq, pos1 = (((kb1 >> 7) + n + 1) & 1) * 128 + (kb1 & 127) + 4 * fq;
#pragma unroll
                    for (int dt = 0; dt < 4; ++dt) {
                        const LAS unsigned char* vp = lds + L_V + (dt * 16 + fr) * VST;
                        const u32x2 lo = *(const LAS u32x2*)(vp + pos0 * 2), hi = *(const LAS u32x2*)(vp + pos1 * 2);
                        const u32x4 aw = (u32x4){lo.x, lo.y, hi.x, hi.y};
                        oacc[dt] = __builtin_amdgcn_mfma_f32_16x16x32_bf16(__builtin_bit_cast(bf16x8, aw), pb, oacc[dt], 0, 0, 0);
                    }
                }
                const float inv = 1.f / ls;
#pragma unroll
                for (int dt = 0; dt < 4; ++dt) {
                    u32x2 ow; ow.x = pk2(oacc[dt][0] * inv, oacc[dt][1] * inv); ow.y = pk2(oacc[dt][2] * inv, oacc[dt][3] * inv);
                    *(u32x2*)(OP + tokq * 64 + dt * 16 + 4 * fq) = ow;
                }
                if (fq == 0) LSE[tokq] = m + __logf(ls);
                __syncthreads();
            }
        }
        for (int pass = 0; pass < SEQ / 64; ++pass) {
            const int t = pass * 64 + (tid >> 3), pc = tid & 7; const size_t row = (size_t)bh * 2048 + t;
            const float l1 = plse[row], l2 = plse[(size_t)MTOK * 16 + row], l3 = plse[(size_t)2 * MTOK * 16 + row];
            const float mx = fmaxf(l1, fmaxf(l2, l3));
            float e1 = __expf(l1 - mx), e2 = __expf(l2 - mx), e3 = __expf(l3 - mx);
            const float inv = 1.f / (e1 + e2 + e3); e1 *= inv; e2 *= inv; e3 *= inv;
            const u32x4 a = *(const u32x4*)(po1 + row * 64 + pc * 8), bb = *(const u32x4*)(po2 + row * 64 + pc * 8), c = *(const u32x4*)(po3 + row * 64 + pc * 8);
            const u32x4 g = *(const u32x4*)(pG + (size_t)t * 64 + pc * 8);
            u32x4 ov;
#pragma unroll
            for (int i = 0; i < 4; ++i) {
                const float lo = (e1 * bflo(a[i]) + e2 * bflo(bb[i]) + e3 * bflo(c[i])) * silu(bflo(g[i]));
                const float hi = (e1 * bfhi(a[i]) + e2 * bfhi(bb[i]) + e3 * bfhi(c[i])) * silu(bfhi(g[i]));
                ov[i] = pk2(lo, hi);
            }
            *(u32x4*)(mix + ((size_t)b * SEQ + t) * MIXW + 1024 + h * 64 + pc * 8) = ov;
        }
        __syncthreads();
    }
}

__device__ __forceinline__ void final_norm(const Ptrs& P, int tid) {
    const int wave = tid >> 6, lane = tid & 63;
    const int gw = blockIdx.x * NWAVES + wave, NGW = gridDim.x * NWAVES;
    for (int m = gw; m < MTOK; m += NGW) {
        float ps = (lane < 16) ? P.part[(size_t)m * 16 + lane] : 0.f;
        ps += __shfl_xor(ps, 1); ps += __shfl_xor(ps, 2); ps += __shfl_xor(ps, 4); ps += __shfl_xor(ps, 8);
        const float ss = __shfl(ps, 0);
        const float rstd = 1.f / sqrtf(ss * (1.f / DM) + RMS_EPS);
        f32x4* o = (f32x4*)(P.out + (size_t)m * DM) + lane; const f32x4* w = (const f32x4*)P.fin_w + lane;
#pragma unroll
        for (int j = 0; j < 4; ++j) { const f32x4 v = o[64 * j]; o[64 * j] = v * rstd * w[64 * j]; }
    }
}

struct Args { const float* in[15]; float* out; unsigned char* ws; int mask; int sync; };
#ifndef MK_MULTI
#define MK_MULTI 0
#endif
#ifndef MK_REP
#define MK_REP 0
#endif
#ifndef MK_MASK
#define MK_MASK 0x7f
#endif
__global__ void __launch_bounds__(NTHR, 2) fwd_kernel(Args a) {
    extern __shared__ __attribute__((aligned(16))) unsigned char lds_[];
    LAS unsigned char* lds = (LAS unsigned char*)lds_;
    cg::grid_group grid = cg::this_grid();
    const int tid = threadIdx.x;
    Ptrs P;
    P.x = a.in[0]; P.norm_w = a.in[1]; P.w_in = a.in[2]; P.mu = a.in[3]; P.w0 = a.in[4]; P.w_up = a.in[5]; P.a0 = a.in[6]; P.a_up = a.in[7];
    P.k_k = a.in[8]; P.k_a = a.in[9]; P.r_k = a.in[10]; P.ln_w = a.in[11]; P.ln_b = a.in[12]; P.w_out = a.in[13]; P.fin_w = a.in[14];
    P.out = a.out; unsigned char* ws = a.ws;
    P.part = (float*)(ws + WS_PART); P.lse = (float*)(ws + WS_LSE);
    P.wtin = (bf16*)(ws + WS_WTIN); P.wtout = (bf16*)(ws + WS_WTOUT); P.wupT = (bf16*)(ws + WS_WUPT); P.aupT = (bf16*)(ws + WS_AUPT);
    P.mix = (bf16*)(ws + WS_MIX); P.P = (bf16*)(ws + WS_P); P.xb = (bf16*)(ws + WS_XB);
    P.o1 = (bf16*)a.out; P.o2 = (bf16*)a.out + (size_t)MTOK * DM; P.o3 = (bf16*)(ws + WS_XB);
    const int mask = a.mask;
#define SEAM() do { if (a.sync) grid.sync(); } while (0)
    if (mask & 1) p0_prologue(lds, P, tid, (mask & 0x80) != 0);
    SEAM();
    if (mask & 2) {
        pg8::Gemm g{P.xb, P.wtin, MTOK, PA, DM}; pg8::StaticOrder S; S.init(MTOK, PA, gridDim.x, (int)blockIdx.x);
        pg8::EpiHM<1> E{P.P};
        pg8::gemm_phase<pg8::EpiHM<1>, pg8::StaticOrder, true, true>(lds, g, S, E);
    }
    SEAM();
    if (mask & 4) for (int rep = 0; rep < ((MK_REP & 4) ? 2 : 1); ++rep) rwkv_phase(lds, P, tid);
    SEAM();
    if (mask & 8) {
        pg8::Gemm g{P.xb, P.wtin + (size_t)PA * DM, MTOK, PB, DM}; pg8::StaticOrder S; S.init(MTOK, PB, gridDim.x, (int)blockIdx.x);
        pg8::EpiHM<0> E{P.P};
        pg8::gemm_phase<pg8::EpiHM<0>, pg8::StaticOrder, true, true>(lds, g, S, E);
    }
    SEAM();
    if (mask & 16) for (int rep = 0; rep < ((MK_REP & 16) ? 2 : 1); ++rep) attn_phase(lds, P, tid);
    SEAM();
    if (mask & 32) {
        pg8::Gemm g{P.mix, P.wtout, MTOK, DM, MIXW}; pg8::StaticOrder S; S.init(MTOK, DM, gridDim.x, (int)blockIdx.x);
        pg8::EpiResF32 E{P.x, P.out, P.part, DM};
        pg8::gemm_phase<pg8::EpiResF32, pg8::StaticOrder, true, true>(lds, g, S, E);
    }
    SEAM();
    if (mask & 64) final_norm(P, tid);
}

extern "C" void kernel_launch(void* const* d_in, const int* in_sizes, int n_in, void* d_out, int out_size, void* d_ws, size_t ws_size, hipStream_t stream) {
    static int grid = 0;
    if (grid == 0) {
        if (n_in != 15 || in_sizes[0] != MTOK * DM || out_size != MTOK * DM || ws_size < WS_END) {
            fprintf(stderr, "kernel_launch: unexpected shapes / workspace (n_in %d, ws %zu, need %zu); nothing launched\n", n_in, ws_size, (size_t)WS_END); grid = -1; return; }
        int dev = 0, cus = 0, per_cu = 0;
        if (hipGetDevice(&dev) != hipSuccess || hipDeviceGetAttribute(&cus, hipDeviceAttributeMultiprocessorCount, dev) != hipSuccess) { grid = -1; return; }
        if (hipFuncSetAttribute((const void*)fwd_kernel, hipFuncAttributeMaxDynamicSharedMemorySize, LDS_BYTES) != hipSuccess) { fprintf(stderr, "kernel_launch: hipFuncSetAttribute failed\n"); grid = -1; return; }
        if (hipOccupancyMaxActiveBlocksPerMultiprocessor(&per_cu, (const void*)fwd_kernel, NTHR, LDS_BYTES) != hipSuccess || per_cu < 1) { fprintf(stderr, "kernel_launch: occupancy query says %d blocks per CU\n", per_cu); grid = -1; return; }
        grid = cus;
    }
    if (grid < 0) return;
    Args a{};
    for (int i = 0; i < 15; ++i) a.in[i] = (const float*)d_in[i];
    a.out = (float*)d_out; a.ws = (unsigned char*)d_ws;
#if MK_MULTI
    for (int ph = 0; ph < 7; ++ph) {
        a.mask = (1 << ph) & (MK_MASK); if (ph == 0) a.mask |= (MK_MASK & 0x80); a.sync = 0;
        if (!(a.mask & 0x7f)) continue;
        hipLaunchKernelGGL(fwd_kernel, dim3(grid), dim3(NTHR), LDS_BYTES, stream, a);
    }
#else
    a.mask = MK_MASK; a.sync = 1;
    void* args[] = {&a};
    hipError_t e = hipLaunchCooperativeKernel((void*)fwd_kernel, dim3(grid), dim3(NTHR), args, LDS_BYTES, stream);
    if (e != hipSuccess) fprintf(stderr, "cooperative launch failed: %s (grid %d)\n", hipGetErrorString(e), grid);
#endif
}
```

```cpp
#include <hip/hip_runtime.h>
#include <hip/hip_cooperative_groups.h>
#include <cstdio>
#include <cstdint>
namespace cg = cooperative_groups;
#define MK_MULTI 0
#define MK_MASK 0x7f
#define MK_REP 0
namespace pg8 {
#define PG8_LAS __attribute__((address_space(3)))
typedef unsigned short bf16_t;
typedef short bf16x8 __attribute__((ext_vector_type(8)));
typedef float f32x4 __attribute__((ext_vector_type(4)));
typedef unsigned u32x4 __attribute__((ext_vector_type(4)));
constexpr int BM = 256, BK = 64, HALF = 128, HTB = HALF * BK * 2  , STAGE_BYTES = 8 * HTB, NXCD = 8, WGM = 8;

__host__ __device__ __forceinline__ int lds_byte(int r, int c) { const int st = (r >> 4) * 2 + (c >> 5), rr = r & 15, cc = c & 31, ob = rr * 64 + cc * 2; return st * 1024 + (ob ^ (((ob >> 9) & 1) << 5)); }
__host__ __device__ __forceinline__ void stage_rc(int b, int& R, int& C) { const int st = b / 1024, sb = b % 1024, swz = sb ^ (((sb >> 9) & 1) << 5); R = (st >> 1) * 16 + swz / 64; C = (st & 1) * 32 + (swz % 64) / 2; }
__host__ __device__ __forceinline__ int perm32(int rho) { const int n = rho >> 4, i = rho & 15; return 8 * (i >> 2) + 4 * n + (i & 3); }

struct Unit { int pm, pn; };
struct Gemm { const bf16_t* A; const bf16_t* Bt; int M, N, K; };

struct StaticOrder {
    int nM, nN, nwg, G, c;
    __host__ __device__ void init(int M, int N, int G_, int c_) { nM = M / BM; nN = N / BM; nwg = nM * nN; G = G_; c = c_; }
    __host__ __device__ bool next(int i, Unit& u) const {
        const long L = (long)i * G + c; if (L >= nwg) return false;
        int wgid = (int)L; { const int q = nwg / NXCD, r = nwg % NXCD, xcd = wgid % NXCD, off = wgid / NXCD; wgid = (xcd < r ? xcd * (q + 1) : r * (q + 1) + (xcd - r) * q) + off; }
        const int nig = WGM * nN, gid = wgid / nig, fm = gid * WGM, gsz = (nM - fm) < WGM ? (nM - fm) : WGM;
        u.pm = fm + ((wgid % nig) % gsz); u.pn = (wgid % nig) / gsz; return true;
    }
    __device__ __forceinline__ void a_ready(const Unit&) const {}
    __device__ __forceinline__ void done(const Unit&) const {}
};

__device__ __forceinline__ unsigned cvt_pk_bf16(float lo, float hi) { unsigned r; asm volatile("v_cvt_pk_bf16_f32 %0, %1, %2" : "=v"(r) : "v"(lo), "v"(hi)); return r; }
typedef float f32x2 __attribute__((ext_vector_type(2)));
__device__ __forceinline__ f32x2 gelu_pk(f32x2 v) {
    const f32x2 av = __builtin_elementwise_abs(v), d = av * 0.2316418882f + 1.0f;
    f32x2 t; t.x = __builtin_amdgcn_rcpf(d.x); t.y = __builtin_amdgcn_rcpf(d.y);
    f32x2 q = t * 0.5307027145f + (-0.7265760135f); q = q * t + 0.7107068705f; q = q * t + (-0.142248368f); q = q * t + 0.127414796f; q = q * t;
    const f32x2 s = (v * v) * (-0.72134752044f);
    f32x2 e; e.x = __builtin_amdgcn_exp2f(s.x); e.y = __builtin_amdgcn_exp2f(s.y);
    const f32x2 m = v * (q * e), r = v - m;
    f32x2 o; o.x = v.x < 0.f ? m.x : r.x; o.y = v.y < 0.f ? m.y : r.y; return o;
}

template <int ACT  > struct EpiBf16 {
    static constexpr bool PERM = true, AFTER_DRAIN = false; static_assert(ACT == 0 || ACT == 1, "EpiBf16: ACT is 0 (none) or 1 (gelu_pk)");
    bf16_t* O; int ldc; const float* bias; int split_cols; size_t split_stride; float scale0;
    __device__ __forceinline__ void operator()(const f32x4 (&acc)[2][2][4][2], const Unit& u, int wr, int wc, int fr, int fq) const {
        const int row0 = u.pm * BM + wr * 64 + fr; int colt = u.pn * BM; bf16_t* base = O;
        float sc = 1.f; if (split_cols) { const int t = colt / split_cols; base += (size_t)t * split_stride; colt -= t * split_cols; if (t == 0) sc = scale0; }
        const int col0 = colt + wc * 32 + 8 * fq, bcol0 = u.pn * BM + wc * 32 + 8 * fq;
        f32x4 bv[2][2];
#pragma unroll
        for (int bj = 0; bj < 2; ++bj)
#pragma unroll
            for (int n = 0; n < 2; ++n) bv[bj][n] = bias ? *(const f32x4*)(bias + bcol0 + bj * HALF + 4 * n) : (f32x4){0.f, 0.f, 0.f, 0.f};
#pragma unroll
        for (int ai = 0; ai < 2; ++ai)
#pragma unroll
            for (int m = 0; m < 4; ++m) { bf16_t* rowp = base + (size_t)(row0 + ai * HALF + m * 16) * ldc + col0;
#pragma unroll
                for (int bj = 0; bj < 2; ++bj) { f32x4 v0 = acc[ai][bj][m][0] + bv[bj][0], v1 = acc[ai][bj][m][1] + bv[bj][1];
                    if (ACT == 1) { f32x2 a = gelu_pk((f32x2){v0[0], v0[1]}), b = gelu_pk((f32x2){v0[2], v0[3]}), c = gelu_pk((f32x2){v1[0], v1[1]}), d = gelu_pk((f32x2){v1[2], v1[3]});
                        v0 = (f32x4){a.x, a.y, b.x, b.y}; v1 = (f32x4){c.x, c.y, d.x, d.y}; }
                    v0 = v0 * sc; v1 = v1 * sc; u32x4 w; w.x = cvt_pk_bf16(v0[0], v0[1]); w.y = cvt_pk_bf16(v0[2], v0[3]); w.z = cvt_pk_bf16(v1[0], v1[1]); w.w = cvt_pk_bf16(v1[2], v1[3]);
                    *(u32x4*)(rowp + bj * HALF) = w; } }
    }
};
struct EpiResF32 {
    static constexpr bool PERM = false, AFTER_DRAIN = false;
    const float* base; float* out; float* part; int ldc;
    __device__ __forceinline__ void operator()(const f32x4 (&acc)[2][2][4][2], const Unit& u, int wr, int wc, int fr, int fq) const {
        const int col0 = u.pn * BM + wc * 32 + 4 * fq;
#pragma unroll
        for (int ai = 0; ai < 2; ++ai)
#pragma unroll
            for (int m = 0; m < 4; ++m) {
                const int row = u.pm * BM + ai * HALF + wr * 64 + m * 16 + fr;
                const size_t off = (size_t)row * ldc + col0;
                float ss = 0.f;
#pragma unroll
                for (int bj = 0; bj < 2; ++bj)
#pragma unroll
                    for (int n = 0; n < 2; ++n) {
                        const f32x4 b = *(const f32x4*)(base + off + bj * HALF + n * 16);
                        const f32x4 h = b + acc[ai][bj][m][n];
                        *(f32x4*)(out + off + bj * HALF + n * 16) = h;
                        ss += (h[0] * h[0] + h[1] * h[1]) + (h[2] * h[2] + h[3] * h[3]);
                    }
                ss += __shfl_xor(ss, 16); ss += __shfl_xor(ss, 32);
                if (fq == 0) part[(size_t)row * 16 + u.pn * 4 + wc] = ss;
            }
    }
};
template <int MODE> struct EpiHM {
    static constexpr bool PERM = true, AFTER_DRAIN = false;
    static constexpr size_t SEC = (size_t)256 * 2048 * 64;
    bf16_t* O;
    __device__ __forceinline__ void operator()(const f32x4 (&acc)[2][2][4][2], const Unit& u, int wr, int wc, int fr, int fq) const {
        const int row0 = u.pm * BM + wr * 64 + fr;
        const size_t bterm = (size_t)(row0 >> 11) * (16 * 2048 * 64);
#pragma unroll
        for (int bj = 0; bj < 2; ++bj) {
            const int c0 = u.pn * BM + bj * HALF + wc * 32 + 8 * fq;
            bf16_t* base; bool hm = true, skip = false;
            if (MODE == 0 || c0 < 3072) { base = O + (size_t)(c0 >> 10) * SEC + (size_t)((c0 >> 6) & 15) * (2048 * 64) + (c0 & 63); }
            else if (c0 < 3200) { base = O + 4 * SEC + (c0 - 3072); hm = false; }
            else if (c0 < 4224) { const int c1 = c0 - 3200; base = O + 3 * SEC + (size_t)(c1 >> 6) * (2048 * 64) + (c1 & 63); }
            else { base = O; skip = true; }
            if (skip) continue;
#pragma unroll
            for (int ai = 0; ai < 2; ++ai)
#pragma unroll
                for (int m = 0; m < 4; ++m) {
                    const int row = row0 + ai * HALF + m * 16;
                    bf16_t* p = hm ? base + bterm + (size_t)(row & 2047) * 64 : base + (size_t)row * 128;
                    const f32x4 v0 = acc[ai][bj][m][0], v1 = acc[ai][bj][m][1];
                    u32x4 w; w.x = cvt_pk_bf16(v0[0], v0[1]); w.y = cvt_pk_bf16(v0[2], v0[3]); w.z = cvt_pk_bf16(v1[0], v1[1]); w.w = cvt_pk_bf16(v1[2], v1[3]);
                    *(u32x4*)p = w;
                }
        }
    }
};
template <class Epi, class Sched, bool ALIGN_EPI = false, bool SP2 = false>
__device__ __forceinline__ void gemm_phase(PG8_LAS unsigned char* lds, const Gemm g, const Sched& S, const Epi& E) {
    const int tid = threadIdx.x, wid = __builtin_amdgcn_readfirstlane(tid >> 6), lane = tid & 63, wr = wid >> 2, wc = wid & 3, fr = lane & 15, fq = lane >> 4;
    const int K = g.K, nt = K / BK;
    unsigned voffA[2], voffB[2];
#pragma unroll
    for (int i = 0; i < 2; ++i) { int R, C; stage_rc(tid * 16 + i * 8192, R, C); const int Rb = Epi::PERM ? ((R & ~31) + perm32(R & 31)) : R;
        voffA[i] = (unsigned)(R * K + C) * 2u; voffB[i] = (unsigned)(Rb * K + C) * 2u; }
    const size_t kstep = (size_t)(BK * 2);
    const size_t hstep = (size_t)HALF * K * 2;
    const size_t tstep = 2 * hstep;
    const unsigned ldsw = (unsigned)wid * 1024u;
    const int aoff = lds_byte(wr * 64 + fr, fq * 8), boff = lds_byte(wc * 32 + fr, fq * 8);
#define PG8_SA(b, h) (((b) * 2 + (h)) * HTB)
#define PG8_SB(b, h) ((4 + (b) * 2 + (h)) * HTB)
#define PG8_STAGE(bufoff, gbase, voff) do { _Pragma("unroll") for (int _i = 0; _i < 2; ++_i) \
        __builtin_amdgcn_global_load_lds((const unsigned*)((const char*)(gbase) + (voff)[_i]), (PG8_LAS unsigned*)(lds + (bufoff) + ldsw + _i * 8192), 16, 0, 0); } while (0)
#define PG8_LDA(dst, b, h) do { _Pragma("unroll") for (int m = 0; m < 4; ++m) _Pragma("unroll") for (int k = 0; k < 2; ++k) dst[m][k] = *(const PG8_LAS bf16x8*)(lds + PG8_SA(b, h) + aoff + m * 2048 + k * 1024); } while (0)
#define PG8_LDB(dst, b, h) do { _Pragma("unroll") for (int n = 0; n < 2; ++n) _Pragma("unroll") for (int k = 0; k < 2; ++k) dst[n][k] = *(const PG8_LAS bf16x8*)(lds + PG8_SB(b, h) + boff + n * 2048 + k * 1024); } while (0)
#define PG8_MMA(ai, bj, At, Bt) do { __builtin_amdgcn_s_setprio(1); _Pragma("unroll") for (int m = 0; m < 4; ++m) _Pragma("unroll") for (int n = 0; n < 2; ++n) _Pragma("unroll") for (int k = 0; k < 2; ++k) \
        acc[ai][bj][m][n] = __builtin_amdgcn_mfma_f32_16x16x32_bf16(Bt[n][k], At[m][k], acc[ai][bj][m][n], 0, 0, 0); __builtin_amdgcn_s_setprio(0); } while (0)
#define PG8_WAIT_V(n) asm volatile("s_waitcnt vmcnt(" #n ")" ::: "memory")
#define PG8_WAIT_L(n) asm volatile("s_waitcnt lgkmcnt(" #n ")" ::: "memory")
#define PG8_BAR __builtin_amdgcn_s_barrier()
#define PG8_SCHED __builtin_amdgcn_sched_barrier(0)
    Unit cur, nxt; int ui = 0;
    if (!S.next(0, cur)) return;
    f32x4 acc[2][2][4][2];
#pragma unroll
    for (int a = 0; a < 2; ++a)
#pragma unroll
        for (int b = 0; b < 2; ++b)
#pragma unroll
            for (int m = 0; m < 4; ++m)
#pragma unroll
                for (int n = 0; n < 2; ++n) acc[a][b][m][n] = (f32x4){0.f, 0.f, 0.f, 0.f};
    bf16x8 At[4][2], B0[2][2], B1[2][2];
    const char* cA = (const char*)g.A + (size_t)cur.pm * tstep; const char* cB = (const char*)g.Bt + (size_t)cur.pn * tstep;
    S.a_ready(cur);
    if constexpr (SP2) {
        PG8_STAGE(PG8_SB(0, 0), cB, voffB); PG8_STAGE(PG8_SB(0, 1), cB + hstep, voffB); PG8_STAGE(PG8_SA(0, 0), cA, voffA); PG8_STAGE(PG8_SA(0, 1), cA + hstep, voffA);
        if (wr == 1) PG8_BAR;
        PG8_WAIT_V(2); PG8_BAR;
        PG8_STAGE(PG8_SB(1, 0), cB + kstep, voffB); PG8_STAGE(PG8_SA(1, 0), cA + kstep, voffA); PG8_STAGE(PG8_SB(1, 1), cB + hstep + kstep, voffB);
        PG8_WAIT_V(6); PG8_BAR;
    } else {
        PG8_STAGE(PG8_SB(0, 0), cB, voffB); PG8_STAGE(PG8_SA(0, 0), cA, voffA); PG8_STAGE(PG8_SB(0, 1), cB + hstep, voffB); PG8_STAGE(PG8_SA(0, 1), cA + hstep, voffA);
        if (wr == 1) PG8_BAR;
        PG8_WAIT_V(4); PG8_BAR;
        PG8_STAGE(PG8_SB(1, 0), cB + kstep, voffB); PG8_STAGE(PG8_SA(1, 0), cA + kstep, voffA); PG8_STAGE(PG8_SB(1, 1), cB + hstep + kstep, voffB);
        PG8_WAIT_V(6); PG8_BAR;
    }
    for (;;) {
        const bool has_next = S.next(ui + 1, nxt);
        const char* nA = has_next ? (const char*)g.A + (size_t)nxt.pm * tstep : cA; const char* nB = has_next ? (const char*)g.Bt + (size_t)nxt.pn * tstep : cB;
        for (int t = 0; t < nt; t += 2) {
            const bool last = (t == nt - 2);
            const char* a1 = cA + (size_t)(t + 1) * kstep;
            const char* a2 = last ? nA : cA + (size_t)(t + 2) * kstep; const char* b2 = last ? nB : cB + (size_t)(t + 2) * kstep;
            const char* a3 = a2 + kstep; const char* b3 = b2 + kstep;
            if (last && has_next) S.a_ready(nxt);
            if constexpr (SP2) {
            PG8_LDB(B0, 0, 0); PG8_LDB(B1, 0, 1); PG8_SCHED; PG8_LDA(At, 0, 0); PG8_STAGE(PG8_SA(1, 1), a1 + hstep, voffA);
            PG8_WAIT_V(8); PG8_WAIT_L(0); PG8_BAR; PG8_MMA(0, 0, At, B0); PG8_MMA(0, 1, At, B1); PG8_BAR; PG8_SCHED;
            PG8_LDA(At, 0, 1); PG8_STAGE(PG8_SB(0, 0), b2, voffB); PG8_STAGE(PG8_SB(0, 1), b2 + hstep, voffB); PG8_STAGE(PG8_SA(0, 0), a2, voffA);
            PG8_WAIT_V(8); PG8_WAIT_L(0); PG8_BAR; PG8_MMA(1, 0, At, B0); PG8_MMA(1, 1, At, B1); PG8_BAR; PG8_SCHED;
            PG8_LDB(B0, 1, 0); PG8_LDB(B1, 1, 1); PG8_SCHED; PG8_LDA(At, 1, 0); PG8_STAGE(PG8_SA(0, 1), a2 + hstep, voffA);
            PG8_WAIT_V(8); PG8_WAIT_L(0); PG8_BAR; PG8_MMA(0, 0, At, B0); PG8_MMA(0, 1, At, B1); PG8_BAR; PG8_SCHED;
            PG8_LDA(At, 1, 1); PG8_STAGE(PG8_SB(1, 0), b3, voffB); PG8_STAGE(PG8_SB(1, 1), b3 + hstep, voffB); PG8_STAGE(PG8_SA(1, 0), a3, voffA);
            PG8_WAIT_V(8); PG8_WAIT_L(0); PG8_BAR; PG8_MMA(1, 0, At, B0); PG8_MMA(1, 1, At, B1); PG8_BAR; PG8_SCHED;
            } else {
            PG8_LDB(B0, 0, 0); PG8_SCHED; PG8_LDA(At, 0, 0); PG8_STAGE(PG8_SA(1, 1), a1 + hstep, voffA);
            PG8_WAIT_L(8); PG8_BAR; PG8_WAIT_L(0); PG8_MMA(0, 0, At, B0); PG8_BAR; PG8_SCHED;
            PG8_LDB(B1, 0, 1); PG8_STAGE(PG8_SB(0, 0), b2, voffB);
            PG8_BAR; PG8_WAIT_L(0); PG8_MMA(0, 1, At, B1); PG8_BAR;
            PG8_LDA(At, 0, 1); PG8_STAGE(PG8_SA(0, 0), a2, voffA);
            PG8_BAR; PG8_WAIT_L(0); PG8_MMA(1, 0, At, B0); PG8_BAR; PG8_SCHED;
            PG8_STAGE(PG8_SB(0, 1), b2 + hstep, voffB);
            PG8_WAIT_V(6); PG8_BAR; PG8_MMA(1, 1, At, B1); PG8_BAR;
            PG8_LDB(B0, 1, 0); PG8_SCHED; PG8_LDA(At, 1, 0); PG8_STAGE(PG8_SA(0, 1), a2 + hstep, voffA);
            PG8_WAIT_L(8); PG8_BAR; PG8_WAIT_L(0); PG8_MMA(0, 0, At, B0); PG8_BAR; PG8_SCHED;
            PG8_LDB(B1, 1, 1); PG8_STAGE(PG8_SB(1, 0), b3, voffB);
            PG8_BAR; PG8_WAIT_L(0); PG8_MMA(0, 1, At, B1); PG8_BAR;
            PG8_LDA(At, 1, 1); PG8_STAGE(PG8_SA(1, 0), a3, voffA);
            PG8_BAR; PG8_WAIT_L(0); PG8_MMA(1, 0, At, B0); PG8_BAR; PG8_SCHED;
            PG8_STAGE(PG8_SB(1, 1), b3 + hstep, voffB);
            PG8_WAIT_V(6); PG8_BAR; PG8_MMA(1, 1, At, B1); PG8_BAR;
            }
        }
        if constexpr (ALIGN_EPI) { if (wr == 0) PG8_BAR; }
        if constexpr (!Epi::AFTER_DRAIN) { E(acc, cur, wr, wc, fr, fq); S.done(cur); }
        if (!has_next) break;
#pragma unroll
        for (int a = 0; a < 2; ++a)
#pragma unroll
            for (int b = 0; b < 2; ++b)
#pragma unroll
                for (int m = 0; m < 4; ++m)
#pragma unroll
                    for (int n = 0; n < 2; ++n) acc[a][b][m][n] = (f32x4){0.f, 0.f, 0.f, 0.f};
        cur = nxt; cA = nA; cB = nB; ++ui;
        if constexpr (ALIGN_EPI) { if (wr == 1) PG8_BAR; }
    }
    PG8_WAIT_V(0);
    if constexpr (!ALIGN_EPI) { if (wr == 0) PG8_BAR; }
    PG8_BAR;
    if constexpr (Epi::AFTER_DRAIN) { E.fused(acc, cur, wr, wc, fr, fq, lds, wid, lane); S.done(cur); }
#undef PG8_SA
#undef PG8_SB
#undef PG8_STAGE
#undef PG8_LDA
#undef PG8_LDB
#undef PG8_MMA
#undef PG8_WAIT_V
#undef PG8_WAIT_L
#undef PG8_BAR
#undef PG8_SCHED
}
}

#define LAS __attribute__((address_space(3)))
typedef unsigned short bf16;
typedef unsigned u32x4 __attribute__((ext_vector_type(4)));
typedef unsigned u32x2 __attribute__((ext_vector_type(2)));
typedef float f32x4 __attribute__((ext_vector_type(4)));
typedef short bf16x8 __attribute__((ext_vector_type(8)));
typedef float f32x2 __attribute__((ext_vector_type(2)));
constexpr int DM = 1024, NBATCH = 16, SEQ = 2048, MTOK = NBATCH * SEQ, NH = 16;
constexpr int N_IN = 8320, RW_COLS = 4224, PA = 4352, PB = 4096, MIXW = 2048;
constexpr float RMS_EPS = 1e-5f, GN_EPS = 64e-5f;
constexpr size_t MiB = 1u << 20;
constexpr size_t WS_PART = 1 * MiB, WS_WTIN = 3 * MiB, WS_WTOUT = 20 * MiB, WS_WUPT = 24 * MiB, WS_AUPT = 24 * MiB + 256 * 1024, WS_LSE = 25 * MiB,
                 WS_MIX = 32 * MiB, WS_P = 160 * MiB, WS_XB = 432 * MiB, WS_END = 496 * MiB;
constexpr int LDS_BYTES = 147456;
constexpr int NWAVES = 8, NTHR = 512;

struct Ptrs {
    const float *x, *norm_w, *w_in, *mu, *w0, *w_up, *a0, *a_up, *k_k, *k_a, *r_k, *ln_w, *ln_b, *w_out, *fin_w;
    float* out; float* part; float* lse;
    bf16 *wtin, *wtout, *wupT, *aupT, *mix, *P, *xb, *o1, *o2, *o3;
};

__device__ __forceinline__ unsigned f2bf(float f) { unsigned u = __builtin_bit_cast(unsigned, f); return (u + 0x7fffu + ((u >> 16) & 1u)) >> 16; }
typedef __bf16 bf16x2_t __attribute__((ext_vector_type(2)));
__device__ __forceinline__ unsigned pk2(float lo, float hi) { const f32x2 v = (f32x2){lo, hi}; const bf16x2_t bq = __builtin_convertvector(v, bf16x2_t); return __builtin_bit_cast(unsigned, bq); }
__device__ __forceinline__ float bflo(unsigned w) { return __builtin_bit_cast(float, w << 16); }
__device__ __forceinline__ float bfhi(unsigned w) { return __builtin_bit_cast(float, w & 0xffff0000u); }
__device__ __forceinline__ float wave_sum(float v) {
#pragma unroll
    for (int o = 1; o < 64; o <<= 1) v += __shfl_xor(v, o);
    return v;
}
__device__ __forceinline__ float silu(float g) { return g / (1.f + __expf(-g)); }

__device__ __forceinline__ void p0_transpose_item(const float* W, int K, int N, bf16* WT, int split, LAS float* scr, int item, int lane) {
    const int nblk = N / 32, kb = item / nblk, nb = item % nblk, k0 = 64 * kb, n0 = 32 * nb;
    const int row_off = (n0 >= split) ? 128 : 0;
#pragma unroll 8
    for (int i = 0; i < 32; ++i) { const int kk = 2 * i + (lane >> 5); scr[kk * 33 + (lane & 31)] = W[(size_t)(k0 + kk) * N + n0 + (lane & 31)]; }
    asm volatile("s_waitcnt lgkmcnt(0)" ::: "memory");
    const int c = lane & 7;
#pragma unroll
    for (int j = 0; j < 4; ++j) { const int n = (lane >> 3) + 8 * j; const LAS float* s = scr + (8 * c) * 33 + n;
        u32x4 o; o.x = pk2(s[0 * 33], s[1 * 33]); o.y = pk2(s[2 * 33], s[3 * 33]); o.z = pk2(s[4 * 33], s[5 * 33]); o.w = pk2(s[6 * 33], s[7 * 33]);
        *(u32x4*)(WT + (size_t)(row_off + n0 + n) * K + k0 + 8 * c) = o; }
    asm volatile("s_waitcnt lgkmcnt(0)" ::: "memory");
}
__device__ __forceinline__ void p0_prologue(LAS unsigned char* lds, const Ptrs& P, int tid, bool zero_mix) {
    const int wave = __builtin_amdgcn_readfirstlane(tid >> 6), lane = tid & 63;
    LAS float* scr = (LAS float*)(lds + wave * 16384);
    const int gw = blockIdx.x * NWAVES + wave, NGW = gridDim.x * NWAVES;
    constexpr int I_IN = (DM / 64) * (N_IN / 32), I_OUT = (MIXW / 64) * (DM / 32), I_UP = DM / 32;
    constexpr int NITEMS = I_IN + I_OUT + 2 * I_UP;
    for (int it = gw; it < NITEMS; it += NGW) {
        int r = it;
        if (r < I_IN) { p0_transpose_item(P.w_in, DM, N_IN, P.wtin, RW_COLS, scr, r, lane); continue; } r -= I_IN;
        if (r < I_OUT) { p0_transpose_item(P.w_out, MIXW, DM, P.wtout, 1 << 30, scr, r, lane); continue; } r -= I_OUT;
        if (r < I_UP) { p0_transpose_item(P.w_up, 64, DM, P.wupT, 1 << 30, scr, r, lane); continue; } r -= I_UP;
        p0_transpose_item(P.a_up, 64, DM, P.aupT, 1 << 30, scr, r, lane);
    }
    { const int gt = blockIdx.x * NTHR + tid, NGT = gridDim.x * NTHR; u32x4* z = (u32x4*)(P.wtin + (size_t)RW_COLS * DM);
      for (int i = gt; i < 128 * DM * 2 / 16; i += NGT) z[i] = (u32x4){0u, 0u, 0u, 0u};
      if (zero_mix) { u32x4* zm = (u32x4*)P.mix; for (size_t i = gt; i < (size_t)MTOK * MIXW * 2 / 16; i += NGT) zm[i] = (u32x4){0u, 0u, 0u, 0u}; } }
    for (int m = gw; m < MTOK; m += NGW) {
        const f32x4* xr = (const f32x4*)(P.x + (size_t)m * DM) + lane; const f32x4* wr = (const f32x4*)P.norm_w + lane;
        f32x4 v[4]; float s = 0.f;
#pragma unroll
        for (int j = 0; j < 4; ++j) { v[j] = xr[64 * j]; s += (v[j].x * v[j].x + v[j].y * v[j].y) + (v[j].z * v[j].z + v[j].w * v[j].w); }
        const float rstd = 1.f / sqrtf(wave_sum(s) * (1.f / DM) + RMS_EPS);
        unsigned long long* o8 = (unsigned long long*)(P.xb + (size_t)m * DM) + lane;
#pragma unroll
        for (int j = 0; j < 4; ++j) { const f32x4 w = wr[64 * j];
            o8[64 * j] = (unsigned long long)pk2(v[j].x * rstd * w.x, v[j].y * rstd * w.y) | ((unsigned long long)pk2(v[j].z * rstd * w.z, v[j].w * rstd * w.w) << 32); }
    }
}

namespace rw {
constexpr int T = 32, NCH = SEQ / T;
constexpr size_t SEC = (size_t)256 * 2048 * 64;
constexpr int O_DEC = 0, O_BV = 8192, O_K = 16384, O_R = 24576, O_AV = 32768, BUF = 40960;
constexpr int L_B = 0, L_V = 2 * BUF, L_Y = L_V + 3 * 8192, L_ST = L_Y + 2 * 8192, WLS = 144, ST_W = 16 * WLS, L_BON = L_ST + 4 * 2 * ST_W, L_END = L_BON + 3 * T * 4;
static_assert(L_END <= LDS_BYTES, "rwkv LDS");
template <int CTRL> __device__ __forceinline__ float dpp_add(float x) {
    const int y = __builtin_amdgcn_update_dpp(0, __builtin_bit_cast(int, x), CTRL, 0xf, 0xf, false);
    return x + __builtin_bit_cast(float, y);
}
__device__ __forceinline__ float allreduce16(float x) {
    x = dpp_add<0xB1>(x);
    x = dpp_add<0x4E>(x);
    x = dpp_add<0x141>(x);
    x = dpp_add<0x140>(x);
    return x;
}
__device__ __forceinline__ float allreduce8(float x) {
    x = dpp_add<0xB1>(x); x = dpp_add<0x4E>(x); x = dpp_add<0x141>(x);
    return x;
}
__device__ __forceinline__ void lerp8(const u32x4 cur, const u32x4 prv, const f32x4 m0, const f32x4 m1, float (&v)[8]) {
#pragma unroll
    for (int i = 0; i < 4; ++i) { const float cl = bflo(cur[i]), ch = bfhi(cur[i]), pl = bflo(prv[i]), ph = bfhi(prv[i]);
        const float ma = (i < 2) ? m0[2 * i] : m1[2 * i - 4], mb = (i < 2) ? m0[2 * i + 1] : m1[2 * i - 3];
        v[2 * i] = cl + (pl - cl) * ma; v[2 * i + 1] = ch + (ph - ch) * mb; }
}
}

__device__ __forceinline__ void rwkv_phase(LAS unsigned char* lds, const Ptrs& P, int tid) {
    using namespace rw;
    const int wv = __builtin_amdgcn_readfirstlane(tid >> 6), lane = tid & 63, fr = lane & 15, fq = lane >> 4;
    const bf16* Pb = P.P;
    const float* mu = P.mu; const float* g_w0 = P.w0; const float* g_a0 = P.a0; const float* g_kk = P.k_k; const float* g_ka = P.k_a; const float* g_rk = P.r_k;
    const float* g_lw = P.ln_w; const float* g_lb = P.ln_b; bf16* mix = P.mix;
    const int pw = wv & 3;
    const int ptt = lane >> 3, c8 = (lane & 7) * 8;
    const int trow = pw * 8 + ptt;
    LAS unsigned char* stw = lds + L_ST + pw * 2 * ST_W; LAS unsigned char* sta = stw + ST_W;
    for (int bh = blockIdx.x; bh < NBATCH * NH; bh += gridDim.x) {
        const int b = bh >> 4, h = bh & 15;
        const bf16* pR = Pb + (size_t)bh * 2048 * 64; const bf16* pK = pR + SEC; const bf16* pV = pR + 2 * SEC; const bf16* pG = pR + 3 * SEC;
        const bf16* pL = Pb + 4 * SEC + (size_t)b * 2048 * 128;
        bf16x8 bw[4][2], ba[4][2];
        if (wv >= 4) {
#pragma unroll
            for (int nt = 0; nt < 4; ++nt)
#pragma unroll
                for (int ks = 0; ks < 2; ++ks) { bw[nt][ks] = *(const bf16x8*)(P.wupT + (size_t)(h * 64 + nt * 16 + fr) * 64 + ks * 32 + fq * 8);
                                                 ba[nt][ks] = *(const bf16x8*)(P.aupT + (size_t)(h * 64 + nt * 16 + fr) * 64 + ks * 32 + fq * 8); }
        }
        f32x2 S2[4][2];
#pragma unroll
        for (int i = 0; i < 4; ++i) { S2[i][0] = (f32x2){0.f, 0.f}; S2[i][1] = (f32x2){0.f, 0.f}; }
        for (int c = -1; c <= NCH; ++c) {
            if (wv < 4) {
                if (c >= 0 && c < NCH) {
                    __builtin_amdgcn_s_setprio(3);
                    const int rg = lane >> 4, kg = lane & 15;
                    const LAS float* bb = (const LAS float*)(lds + L_B + (c & 1) * BUF) + kg * 4;
                    const LAS float* pv = (const LAS float*)(lds + L_V + (c % 3) * 8192) + wv * 16 + rg * 4;
                    LAS float* py = (LAS float*)(lds + L_Y + (c & 1) * 8192) + wv * 16 + rg * 4;
                    const bool hi8 = (kg & 8) != 0, hi4 = (kg & 4) != 0; const int yrow = ((kg >> 3) & 1) + 2 * ((kg >> 2) & 1);
                    f32x4 n_dec = *(const LAS f32x4*)(bb + O_DEC / 4), n_bv = *(const LAS f32x4*)(bb + O_BV / 4), n_kk = *(const LAS f32x4*)(bb + O_K / 4),
                          n_rr = *(const LAS f32x4*)(bb + O_R / 4), n_av = *(const LAS f32x4*)(bb + O_AV / 4), n_vv = *(const LAS f32x4*)pv;
#pragma unroll 2
                    for (int t = 0; t < T; ++t) {
                        const f32x4 dec = n_dec, bv = n_bv, kk = n_kk, rr = n_rr, av = n_av, vv = n_vv;
                        const int tn = (t + 1 < T) ? t + 1 : t;
                        n_dec = *(const LAS f32x4*)(bb + O_DEC / 4 + tn * 64); n_bv = *(const LAS f32x4*)(bb + O_BV / 4 + tn * 64); n_kk = *(const LAS f32x4*)(bb + O_K / 4 + tn * 64);
                        n_rr = *(const LAS f32x4*)(bb + O_R / 4 + tn * 64); n_av = *(const LAS f32x4*)(bb + O_AV / 4 + tn * 64); n_vv = *(const LAS f32x4*)(pv + tn * 64);
                        const f32x2 av01 = (f32x2){av[0], av[1]}, av23 = (f32x2){av[2], av[3]}, de01 = (f32x2){dec[0], dec[1]}, de23 = (f32x2){dec[2], dec[3]};
                        const f32x2 bv01 = (f32x2){bv[0], bv[1]}, bv23 = (f32x2){bv[2], bv[3]}, kk01 = (f32x2){kk[0], kk[1]}, kk23 = (f32x2){kk[2], kk[3]};
                        const f32x2 rr01 = (f32x2){rr[0], rr[1]}, rr23 = (f32x2){rr[2], rr[3]};
                        float sa[4];
#pragma unroll
                        for (int i = 0; i < 4; ++i) { const f32x2 q = S2[i][0] * av01 + S2[i][1] * av23; sa[i] = q.x + q.y; }
#pragma unroll
                        for (int i = 0; i < 4; ++i) sa[i] = allreduce16(sa[i]);
#pragma unroll
                        for (int i = 0; i < 4; ++i) {
                            const f32x2 s2 = (f32x2){sa[i], sa[i]}, v2 = (f32x2){vv[i], vv[i]};
                            S2[i][0] = S2[i][0] * de01 + s2 * bv01 + v2 * kk01;
                            S2[i][1] = S2[i][1] * de23 + s2 * bv23 + v2 * kk23;
                        }
                        float y[4];
#pragma unroll
                        for (int i = 0; i < 4; ++i) { const f32x2 q = S2[i][0] * rr01 + S2[i][1] * rr23; y[i] = q.x + q.y; }
                        const float e0 = dpp_add<0x128>(y[0]), e1 = dpp_add<0x128>(y[1]), e2 = dpp_add<0x128>(y[2]), e3 = dpp_add<0x128>(y[3]);
                        const float z01 = hi8 ? e1 : e0, z23 = hi8 ? e3 : e2;
                        const float g0 = dpp_add<0x141>(z01), g1 = dpp_add<0x141>(z23);
                        float w = hi4 ? g1 : g0;
                        w = dpp_add<0xB1>(w); w = dpp_add<0x4E>(w);
                        if ((kg & 3) == 0) py[t * 64 + yrow] = w;
                    }
                    __builtin_amdgcn_s_setprio(0);
                }
            } else {
                if (c >= 1) {
                    const int cp = c - 1, t = cp * T + trow, o = trow * 64 + c8;
                    const LAS float* aY = (const LAS float*)(lds + L_Y + (cp & 1) * 8192); const LAS float* aV = (const LAS float*)(lds + L_V + (cp % 3) * 8192);
                    const u32x4 g = *(const u32x4*)(pG + (size_t)t * 64 + c8);
                    const f32x4 lw0 = *(const f32x4*)(g_lw + h * 64 + c8), lw1 = *(const f32x4*)(g_lw + h * 64 + c8 + 4);
                    const f32x4 lb0 = *(const f32x4*)(g_lb + h * 64 + c8), lb1 = *(const f32x4*)(g_lb + h * 64 + c8 + 4);
                    const f32x4 y0 = *(const LAS f32x4*)(aY + o), y1 = *(const LAS f32x4*)(aY + o + 4), v0 = *(const LAS f32x4*)(aV + o), v1 = *(const LAS f32x4*)(aV + o + 4);
                    const float bon = ((const LAS float*)(lds + L_BON))[(cp % 3) * T + trow];
                    const float s = allreduce8((y0.x + y0.y) + (y0.z + y0.w) + (y1.x + y1.y) + (y1.z + y1.w));
                    const float mean = s * (1.f / 64.f);
                    const f32x4 d0 = y0 - mean, d1 = y1 - mean;
                    const float q = allreduce8((d0.x * d0.x + d0.y * d0.y) + (d0.z * d0.z + d0.w * d0.w) + (d1.x * d1.x + d1.y * d1.y) + (d1.z * d1.z + d1.w * d1.w));
                    const float rstd = 1.f / sqrtf(q * (1.f / 64.f) + GN_EPS);
                    const f32x4 e0 = d0 * rstd * lw0 + lb0 + bon * v0, e1 = d1 * rstd * lw1 + lb1 + bon * v1;
                    u32x4 ov;
                    ov.x = pk2(e0.x * silu(bflo(g.x)), e0.y * silu(bfhi(g.x))); ov.y = pk2(e0.z * silu(bflo(g.y)), e0.w * silu(bfhi(g.y)));
                    ov.z = pk2(e1.x * silu(bflo(g.z)), e1.y * silu(bfhi(g.z))); ov.w = pk2(e1.z * silu(bflo(g.w)), e1.w * silu(bfhi(g.w)));
                    *(u32x4*)(mix + ((size_t)b * SEQ + t) * MIXW + h * 64 + c8) = ov;
                }
                if (c + 1 < NCH) {
                    const int cn = c + 1, t = cn * T + trow, o = trow * 64 + c8;
                    LAS float* B = (LAS float*)(lds + L_B + (cn & 1) * BUF);
                    LAS float* aV = (LAS float*)(lds + L_V + (cn % 3) * 8192);
                    const bf16* sR = pR + (size_t)t * 64 + c8; const bf16* sK = pK + (size_t)t * 64 + c8; const bf16* sV = pV + (size_t)t * 64 + c8;
                    const bf16* sW = pL + (size_t)t * 128 + c8; const bf16* sA = sW + 64;
                    const u32x4 zz = (u32x4){0u, 0u, 0u, 0u};
                    const u32x4 cR = *(const u32x4*)sR, cK = *(const u32x4*)sK, cV = *(const u32x4*)sV, cW = *(const u32x4*)sW, cA = *(const u32x4*)sA;
                    u32x4 qR = zz, qK = zz, qV = zz, qW = zz, qA = zz;
                    if (t > 0) { qR = *(const u32x4*)(sR - 64); qK = *(const u32x4*)(sK - 64); qV = *(const u32x4*)(sV - 64); qW = *(const u32x4*)(sW - 128); qA = *(const u32x4*)(sA - 128); }
                    const int hc = h * 64 + c8;
                    float v[8];
                    lerp8(cR, qR, *(const f32x4*)(mu + hc), *(const f32x4*)(mu + hc + 4), v);
                    *(LAS f32x4*)(B + O_R / 4 + o) = (f32x4){v[0], v[1], v[2], v[3]}; *(LAS f32x4*)(B + O_R / 4 + o + 4) = (f32x4){v[4], v[5], v[6], v[7]};
                    const f32x4 r0 = (f32x4){v[0], v[1], v[2], v[3]}, r1 = (f32x4){v[4], v[5], v[6], v[7]};
                    lerp8(cV, qV, *(const f32x4*)(mu + 2048 + hc), *(const f32x4*)(mu + 2048 + hc + 4), v);
                    *(LAS f32x4*)(aV + o) = (f32x4){v[0], v[1], v[2], v[3]}; *(LAS f32x4*)(aV + o + 4) = (f32x4){v[4], v[5], v[6], v[7]};
                    lerp8(cW, qW, *(const f32x4*)(mu + 3072 + c8), *(const f32x4*)(mu + 3072 + c8 + 4), v);
#pragma unroll
                    for (int i = 0; i < 8; ++i) v[i] = 1.f - 2.f / (1.f + __expf(2.f * v[i]));
                    { u32x4 ow; ow.x = pk2(v[0], v[1]); ow.y = pk2(v[2], v[3]); ow.z = pk2(v[4], v[5]); ow.w = pk2(v[6], v[7]); *(LAS u32x4*)(stw + ptt * WLS + c8 * 2) = ow; }
                    lerp8(cA, qA, *(const f32x4*)(mu + 3136 + c8), *(const f32x4*)(mu + 3136 + c8 + 4), v);
                    { u32x4 ow; ow.x = pk2(v[0], v[1]); ow.y = pk2(v[2], v[3]); ow.z = pk2(v[4], v[5]); ow.w = pk2(v[6], v[7]); *(LAS u32x4*)(sta + ptt * WLS + c8 * 2) = ow; }
                    lerp8(cK, qK, *(const f32x4*)(mu + 1024 + hc), *(const f32x4*)(mu + 1024 + hc + 4), v);
                    const f32x4 k0 = (f32x4){v[0], v[1], v[2], v[3]}, k1 = (f32x4){v[4], v[5], v[6], v[7]};
                    {
                        bf16x8 aw[2], aa[2];
#pragma unroll
                        for (int ks = 0; ks < 2; ++ks) { aw[ks] = *(const LAS bf16x8*)(stw + fr * WLS + (ks * 32 + fq * 8) * 2); aa[ks] = *(const LAS bf16x8*)(sta + fr * WLS + (ks * 32 + fq * 8) * 2); }
#pragma unroll
                        for (int nt = 0; nt < 4; ++nt) {
                            f32x4 accw = (f32x4){0.f, 0.f, 0.f, 0.f}, acca = (f32x4){0.f, 0.f, 0.f, 0.f};
#pragma unroll
                            for (int ks = 0; ks < 2; ++ks) { accw = __builtin_amdgcn_mfma_f32_16x16x32_bf16(aw[ks], bw[nt][ks], accw, 0, 0, 0);
                                                             acca = __builtin_amdgcn_mfma_f32_16x16x32_bf16(aa[ks], ba[nt][ks], acca, 0, 0, 0); }
                            if (fq < 2) {
#pragma unroll
                                for (int j = 0; j < 4; ++j) { const int oo = (pw * 8 + fq * 4 + j) * 64 + nt * 16 + fr; B[O_DEC / 4 + oo] = accw[j]; B[O_BV / 4 + oo] = acca[j]; }
                            }
                        }
                    }
                    {
                        const f32x4 wr0 = *(const LAS f32x4*)(B + O_DEC / 4 + o), wr1 = *(const LAS f32x4*)(B + O_DEC / 4 + o + 4), ar0 = *(const LAS f32x4*)(B + O_BV / 4 + o), ar1 = *(const LAS f32x4*)(B + O_BV / 4 + o + 4);
                        const f32x4 w00 = *(const f32x4*)(g_w0 + hc), w01 = *(const f32x4*)(g_w0 + hc + 4), a00 = *(const f32x4*)(g_a0 + hc), a01 = *(const f32x4*)(g_a0 + hc + 4);
                        const f32x4 kk0 = *(const f32x4*)(g_kk + hc), kk1 = *(const f32x4*)(g_kk + hc + 4), ka0 = *(const f32x4*)(g_ka + hc), ka1 = *(const f32x4*)(g_ka + hc + 4);
                        const f32x4 rk0 = *(const f32x4*)(g_rk + hc), rk1 = *(const f32x4*)(g_rk + hc + 4);
                        f32x4 dec0, dec1, a0v, a1v;
#pragma unroll
                        for (int i = 0; i < 4; ++i) {
                            { const float z = -(w00[i] + wr0[i]); const float sp = fmaxf(z, 0.f) + __logf(1.f + __expf(-fabsf(z))); dec0[i] = __expf(-__expf(-sp - 0.5f)); a0v[i] = 1.f / (1.f + __expf(-(a00[i] + ar0[i]))); }
                            { const float z = -(w01[i] + wr1[i]); const float sp = fmaxf(z, 0.f) + __logf(1.f + __expf(-fabsf(z))); dec1[i] = __expf(-__expf(-sp - 0.5f)); a1v[i] = 1.f / (1.f + __expf(-(a01[i] + ar1[i]))); }
                        }
                        f32x4 n0 = k0 * kk0, n1 = k1 * kk1;
                        const float ss = allreduce8((n0.x * n0.x + n0.y * n0.y) + (n0.z * n0.z + n0.w * n0.w) + (n1.x * n1.x + n1.y * n1.y) + (n1.z * n1.z + n1.w * n1.w));
                        const float inv = 1.f / fmaxf(sqrtf(ss), 1e-12f);
                        n0 = n0 * inv; n1 = n1 * inv;
                        const f32x4 kp0 = k0 * (1.f + (a0v - 1.f) * ka0), kp1 = k1 * (1.f + (a1v - 1.f) * ka1);
                        const f32x4 bq0 = r0 * kp0 * rk0, bq1 = r1 * kp1 * rk1;
                        const float bon = allreduce8((bq0.x + bq0.y) + (bq0.z + bq0.w) + (bq1.x + bq1.y) + (bq1.z + bq1.w));
                        *(LAS f32x4*)(B + O_DEC / 4 + o) = dec0; *(LAS f32x4*)(B + O_DEC / 4 + o + 4) = dec1;
                        *(LAS f32x4*)(B + O_K / 4 + o) = kp0; *(LAS f32x4*)(B + O_K / 4 + o + 4) = kp1;
                        *(LAS f32x4*)(B + O_AV / 4 + o) = -n0; *(LAS f32x4*)(B + O_AV / 4 + o + 4) = -n1;
                        *(LAS f32x4*)(B + O_BV / 4 + o) = n0 * a0v; *(LAS f32x4*)(B + O_BV / 4 + o + 4) = n1 * a1v;
                        if ((lane & 7) == 0) ((LAS float*)(lds + L_BON))[(cn % 3) * T + trow] = bon;
                    }
                }
            }
            __syncthreads();
        }
    }
}

namespace att { constexpr int KST = 144, NSL = 3, VST = NSL * 256 + 16, L_K = 0, L_V = NSL * 128 * KST; static_assert(L_V + 64 * VST <= LDS_BYTES, "att LDS"); constexpr size_t SEC = (size_t)256 * 2048 * 64; }

__device__ __forceinline__ void attn_phase(LAS unsigned char* lds, const Ptrs& P, int tid) {
    using namespace att;
    const int wv = __builtin_amdgcn_readfirstlane(tid >> 6), lane = tid & 63, fr = lane & 15, fq = lane >> 4;
    const float NEG = -__builtin_inff();
    bf16* const po1 = P.o1; bf16* const po2 = P.o2; bf16* const po3 = P.o3; float* const plse = P.lse; bf16* const mix = P.mix;
    for (int i = tid; i < 64 * VST / 16; i += NTHR) *(LAS u32x4*)(lds + L_V + i * 16) = (u32x4){0u, 0u, 0u, 0u};
    __syncthreads();
    const int i0 = wv * 16, qi = i0 + fr, ks0 = i0 < 96 ? i0 : 96;
    const int kkey0 = tid >> 3, kpc = tid & 7, vpc = tid >> 6, vkp = tid & 63;
    for (int bh = blockIdx.x; bh < NBATCH * NH; bh += gridDim.x) {
        const int b = bh >> 4, h = bh & 15;
        const bf16* pQ = P.P + (size_t)bh * 2048 * 64; const bf16* pK = pQ + SEC; const bf16* pV = pQ + 2 * SEC; const bf16* pG = pQ + 3 * SEC;
        u32x4 rk0, rk1, rv0, rv1; bf16x8 rq0, rq1;
#define ATT_LOAD(G) do { const int p_ = (G) >> 4, u_ = (G) & 15, sh_ = 2 * p_, r_ = u_ >> (4 - sh_), n_ = u_ & ((16 >> sh_) - 1); \
            const int lb_ = n_ * 128; \
            rk0 = *(const u32x4*)(pK + (size_t)(((lb_ + kkey0) << sh_) + r_) * 64 + kpc * 8); rk1 = *(const u32x4*)(pK + (size_t)(((lb_ + 64 + kkey0) << sh_) + r_) * 64 + kpc * 8); \
            rv0 = *(const u32x4*)(pV + (size_t)(((lb_ + 2 * vkp) << sh_) + r_) * 64 + vpc * 8); rv1 = *(const u32x4*)(pV + (size_t)(((lb_ + 2 * vkp + 1) << sh_) + r_) * 64 + vpc * 8); \
            const size_t tq_ = (size_t)(((lb_ + qi) << sh_) + r_); rq0 = *(const bf16x8*)(pQ + tq_ * 64 + fq * 8); rq1 = *(const bf16x8*)(pQ + tq_ * 64 + 32 + fq * 8); } while (0)
        ATT_LOAD(0);
        for (int g = 0; g < 48; ++g) {
            const int p = g >> 4, u = g & 15, sh = 2 * p, r = u >> (4 - sh), n = u & ((16 >> sh) - 1);
            const int scur = g % 3, sprev = (g + 2) % 3;
            *(LAS u32x4*)(lds + L_K + (scur * 128 + kkey0) * KST + kpc * 16) = rk0;
            *(LAS u32x4*)(lds + L_K + (scur * 128 + 64 + kkey0) * KST + kpc * 16) = rk1;
#pragma unroll
            for (int m = 0; m < 4; ++m) {
                const unsigned lo = (rv0[m] & 0xffffu) | (rv1[m] << 16), hi = (rv0[m] >> 16) | (rv1[m] & 0xffff0000u);
                *(LAS unsigned*)(lds + L_V + (vpc * 8 + 2 * m) * VST + (scur * 128 + 2 * vkp) * 2) = lo;
                *(LAS unsigned*)(lds + L_V + (vpc * 8 + 2 * m + 1) * VST + (scur * 128 + 2 * vkp) * 2) = hi;
            }
            const bf16x8 qf0 = rq0, qf1 = rq1;
            __syncthreads();
            if (g + 1 < 48) ATT_LOAD(g + 1);
            const size_t tokq = (size_t)(((n * 128 + qi) << sh) + r);
            bf16* OP = ((p == 0) ? po1 : (p == 1 ? po2 : po3)) + (size_t)bh * 2048 * 64;
            float* LSE = plse + (size_t)p * MTOK * 16 + (size_t)bh * 2048;
            f32x4 st[10];
#pragma unroll
            for (int kt = 0; kt < 10; ++kt) {
                const int kb = ks0 + kt * 16, pos = ((kb >> 7) ? scur : sprev) * 128 + (kb & 127);
                const LAS unsigned char* kp = lds + L_K + (pos + fr) * KST + fq * 16;
                f32x4 acc = (f32x4){0.f, 0.f, 0.f, 0.f};
                acc = __builtin_amdgcn_mfma_f32_16x16x32_bf16(*(const LAS bf16x8*)kp, qf0, acc, 0, 0, 0);
                acc = __builtin_amdgcn_mfma_f32_16x16x32_bf16(*(const LAS bf16x8*)(kp + 64), qf1, acc, 0, 0, 0);
                st[kt] = acc;
            }
            const int lo = (n == 0 && qi < 128) ? 128 : qi;
            const int dl = ks0 + 4 * fq - lo; const unsigned span = (unsigned)(qi + 128 - lo);
            float m = NEG;
#pragma unroll
            for (int kt = 0; kt < 10; ++kt)
#pragma unroll
                for (int j = 0; j < 4; ++j) {
                    const bool valid = (unsigned)(dl + kt * 16 + j) <= span;
                    const float s = valid ? st[kt][j] : NEG;
                    st[kt][j] = s; m = fmaxf(m, s);
                }
            m = fmaxf(m, __shfl_xor(m, 16)); m = fmaxf(m, __shfl_xor(m, 32));
            const float C = 0.125f * 1.4426950408889634f, mc = m * C;
            float ls = 0.f;
#pragma unroll
            for (int kt = 0; kt < 10; ++kt)
#pragma unroll
                for (int j = 0; j < 4; ++j) { const float pe = __builtin_amdgcn_exp2f(st[kt][j] * C - mc); st[kt][j] = pe; ls += pe; }
            ls += __shfl_xor(ls, 16); ls += __shfl_xor(ls, 32);
            f32x4 oacc[4];
#pragma unroll
            for (int dt = 0; dt < 4; ++dt) oacc[dt] = (f32x4){0.f, 0.f, 0.f, 0.f};
#pragma unroll
            for (int s5 = 0; s5 < 5; ++s5) {
                u32x4 pw; pw.x = pk2(st[2 * s5][0], st[2 * s5][1]); pw.y = pk2(st[2 * s5][2], st[2 * s5][3]);
                pw.z = pk2(st[2 * s5 + 1][0], st[2 * s5 + 1][1]); pw.w = pk2(st[2 * s5 + 1][2], st[2 * s5 + 1][3]);
                const bf16x8 pb = __builtin_bit_cast(bf16x8, pw);
                const int kb0 = ks0 + 32 * s5, kb1 = kb0 + 16;
                const int pos0 = ((kb0 >> 7) ? scur : sprev) * 128 + (kb0 & 127) + 4 * fq, pos1 = ((kb1 >> 7) ? scur : sprev) * 128 + (kb1 & 127) + 4 * fq;
#pragma unroll
                for (int dt = 0; dt < 4; ++dt) {
                    const LAS unsigned char* vp = lds + L_V + (dt * 16 + fr) * VST;
                    const u32x2 lo2 = *(const LAS u32x2*)(vp + pos0 * 2), hi2 = *(const LAS u32x2*)(vp + pos1 * 2);
                    const u32x4 aw = (u32x4){lo2.x, lo2.y, hi2.x, hi2.y};
                    oacc[dt] = __builtin_amdgcn_mfma_f32_16x16x32_bf16(__builtin_bit_cast(bf16x8, aw), pb, oacc[dt], 0, 0, 0);
                }
            }
            const float inv = 1.f / ls;
#pragma unroll
            for (int dt = 0; dt < 4; ++dt) {
                u32x2 ow; ow.x = pk2(oacc[dt][0] * inv, oacc[dt][1] * inv); ow.y = pk2(oacc[dt][2] * inv, oacc[dt][3] * inv);
                *(u32x2*)(OP + tokq * 64 + dt * 16 + 4 * fq) = ow;
            }
            if (fq == 0) LSE[tokq] = m * 0.125f + __logf(ls);
        }
#undef ATT_LOAD
        __syncthreads();
        for (int pass = 0; pass < SEQ / 64; ++pass) {
            const int t = pass * 64 + (tid >> 3), pc = tid & 7; const size_t row = (size_t)bh * 2048 + t;
            const float l1 = plse[row], l2 = plse[(size_t)MTOK * 16 + row], l3 = plse[(size_t)2 * MTOK * 16 + row];
            const float mx = fmaxf(l1, fmaxf(l2, l3));
            float e1 = __expf(l1 - mx), e2 = __expf(l2 - mx), e3 = __expf(l3 - mx);
            const float inv = 1.f / (e1 + e2 + e3); e1 *= inv; e2 *= inv; e3 *= inv;
            const u32x4 a = *(const u32x4*)(po1 + row * 64 + pc * 8), bb = *(const u32x4*)(po2 + row * 64 + pc * 8), c = *(const u32x4*)(po3 + row * 64 + pc * 8);
            const u32x4 gt = *(const u32x4*)(pG + (size_t)t * 64 + pc * 8);
            u32x4 ov;
#pragma unroll
            for (int i = 0; i < 4; ++i) {
                const float lo = (e1 * bflo(a[i]) + e2 * bflo(bb[i]) + e3 * bflo(c[i])) * silu(bflo(gt[i]));
                const float hi = (e1 * bfhi(a[i]) + e2 * bfhi(bb[i]) + e3 * bfhi(c[i])) * silu(bfhi(gt[i]));
                ov[i] = pk2(lo, hi);
            }
            *(u32x4*)(mix + ((size_t)b * SEQ + t) * MIXW + 1024 + h * 64 + pc * 8) = ov;
        }
        __syncthreads();
    }
}

__device__ __forceinline__ void final_norm(const Ptrs& P, int tid) {
    const int wave = tid >> 6, lane = tid & 63;
    const int gw = blockIdx.x * NWAVES + wave, NGW = gridDim.x * NWAVES;
    for (int m = gw; m < MTOK; m += NGW) {
        float ps = (lane < 16) ? P.part[(size_t)m * 16 + lane] : 0.f;
        ps += __shfl_xor(ps, 1); ps += __shfl_xor(ps, 2); ps += __shfl_xor(ps, 4); ps += __shfl_xor(ps, 8);
        const float ss = __shfl(ps, 0);
        const float rstd = 1.f / sqrtf(ss * (1.f / DM) + RMS_EPS);
        f32x4* o = (f32x4*)(P.out + (size_t)m * DM) + lane; const f32x4* w = (const f32x4*)P.fin_w + lane;
#pragma unroll
        for (int j = 0; j < 4; ++j) { const f32x4 v = o[64 * j]; o[64 * j] = v * rstd * w[64 * j]; }
    }
}

struct Args { const float* in[15]; float* out; unsigned char* ws; int mask; int sync; };
#ifndef MK_MULTI
#define MK_MULTI 0
#endif
#ifndef MK_REP
#define MK_REP 0
#endif
#ifndef MK_MASK
#define MK_MASK 0x7f
#endif
__global__ void __launch_bounds__(NTHR, 2) fwd_kernel(Args a) {
    extern __shared__ __attribute__((aligned(16))) unsigned char lds_[];
    LAS unsigned char* lds = (LAS unsigned char*)lds_;
    cg::grid_group grid = cg::this_grid();
    const int tid = threadIdx.x;
    Ptrs P;
    P.x = a.in[0]; P.norm_w = a.in[1]; P.w_in = a.in[2]; P.mu = a.in[3]; P.w0 = a.in[4]; P.w_up = a.in[5]; P.a0 = a.in[6]; P.a_up = a.in[7];
    P.k_k = a.in[8]; P.k_a = a.in[9]; P.r_k = a.in[10]; P.ln_w = a.in[11]; P.ln_b = a.in[12]; P.w_out = a.in[13]; P.fin_w = a.in[14];
    P.out = a.out; unsigned char* ws = a.ws;
    P.part = (float*)(ws + WS_PART); P.lse = (float*)(ws + WS_LSE);
    P.wtin = (bf16*)(ws + WS_WTIN); P.wtout = (bf16*)(ws + WS_WTOUT); P.wupT = (bf16*)(ws + WS_WUPT); P.aupT = (bf16*)(ws + WS_AUPT);
    P.mix = (bf16*)(ws + WS_MIX); P.P = (bf16*)(ws + WS_P); P.xb = (bf16*)(ws + WS_XB);
    P.o1 = (bf16*)a.out; P.o2 = (bf16*)a.out + (size_t)MTOK * DM; P.o3 = (bf16*)(ws + WS_XB);
    const int mask = a.mask;
#define SEAM() do { if (a.sync) grid.sync(); } while (0)
    if (mask & 1) p0_prologue(lds, P, tid, (mask & 0x80) != 0);
    SEAM();
    if (mask & 2) {
        pg8::Gemm g{P.xb, P.wtin, MTOK, PA, DM}; pg8::StaticOrder S; S.init(MTOK, PA, gridDim.x, (int)blockIdx.x);
        pg8::EpiHM<1> E{P.P};
        pg8::gemm_phase<pg8::EpiHM<1>, pg8::StaticOrder, true, true>(lds, g, S, E);
    }
    SEAM();
    if (mask & 4) for (int rep = 0; rep < ((MK_REP & 4) ? 2 : 1); ++rep) rwkv_phase(lds, P, tid);
    SEAM();
    if (mask & 8) {
        pg8::Gemm g{P.xb, P.wtin + (size_t)PA * DM, MTOK, PB, DM}; pg8::StaticOrder S; S.init(MTOK, PB, gridDim.x, (int)blockIdx.x);
        pg8::EpiHM<0> E{P.P};
        pg8::gemm_phase<pg8::EpiHM<0>, pg8::StaticOrder, true, true>(lds, g, S, E);
    }
    SEAM();
    if (mask & 16) for (int rep = 0; rep < ((MK_REP & 16) ? 2 : 1); ++rep) attn_phase(lds, P, tid);
    SEAM();
    if (mask & 32) {
        pg8::Gemm g{P.mix, P.wtout, MTOK, DM, MIXW}; pg8::StaticOrder S; S.init(MTOK, DM, gridDim.x, (int)blockIdx.x);
        pg8::EpiResF32 E{P.x, P.out, P.part, DM};
        pg8::gemm_phase<pg8::EpiResF32, pg8::StaticOrder, true, true>(lds, g, S, E);
    }
    SEAM();
    if (mask & 64) final_norm(P, tid);
}

extern "C" void kernel_launch(void* const* d_in, const int* in_sizes, int n_in, void* d_out, int out_size, void* d_ws, size_t ws_size, hipStream_t stream) {
    static int grid = 0;
    if (grid == 0) {
        if (n_in != 15 || in_sizes[0] != MTOK * DM || out_size != MTOK * DM || ws_size < WS_END) {
            fprintf(stderr, "kernel_launch: unexpected shapes / workspace (n_in %d, ws %zu, need %zu); nothing launched\n", n_in, ws_size, (size_t)WS_END); grid = -1; return; }
        int dev = 0, cus = 0, per_cu = 0;
        if (hipGetDevice(&dev) != hipSuccess || hipDeviceGetAttribute(&cus, hipDeviceAttributeMultiprocessorCount, dev) != hipSuccess) { grid = -1; return; }
        if (hipFuncSetAttribute((const void*)fwd_kernel, hipFuncAttributeMaxDynamicSharedMemorySize, LDS_BYTES) != hipSuccess) { fprintf(stderr, "kernel_launch: hipFuncSetAttribute failed\n"); grid = -1; return; }
        if (hipOccupancyMaxActiveBlocksPerMultiprocessor(&per_cu, (const void*)fwd_kernel, NTHR, LDS_BYTES) != hipSuccess || per_cu < 1) { fprintf(stderr, "kernel_launch: occupancy query says %d blocks per CU\n", per_cu); grid = -1; return; }
        grid = cus;
    }
    if (grid < 0) return;
    Args a{};
    for (int i = 0; i < 15; ++i) a.in[i] = (const float*)d_in[i];
    a.out = (float*)d_out; a.ws = (unsigned char*)d_ws;
#if MK_MULTI
    for (int ph = 0; ph < 7; ++ph) {
        a.mask = (1 << ph) & (MK_MASK); if (ph == 0) a.mask |= (MK_MASK & 0x80); a.sync = 0;
        if (!(a.mask & 0x7f)) continue;
        hipLaunchKernelGGL(fwd_kernel, dim3(grid), dim3(NTHR), LDS_BYTES, stream, a);
    }
#else
    a.mask = MK_MASK; a.sync = 1;
    void* args[] = {&a};
    hipError_t e = hipLaunchCooperativeKernel((void*)fwd_kernel, dim3(grid), dim3(NTHR), args, LDS_BYTES, stream);
    if (e != hipSuccess) fprintf(stderr, "cooperative launch failed: %s (grid %d)\n", hipGetErrorString(e), grid);
#endif
}
```

```cpp
#include <hip/hip_runtime.h>
#include <hip/hip_cooperative_groups.h>
#include <cstdio>
#include <cstdint>
namespace cg = cooperative_groups;
#define MK_MULTI 0
#define MK_MASK 0x7f
#define MK_REP 0
namespace pg8 {
#define PG8_LAS __attribute__((address_space(3)))
typedef unsigned short bf16_t;
typedef short bf16x8 __attribute__((ext_vector_type(8)));
typedef float f32x4 __attribute__((ext_vector_type(4)));
typedef unsigned u32x4 __attribute__((ext_vector_type(4)));
constexpr int BM = 256, BK = 64, HALF = 128, HTB = HALF * BK * 2  , STAGE_BYTES = 8 * HTB, NXCD = 8, WGM = 8;

__host__ __device__ __forceinline__ int lds_byte(int r, int c) { const int st = (r >> 4) * 2 + (c >> 5), rr = r & 15, cc = c & 31, ob = rr * 64 + cc * 2; return st * 1024 + (ob ^ (((ob >> 9) & 1) << 5)); }
__host__ __device__ __forceinline__ void stage_rc(int b, int& R, int& C) { const int st = b / 1024, sb = b % 1024, swz = sb ^ (((sb >> 9) & 1) << 5); R = (st >> 1) * 16 + swz / 64; C = (st & 1) * 32 + (swz % 64) / 2; }
__host__ __device__ __forceinline__ int perm32(int rho) { const int n = rho >> 4, i = rho & 15; return 8 * (i >> 2) + 4 * n + (i & 3); }

struct Unit { int pm, pn; };
struct Gemm { const bf16_t* A; const bf16_t* Bt; int M, N, K; };

struct StaticOrder {
    int nM, nN, nwg, G, c;
    __host__ __device__ void init(int M, int N, int G_, int c_) { nM = M / BM; nN = N / BM; nwg = nM * nN; G = G_; c = c_; }
    __host__ __device__ bool next(int i, Unit& u) const {
        const long L = (long)i * G + c; if (L >= nwg) return false;
        int wgid = (int)L; { const int q = nwg / NXCD, r = nwg % NXCD, xcd = wgid % NXCD, off = wgid / NXCD; wgid = (xcd < r ? xcd * (q + 1) : r * (q + 1) + (xcd - r) * q) + off; }
        const int nig = WGM * nN, gid = wgid / nig, fm = gid * WGM, gsz = (nM - fm) < WGM ? (nM - fm) : WGM;
        u.pm = fm + ((wgid % nig) % gsz); u.pn = (wgid % nig) / gsz; return true;
    }
    __device__ __forceinline__ void a_ready(const Unit&) const {}
    __device__ __forceinline__ void done(const Unit&) const {}
};

__device__ __forceinline__ unsigned cvt_pk_bf16(float lo, float hi) { unsigned r; asm volatile("v_cvt_pk_bf16_f32 %0, %1, %2" : "=v"(r) : "v"(lo), "v"(hi)); return r; }
typedef float f32x2 __attribute__((ext_vector_type(2)));
__device__ __forceinline__ f32x2 gelu_pk(f32x2 v) {
    const f32x2 av = __builtin_elementwise_abs(v), d = av * 0.2316418882f + 1.0f;
    f32x2 t; t.x = __builtin_amdgcn_rcpf(d.x); t.y = __builtin_amdgcn_rcpf(d.y);
    f32x2 q = t * 0.5307027145f + (-0.7265760135f); q = q * t + 0.7107068705f; q = q * t + (-0.142248368f); q = q * t + 0.127414796f; q = q * t;
    const f32x2 s = (v * v) * (-0.72134752044f);
    f32x2 e; e.x = __builtin_amdgcn_exp2f(s.x); e.y = __builtin_amdgcn_exp2f(s.y);
    const f32x2 m = v * (q * e), r = v - m;
    f32x2 o; o.x = v.x < 0.f ? m.x : r.x; o.y = v.y < 0.f ? m.y : r.y; return o;
}

template <int ACT  > struct EpiBf16 {
    static constexpr bool PERM = true, AFTER_DRAIN = false; static_assert(ACT == 0 || ACT == 1, "EpiBf16: ACT is 0 (none) or 1 (gelu_pk)");
    bf16_t* O; int ldc; const float* bias; int split_cols; size_t split_stride; float scale0;
    __device__ __forceinline__ void operator()(const f32x4 (&acc)[2][2][4][2], const Unit& u, int wr, int wc, int fr, int fq) const {
        const int row0 = u.pm * BM + wr * 64 + fr; int colt = u.pn * BM; bf16_t* base = O;
        float sc = 1.f; if (split_cols) { const int t = colt / split_cols; base += (size_t)t * split_stride; colt -= t * split_cols; if (t == 0) sc = scale0; }
        const int col0 = colt + wc * 32 + 8 * fq, bcol0 = u.pn * BM + wc * 32 + 8 * fq;
        f32x4 bv[2][2];
#pragma unroll
        for (int bj = 0; bj < 2; ++bj)
#pragma unroll
            for (int n = 0; n < 2; ++n) bv[bj][n] = bias ? *(const f32x4*)(bias + bcol0 + bj * HALF + 4 * n) : (f32x4){0.f, 0.f, 0.f, 0.f};
#pragma unroll
        for (int ai = 0; ai < 2; ++ai)
#pragma unroll
            for (int m = 0; m < 4; ++m) { bf16_t* rowp = base + (size_t)(row0 + ai * HALF + m * 16) * ldc + col0;
#pragma unroll
                for (int bj = 0; bj < 2; ++bj) { f32x4 v0 = acc[ai][bj][m][0] + bv[bj][0], v1 = acc[ai][bj][m][1] + bv[bj][1];
                    if (ACT == 1) { f32x2 a = gelu_pk((f32x2){v0[0], v0[1]}), b = gelu_pk((f32x2){v0[2], v0[3]}), c = gelu_pk((f32x2){v1[0], v1[1]}), d = gelu_pk((f32x2){v1[2], v1[3]});
                        v0 = (f32x4){a.x, a.y, b.x, b.y}; v1 = (f32x4){c.x, c.y, d.x, d.y}; }
                    v0 = v0 * sc; v1 = v1 * sc; u32x4 w; w.x = cvt_pk_bf16(v0[0], v0[1]); w.y = cvt_pk_bf16(v0[2], v0[3]); w.z = cvt_pk_bf16(v1[0], v1[1]); w.w = cvt_pk_bf16(v1[2], v1[3]);
                    *(u32x4*)(rowp + bj * HALF) = w; } }
    }
};
struct EpiResF32 {
    static constexpr bool PERM = false, AFTER_DRAIN = false;
    const float* base; float* out; float* part; int ldc;
    __device__ __forceinline__ void operator()(const f32x4 (&acc)[2][2][4][2], const Unit& u, int wr, int wc, int fr, int fq) const {
        const int col0 = u.pn * BM + wc * 32 + 4 * fq;
#pragma unroll
        for (int ai = 0; ai < 2; ++ai)
#pragma unroll
            for (int m = 0; m < 4; ++m) {
                const int row = u.pm * BM + ai * HALF + wr * 64 + m * 16 + fr;
                const size_t off = (size_t)row * ldc + col0;
                float ss = 0.f;
#pragma unroll
                for (int bj = 0; bj < 2; ++bj)
#pragma unroll
                    for (int n = 0; n < 2; ++n) {
                        const f32x4 b = *(const f32x4*)(base + off + bj * HALF + n * 16);
                        const f32x4 h = b + acc[ai][bj][m][n];
                        *(f32x4*)(out + off + bj * HALF + n * 16) = h;
                        ss += (h[0] * h[0] + h[1] * h[1]) + (h[2] * h[2] + h[3] * h[3]);
                    }
                ss += __shfl_xor(ss, 16); ss += __shfl_xor(ss, 32);
                if (fq == 0) part[(size_t)row * 16 + u.pn * 4 + wc] = ss;
            }
    }
};
template <int MODE> struct EpiHM {
    static constexpr bool PERM = true, AFTER_DRAIN = false;
    static constexpr size_t SEC = (size_t)256 * 2048 * 64;
    bf16_t* O;
    __device__ __forceinline__ void operator()(const f32x4 (&acc)[2][2][4][2], const Unit& u, int wr, int wc, int fr, int fq) const {
        const int row0 = u.pm * BM + wr * 64 + fr;
        const size_t bterm = (size_t)(row0 >> 11) * (16 * 2048 * 64);
#pragma unroll
        for (int bj = 0; bj < 2; ++bj) {
            const int c0 = u.pn * BM + bj * HALF + wc * 32 + 8 * fq;
            bf16_t* base; bool hm = true, skip = false;
            if (MODE == 0 || c0 < 3072) { base = O + (size_t)(c0 >> 10) * SEC + (size_t)((c0 >> 6) & 15) * (2048 * 64) + (c0 & 63); }
            else if (c0 < 3200) { base = O + 4 * SEC + (c0 - 3072); hm = false; }
            else if (c0 < 4224) { const int c1 = c0 - 3200; base = O + 3 * SEC + (size_t)(c1 >> 6) * (2048 * 64) + (c1 & 63); }
            else { base = O; skip = true; }
            if (skip) continue;
#pragma unroll
            for (int ai = 0; ai < 2; ++ai)
#pragma unroll
                for (int m = 0; m < 4; ++m) {
                    const int row = row0 + ai * HALF + m * 16;
                    bf16_t* p = hm ? base + bterm + (size_t)(row & 2047) * 64 : base + (size_t)row * 128;
                    const f32x4 v0 = acc[ai][bj][m][0], v1 = acc[ai][bj][m][1];
                    u32x4 w; w.x = cvt_pk_bf16(v0[0], v0[1]); w.y = cvt_pk_bf16(v0[2], v0[3]); w.z = cvt_pk_bf16(v1[0], v1[1]); w.w = cvt_pk_bf16(v1[2], v1[3]);
                    *(u32x4*)p = w;
                }
        }
    }
};
template <class Epi, class Sched, bool ALIGN_EPI = false, bool SP2 = false>
__device__ __forceinline__ void gemm_phase(PG8_LAS unsigned char* lds, const Gemm g, const Sched& S, const Epi& E) {
    const int tid = threadIdx.x, wid = __builtin_amdgcn_readfirstlane(tid >> 6), lane = tid & 63, wr = wid >> 2, wc = wid & 3, fr = lane & 15, fq = lane >> 4;
    const int K = g.K, nt = K / BK;
    unsigned voffA[2], voffB[2];
#pragma unroll
    for (int i = 0; i < 2; ++i) { int R, C; stage_rc(tid * 16 + i * 8192, R, C); const int Rb = Epi::PERM ? ((R & ~31) + perm32(R & 31)) : R;
        voffA[i] = (unsigned)(R * K + C) * 2u; voffB[i] = (unsigned)(Rb * K + C) * 2u; }
    const size_t kstep = (size_t)(BK * 2);
    const size_t hstep = (size_t)HALF * K * 2;
    const size_t tstep = 2 * hstep;
    const unsigned ldsw = (unsigned)wid * 1024u;
    const int aoff = lds_byte(wr * 64 + fr, fq * 8), boff = lds_byte(wc * 32 + fr, fq * 8);
#define PG8_SA(b, h) (((b) * 2 + (h)) * HTB)
#define PG8_SB(b, h) ((4 + (b) * 2 + (h)) * HTB)
#define PG8_STAGE(bufoff, gbase, voff) do { _Pragma("unroll") for (int _i = 0; _i < 2; ++_i) \
        __builtin_amdgcn_global_load_lds((const unsigned*)((const char*)(gbase) + (voff)[_i]), (PG8_LAS unsigned*)(lds + (bufoff) + ldsw + _i * 8192), 16, 0, 0); } while (0)
#define PG8_LDA(dst, b, h) do { _Pragma("unroll") for (int m = 0; m < 4; ++m) _Pragma("unroll") for (int k = 0; k < 2; ++k) dst[m][k] = *(const PG8_LAS bf16x8*)(lds + PG8_SA(b, h) + aoff + m * 2048 + k * 1024); } while (0)
#define PG8_LDB(dst, b, h) do { _Pragma("unroll") for (int n = 0; n < 2; ++n) _Pragma("unroll") for (int k = 0; k < 2; ++k) dst[n][k] = *(const PG8_LAS bf16x8*)(lds + PG8_SB(b, h) + boff + n * 2048 + k * 1024); } while (0)
#define PG8_MMA(ai, bj, At, Bt) do { __builtin_amdgcn_s_setprio(1); _Pragma("unroll") for (int m = 0; m < 4; ++m) _Pragma("unroll") for (int n = 0; n < 2; ++n) _Pragma("unroll") for (int k = 0; k < 2; ++k) \
        acc[ai][bj][m][n] = __builtin_amdgcn_mfma_f32_16x16x32_bf16(Bt[n][k], At[m][k], acc[ai][bj][m][n], 0, 0, 0); __builtin_amdgcn_s_setprio(0); } while (0)
#define PG8_WAIT_V(n) asm volatile("s_waitcnt vmcnt(" #n ")" ::: "memory")
#define PG8_WAIT_L(n) asm volatile("s_waitcnt lgkmcnt(" #n ")" ::: "memory")
#define PG8_BAR __builtin_amdgcn_s_barrier()
#define PG8_SCHED __builtin_amdgcn_sched_barrier(0)
    Unit cur, nxt; int ui = 0;
    if (!S.next(0, cur)) return;
    f32x4 acc[2][2][4][2];
#pragma unroll
    for (int a = 0; a < 2; ++a)
#pragma unroll
        for (int b = 0; b < 2; ++b)
#pragma unroll
            for (int m = 0; m < 4; ++m)
#pragma unroll
                for (int n = 0; n < 2; ++n) acc[a][b][m][n] = (f32x4){0.f, 0.f, 0.f, 0.f};
    bf16x8 At[4][2], B0[2][2], B1[2][2];
    const char* cA = (const char*)g.A + (size_t)cur.pm * tstep; const char* cB = (const char*)g.Bt + (size_t)cur.pn * tstep;
    S.a_ready(cur);
    if constexpr (SP2) {
        PG8_STAGE(PG8_SB(0, 0), cB, voffB); PG8_STAGE(PG8_SB(0, 1), cB + hstep, voffB); PG8_STAGE(PG8_SA(0, 0), cA, voffA); PG8_STAGE(PG8_SA(0, 1), cA + hstep, voffA);
        if (wr == 1) PG8_BAR;
        PG8_WAIT_V(2); PG8_BAR;
        PG8_STAGE(PG8_SB(1, 0), cB + kstep, voffB); PG8_STAGE(PG8_SA(1, 0), cA + kstep, voffA); PG8_STAGE(PG8_SB(1, 1), cB + hstep + kstep, voffB);
        PG8_WAIT_V(6); PG8_BAR;
    } else {
        PG8_STAGE(PG8_SB(0, 0), cB, voffB); PG8_STAGE(PG8_SA(0, 0), cA, voffA); PG8_STAGE(PG8_SB(0, 1), cB + hstep, voffB); PG8_STAGE(PG8_SA(0, 1), cA + hstep, voffA);
        if (wr == 1) PG8_BAR;
        PG8_WAIT_V(4); PG8_BAR;
        PG8_STAGE(PG8_SB(1, 0), cB + kstep, voffB); PG8_STAGE(PG8_SA(1, 0), cA + kstep, voffA); PG8_STAGE(PG8_SB(1, 1), cB + hstep + kstep, voffB);
        PG8_WAIT_V(6); PG8_BAR;
    }
    for (;;) {
        const bool has_next = S.next(ui + 1, nxt);
        const char* nA = has_next ? (const char*)g.A + (size_t)nxt.pm * tstep : cA; const char* nB = has_next ? (const char*)g.Bt + (size_t)nxt.pn * tstep : cB;
        for (int t = 0; t < nt; t += 2) {
            const bool last = (t == nt - 2);
            const char* a1 = cA + (size_t)(t + 1) * kstep;
            const char* a2 = last ? nA : cA + (size_t)(t + 2) * kstep; const char* b2 = last ? nB : cB + (size_t)(t + 2) * kstep;
            const char* a3 = a2 + kstep; const char* b3 = b2 + kstep;
            if (last && has_next) S.a_ready(nxt);
            if constexpr (SP2) {
            PG8_LDB(B0, 0, 0); PG8_LDB(B1, 0, 1); PG8_SCHED; PG8_LDA(At, 0, 0); PG8_STAGE(PG8_SA(1, 1), a1 + hstep, voffA);
            PG8_WAIT_V(8); PG8_WAIT_L(0); PG8_BAR; PG8_MMA(0, 0, At, B0); PG8_MMA(0, 1, At, B1); PG8_BAR; PG8_SCHED;
            PG8_LDA(At, 0, 1); PG8_STAGE(PG8_SB(0, 0), b2, voffB); PG8_STAGE(PG8_SB(0, 1), b2 + hstep, voffB); PG8_STAGE(PG8_SA(0, 0), a2, voffA);
            PG8_WAIT_V(8); PG8_WAIT_L(0); PG8_BAR; PG8_MMA(1, 0, At, B0); PG8_MMA(1, 1, At, B1); PG8_BAR; PG8_SCHED;
            PG8_LDB(B0, 1, 0); PG8_LDB(B1, 1, 1); PG8_SCHED; PG8_LDA(At, 1, 0); PG8_STAGE(PG8_SA(0, 1), a2 + hstep, voffA);
            PG8_WAIT_V(8); PG8_WAIT_L(0); PG8_BAR; PG8_MMA(0, 0, At, B0); PG8_MMA(0, 1, At, B1); PG8_BAR; PG8_SCHED;
            PG8_LDA(At, 1, 1); PG8_STAGE(PG8_SB(1, 0), b3, voffB); PG8_STAGE(PG8_SB(1, 1), b3 + hstep, voffB); PG8_STAGE(PG8_SA(1, 0), a3, voffA);
            PG8_WAIT_V(8); PG8_WAIT_L(0); PG8_BAR; PG8_MMA(1, 0, At, B0); PG8_MMA(1, 1, At, B1); PG8_BAR; PG8_SCHED;
            } else {
            PG8_LDB(B0, 0, 0); PG8_SCHED; PG8_LDA(At, 0, 0); PG8_STAGE(PG8_SA(1, 1), a1 + hstep, voffA);
            PG8_WAIT_L(8); PG8_BAR; PG8_WAIT_L(0); PG8_MMA(0, 0, At, B0); PG8_BAR; PG8_SCHED;
            PG8_LDB(B1, 0, 1); PG8_STAGE(PG8_SB(0, 0), b2, voffB);
            PG8_BAR; PG8_WAIT_L(0); PG8_MMA(0, 1, At, B1); PG8_BAR;
            PG8_LDA(At, 0, 1); PG8_STAGE(PG8_SA(0, 0), a2, voffA);
            PG8_BAR; PG8_WAIT_L(0); PG8_MMA(1, 0, At, B0); PG8_BAR; PG8_SCHED;
            PG8_STAGE(PG8_SB(0, 1), b2 + hstep, voffB);
            PG8_WAIT_V(6); PG8_BAR; PG8_MMA(1, 1, At, B1); PG8_BAR;
            PG8_LDB(B0, 1, 0); PG8_SCHED; PG8_LDA(At, 1, 0); PG8_STAGE(PG8_SA(0, 1), a2 + hstep, voffA);
            PG8_WAIT_L(8); PG8_BAR; PG8_WAIT_L(0); PG8_MMA(0, 0, At, B0); PG8_BAR; PG8_SCHED;
            PG8_LDB(B1, 1, 1); PG8_STAGE(PG8_SB(1, 0), b3, voffB);
            PG8_BAR; PG8_WAIT_L(0); PG8_MMA(0, 1, At, B1); PG8_BAR;
            PG8_LDA(At, 1, 1); PG8_STAGE(PG8_SA(1, 0), a3, voffA);
            PG8_BAR; PG8_WAIT_L(0); PG8_MMA(1, 0, At, B0); PG8_BAR; PG8_SCHED;
            PG8_STAGE(PG8_SB(1, 1), b3 + hstep, voffB);
            PG8_WAIT_V(6); PG8_BAR; PG8_MMA(1, 1, At, B1); PG8_BAR;
            }
        }
        if constexpr (ALIGN_EPI) { if (wr == 0) PG8_BAR; }
        if constexpr (!Epi::AFTER_DRAIN) { E(acc, cur, wr, wc, fr, fq); S.done(cur); }
        if (!has_next) break;
#pragma unroll
        for (int a = 0; a < 2; ++a)
#pragma unroll
            for (int b = 0; b < 2; ++b)
#pragma unroll
                for (int m = 0; m < 4; ++m)
#pragma unroll
                    for (int n = 0; n < 2; ++n) acc[a][b][m][n] = (f32x4){0.f, 0.f, 0.f, 0.f};
        cur = nxt; cA = nA; cB = nB; ++ui;
        if constexpr (ALIGN_EPI) { if (wr == 1) PG8_BAR; }
    }
    PG8_WAIT_V(0);
    if constexpr (!ALIGN_EPI) { if (wr == 0) PG8_BAR; }
    PG8_BAR;
    if constexpr (Epi::AFTER_DRAIN) { E.fused(acc, cur, wr, wc, fr, fq, lds, wid, lane); S.done(cur); }
#undef PG8_SA
#undef PG8_SB
#undef PG8_STAGE
#undef PG8_LDA
#undef PG8_LDB
#undef PG8_MMA
#undef PG8_WAIT_V
#undef PG8_WAIT_L
#undef PG8_BAR
#undef PG8_SCHED
}
}

#define LAS __attribute__((address_space(3)))
typedef unsigned short bf16;
typedef unsigned u32x4 __attribute__((ext_vector_type(4)));
typedef unsigned u32x2 __attribute__((ext_vector_type(2)));
typedef float f32x4 __attribute__((ext_vector_type(4)));
typedef short bf16x8 __attribute__((ext_vector_type(8)));
typedef float f32x2 __attribute__((ext_vector_type(2)));
constexpr int DM = 1024, NBATCH = 16, SEQ = 2048, MTOK = NBATCH * SEQ, NH = 16;
constexpr int N_IN = 8320, RW_COLS = 4224, PA = 4352, PB = 4096, MIXW = 2048;
constexpr float RMS_EPS = 1e-5f, GN_EPS = 64e-5f;
constexpr size_t MiB = 1u << 20;
constexpr size_t WS_CTL = 0, WS_PART = 1 * MiB, WS_WTIN = 3 * MiB, WS_WTOUT = 20 * MiB, WS_WUPT = 24 * MiB, WS_AUPT = 24 * MiB + 256 * 1024, WS_LSE = 25 * MiB,
                 WS_MIX = 32 * MiB, WS_P = 160 * MiB, WS_XB = 432 * MiB, WS_END = 496 * MiB;
constexpr int LDS_BYTES = 147456;
constexpr int NWAVES = 8, NTHR = 512;

struct Ptrs {
    const float *x, *norm_w, *w_in, *mu, *w0, *w_up, *a0, *a_up, *k_k, *k_a, *r_k, *ln_w, *ln_b, *w_out, *fin_w;
    float* out; float* part; float* lse;
    bf16 *wtin, *wtout, *wupT, *aupT, *mix, *P, *xb, *o1, *o2, *o3;
};

__device__ __forceinline__ unsigned f2bf(float f) { unsigned u = __builtin_bit_cast(unsigned, f); return (u + 0x7fffu + ((u >> 16) & 1u)) >> 16; }
typedef __bf16 bf16x2_t __attribute__((ext_vector_type(2)));
__device__ __forceinline__ unsigned pk2(float lo, float hi) { const f32x2 v = (f32x2){lo, hi}; const bf16x2_t bq = __builtin_convertvector(v, bf16x2_t); return __builtin_bit_cast(unsigned, bq); }
__device__ __forceinline__ float bflo(unsigned w) { return __builtin_bit_cast(float, w << 16); }
__device__ __forceinline__ float bfhi(unsigned w) { return __builtin_bit_cast(float, w & 0xffff0000u); }
__device__ __forceinline__ float wave_sum(float v) {
#pragma unroll
    for (int o = 1; o < 64; o <<= 1) v += __shfl_xor(v, o);
    return v;
}
__device__ __forceinline__ float silu(float g) { return g / (1.f + __expf(-g)); }

__device__ __forceinline__ void p0_transpose_item(const float* W, int K, int N, bf16* WT, int split, LAS float* scr, int item, int lane) {
    const int nblk = N / 32, kb = item / nblk, nb = item % nblk, k0 = 64 * kb, n0 = 32 * nb;
    const int row_off = (n0 >= split) ? 128 : 0;
#pragma unroll 8
    for (int i = 0; i < 32; ++i) { const int kk = 2 * i + (lane >> 5); scr[kk * 33 + (lane & 31)] = W[(size_t)(k0 + kk) * N + n0 + (lane & 31)]; }
    asm volatile("s_waitcnt lgkmcnt(0)" ::: "memory");
    const int c = lane & 7;
#pragma unroll
    for (int j = 0; j < 4; ++j) { const int n = (lane >> 3) + 8 * j; const LAS float* s = scr + (8 * c) * 33 + n;
        u32x4 o; o.x = pk2(s[0 * 33], s[1 * 33]); o.y = pk2(s[2 * 33], s[3 * 33]); o.z = pk2(s[4 * 33], s[5 * 33]); o.w = pk2(s[6 * 33], s[7 * 33]);
        *(u32x4*)(WT + (size_t)(row_off + n0 + n) * K + k0 + 8 * c) = o; }
    asm volatile("s_waitcnt lgkmcnt(0)" ::: "memory");
}
__device__ __forceinline__ void p0_prologue(LAS unsigned char* lds, const Ptrs& P, int tid, bool zero_mix) {
    const int wave = __builtin_amdgcn_readfirstlane(tid >> 6), lane = tid & 63;
    LAS float* scr = (LAS float*)(lds + wave * 16384);
    const int gw = blockIdx.x * NWAVES + wave, NGW = gridDim.x * NWAVES;
    constexpr int I_IN = (DM / 64) * (N_IN / 32), I_OUT = (MIXW / 64) * (DM / 32), I_UP = DM / 32;
    constexpr int NITEMS = I_IN + I_OUT + 2 * I_UP;
    for (int it = gw; it < NITEMS; it += NGW) {
        int r = it;
        if (r < I_IN) { p0_transpose_item(P.w_in, DM, N_IN, P.wtin, RW_COLS, scr, r, lane); continue; } r -= I_IN;
        if (r < I_OUT) { p0_transpose_item(P.w_out, MIXW, DM, P.wtout, 1 << 30, scr, r, lane); continue; } r -= I_OUT;
        if (r < I_UP) { p0_transpose_item(P.w_up, 64, DM, P.wupT, 1 << 30, scr, r, lane); continue; } r -= I_UP;
        p0_transpose_item(P.a_up, 64, DM, P.aupT, 1 << 30, scr, r, lane);
    }
    { const int gt = blockIdx.x * NTHR + tid, NGT = gridDim.x * NTHR; u32x4* z = (u32x4*)(P.wtin + (size_t)RW_COLS * DM);
      for (int i = gt; i < 128 * DM * 2 / 16; i += NGT) z[i] = (u32x4){0u, 0u, 0u, 0u};
      if (zero_mix) { u32x4* zm = (u32x4*)P.mix; for (size_t i = gt; i < (size_t)MTOK * MIXW * 2 / 16; i += NGT) zm[i] = (u32x4){0u, 0u, 0u, 0u}; } }
    for (int m = gw; m < MTOK; m += NGW) {
        const f32x4* xr = (const f32x4*)(P.x + (size_t)m * DM) + lane; const f32x4* wr = (const f32x4*)P.norm_w + lane;
        f32x4 v[4]; float s = 0.f;
#pragma unroll
        for (int j = 0; j < 4; ++j) { v[j] = xr[64 * j]; s += (v[j].x * v[j].x + v[j].y * v[j].y) + (v[j].z * v[j].z + v[j].w * v[j].w); }
        const float rstd = 1.f / sqrtf(wave_sum(s) * (1.f / DM) + RMS_EPS);
        unsigned long long* o8 = (unsigned long long*)(P.xb + (size_t)m * DM) + lane;
#pragma unroll
        for (int j = 0; j < 4; ++j) { const f32x4 w = wr[64 * j];
            o8[64 * j] = (unsigned long long)pk2(v[j].x * rstd * w.x, v[j].y * rstd * w.y) | ((unsigned long long)pk2(v[j].z * rstd * w.z, v[j].w * rstd * w.w) << 32); }
    }
}

namespace rw {
constexpr int T = 32, NCH = SEQ / T;
constexpr size_t SEC = (size_t)256 * 2048 * 64;
constexpr int O_DEC = 0, O_BV = 8192, O_K = 16384, O_R = 24576, O_AV = 32768, BUF = 40960;
constexpr int L_B = 0, L_V = 2 * BUF, L_Y = L_V + 3 * 8192, L_ST = L_Y + 2 * 8192, WLS = 144, ST_W = 16 * WLS, L_BON = L_ST + 4 * 2 * ST_W, L_END = L_BON + 3 * T * 4;
static_assert(L_END <= LDS_BYTES, "rwkv LDS");
template <int CTRL> __device__ __forceinline__ float dpp_add(float x) {
    const int y = __builtin_amdgcn_update_dpp(0, __builtin_bit_cast(int, x), CTRL, 0xf, 0xf, false);
    return x + __builtin_bit_cast(float, y);
}
__device__ __forceinline__ float allreduce16(float x) {
    x = dpp_add<0xB1>(x);
    x = dpp_add<0x4E>(x);
    x = dpp_add<0x141>(x);
    x = dpp_add<0x140>(x);
    return x;
}
__device__ __forceinline__ float allreduce8(float x) {
    x = dpp_add<0xB1>(x); x = dpp_add<0x4E>(x); x = dpp_add<0x141>(x);
    return x;
}
__device__ __forceinline__ void lerp8(const u32x4 cur, const u32x4 prv, const f32x4 m0, const f32x4 m1, float (&v)[8]) {
#pragma unroll
    for (int i = 0; i < 4; ++i) { const float cl = bflo(cur[i]), ch = bfhi(cur[i]), pl = bflo(prv[i]), ph = bfhi(prv[i]);
        const float ma = (i < 2) ? m0[2 * i] : m1[2 * i - 4], mb = (i < 2) ? m0[2 * i + 1] : m1[2 * i - 3];
        v[2 * i] = cl + (pl - cl) * ma; v[2 * i + 1] = ch + (ph - ch) * mb; }
}
}

__device__ __forceinline__ void rwkv_phase(LAS unsigned char* lds, const Ptrs& P, int tid) {
    using namespace rw;
    const int wv = __builtin_amdgcn_readfirstlane(tid >> 6), lane = tid & 63, fr = lane & 15, fq = lane >> 4;
    const bf16* Pb = P.P;
    const float* mu = P.mu; const float* g_w0 = P.w0; const float* g_a0 = P.a0; const float* g_kk = P.k_k; const float* g_ka = P.k_a; const float* g_rk = P.r_k;
    const float* g_lw = P.ln_w; const float* g_lb = P.ln_b; bf16* mix = P.mix;
    const int pw = wv & 3;
    const int ptt = lane >> 3, c8 = (lane & 7) * 8;
    const int trow = pw * 8 + ptt;
    LAS unsigned char* stw = lds + L_ST + pw * 2 * ST_W; LAS unsigned char* sta = stw + ST_W;
    for (int bh = blockIdx.x; bh < NBATCH * NH; bh += gridDim.x) {
        const int b = bh >> 4, h = bh & 15;
        const bf16* pR = Pb + (size_t)bh * 2048 * 64; const bf16* pK = pR + SEC; const bf16* pV = pR + 2 * SEC; const bf16* pG = pR + 3 * SEC;
        const bf16* pL = Pb + 4 * SEC + (size_t)b * 2048 * 128;
        bf16x8 bw[4][2], ba[4][2];
        if (wv >= 4) {
#pragma unroll
            for (int nt = 0; nt < 4; ++nt)
#pragma unroll
                for (int ks = 0; ks < 2; ++ks) { bw[nt][ks] = *(const bf16x8*)(P.wupT + (size_t)(h * 64 + nt * 16 + fr) * 64 + ks * 32 + fq * 8);
                                                 ba[nt][ks] = *(const bf16x8*)(P.aupT + (size_t)(h * 64 + nt * 16 + fr) * 64 + ks * 32 + fq * 8); }
        }
        f32x2 S2[4][2];
#pragma unroll
        for (int i = 0; i < 4; ++i) { S2[i][0] = (f32x2){0.f, 0.f}; S2[i][1] = (f32x2){0.f, 0.f}; }
        for (int c = -1; c <= NCH; ++c) {
            if (wv < 4) {
                if (c >= 0 && c < NCH) {
                    __builtin_amdgcn_s_setprio(3);
                    const int rg = lane >> 4, kg = lane & 15;
                    const LAS float* bb = (const LAS float*)(lds + L_B + (c & 1) * BUF) + kg * 4;
                    const LAS float* pv = (const LAS float*)(lds + L_V + (c % 3) * 8192) + wv * 16 + rg * 4;
                    LAS float* py = (LAS float*)(lds + L_Y + (c & 1) * 8192) + wv * 16 + rg * 4;
                    const bool hi8 = (kg & 8) != 0, hi4 = (kg & 4) != 0; const int yrow = ((kg >> 3) & 1) + 2 * ((kg >> 2) & 1);
                    f32x4 n_dec = *(const LAS f32x4*)(bb + O_DEC / 4), n_bv = *(const LAS f32x4*)(bb + O_BV / 4), n_kk = *(const LAS f32x4*)(bb + O_K / 4),
                          n_rr = *(const LAS f32x4*)(bb + O_R / 4), n_av = *(const LAS f32x4*)(bb + O_AV / 4), n_vv = *(const LAS f32x4*)pv;
#pragma unroll 2
                    for (int t = 0; t < T; ++t) {
                        const f32x4 dec = n_dec, bv = n_bv, kk = n_kk, rr = n_rr, av = n_av, vv = n_vv;
                        const int tn = (t + 1 < T) ? t + 1 : t;
                        n_dec = *(const LAS f32x4*)(bb + O_DEC / 4 + tn * 64); n_bv = *(const LAS f32x4*)(bb + O_BV / 4 + tn * 64); n_kk = *(const LAS f32x4*)(bb + O_K / 4 + tn * 64);
                        n_rr = *(const LAS f32x4*)(bb + O_R / 4 + tn * 64); n_av = *(const LAS f32x4*)(bb + O_AV / 4 + tn * 64); n_vv = *(const LAS f32x4*)(pv + tn * 64);
                        const f32x2 av01 = (f32x2){av[0], av[1]}, av23 = (f32x2){av[2], av[3]}, de01 = (f32x2){dec[0], dec[1]}, de23 = (f32x2){dec[2], dec[3]};
                        const f32x2 bv01 = (f32x2){bv[0], bv[1]}, bv23 = (f32x2){bv[2], bv[3]}, kk01 = (f32x2){kk[0], kk[1]}, kk23 = (f32x2){kk[2], kk[3]};
                        const f32x2 rr01 = (f32x2){rr[0], rr[1]}, rr23 = (f32x2){rr[2], rr[3]};
                        float sa[4];
#pragma unroll
                        for (int i = 0; i < 4; ++i) { const f32x2 q = S2[i][0] * av01 + S2[i][1] * av23; sa[i] = q.x + q.y; }
#pragma unroll
                        for (int i = 0; i < 4; ++i) sa[i] = allreduce16(sa[i]);
#pragma unroll
                        for (int i = 0; i < 4; ++i) {
                            const f32x2 s2 = (f32x2){sa[i], sa[i]}, v2 = (f32x2){vv[i], vv[i]};
                            S2[i][0] = S2[i][0] * de01 + s2 * bv01 + v2 * kk01;
                            S2[i][1] = S2[i][1] * de23 + s2 * bv23 + v2 * kk23;
                        }
                        float y[4];
#pragma unroll
                        for (int i = 0; i < 4; ++i) { const f32x2 q = S2[i][0] * rr01 + S2[i][1] * rr23; y[i] = q.x + q.y; }
                        const float e0 = dpp_add<0x128>(y[0]), e1 = dpp_add<0x128>(y[1]), e2 = dpp_add<0x128>(y[2]), e3 = dpp_add<0x128>(y[3]);
                        const float z01 = hi8 ? e1 : e0, z23 = hi8 ? e3 : e2;
                        const float g0 = dpp_add<0x141>(z01), g1 = dpp_add<0x141>(z23);
                        float w = hi4 ? g1 : g0;
                        w = dpp_add<0xB1>(w); w = dpp_add<0x4E>(w);
                        if ((kg & 3) == 0) py[t * 64 + yrow] = w;
                    }
                    __builtin_amdgcn_s_setprio(0);
                }
            } else {
                if (c >= 1) {
                    const int cp = c - 1, t = cp * T + trow, o = trow * 64 + c8;
                    const LAS float* aY = (const LAS float*)(lds + L_Y + (cp & 1) * 8192); const LAS float* aV = (const LAS float*)(lds + L_V + (cp % 3) * 8192);
                    const u32x4 g = *(const u32x4*)(pG + (size_t)t * 64 + c8);
                    const f32x4 lw0 = *(const f32x4*)(g_lw + h * 64 + c8), lw1 = *(const f32x4*)(g_lw + h * 64 + c8 + 4);
                    const f32x4 lb0 = *(const f32x4*)(g_lb + h * 64 + c8), lb1 = *(const f32x4*)(g_lb + h * 64 + c8 + 4);
                    const f32x4 y0 = *(const LAS f32x4*)(aY + o), y1 = *(const LAS f32x4*)(aY + o + 4), v0 = *(const LAS f32x4*)(aV + o), v1 = *(const LAS f32x4*)(aV + o + 4);
                    const float bon = ((const LAS float*)(lds + L_BON))[(cp % 3) * T + trow];
                    const float s = allreduce8((y0.x + y0.y) + (y0.z + y0.w) + (y1.x + y1.y) + (y1.z + y1.w));
                    const float mean = s * (1.f / 64.f);
                    const f32x4 d0 = y0 - mean, d1 = y1 - mean;
                    const float q = allreduce8((d0.x * d0.x + d0.y * d0.y) + (d0.z * d0.z + d0.w * d0.w) + (d1.x * d1.x + d1.y * d1.y) + (d1.z * d1.z + d1.w * d1.w));
                    const float rstd = 1.f / sqrtf(q * (1.f / 64.f) + GN_EPS);
                    const f32x4 e0 = d0 * rstd * lw0 + lb0 + bon * v0, e1 = d1 * rstd * lw1 + lb1 + bon * v1;
                    u32x4 ov;
                    ov.x = pk2(e0.x * silu(bflo(g.x)), e0.y * silu(bfhi(g.x))); ov.y = pk2(e0.z * silu(bflo(g.y)), e0.w * silu(bfhi(g.y)));
                    ov.z = pk2(e1.x * silu(bflo(g.z)), e1.y * silu(bfhi(g.z))); ov.w = pk2(e1.z * silu(bflo(g.w)), e1.w * silu(bfhi(g.w)));
                    *(u32x4*)(mix + ((size_t)b * SEQ + t) * MIXW + h * 64 + c8) = ov;
                }
                if (c + 1 < NCH) {
                    const int cn = c + 1, t = cn * T + trow, o = trow * 64 + c8;
                    LAS float* B = (LAS float*)(lds + L_B + (cn & 1) * BUF);
                    LAS float* aV = (LAS float*)(lds + L_V + (cn % 3) * 8192);
                    const bf16* sR = pR + (size_t)t * 64 + c8; const bf16* sK = pK + (size_t)t * 64 + c8; const bf16* sV = pV + (size_t)t * 64 + c8;
                    const bf16* sW = pL + (size_t)t * 128 + c8; const bf16* sA = sW + 64;
                    const u32x4 zz = (u32x4){0u, 0u, 0u, 0u};
                    const u32x4 cR = *(const u32x4*)sR, cK = *(const u32x4*)sK, cV = *(const u32x4*)sV, cW = *(const u32x4*)sW, cA = *(const u32x4*)sA;
                    u32x4 qR = zz, qK = zz, qV = zz, qW = zz, qA = zz;
                    if (t > 0) { qR = *(const u32x4*)(sR - 64); qK = *(const u32x4*)(sK - 64); qV = *(const u32x4*)(sV - 64); qW = *(const u32x4*)(sW - 128); qA = *(const u32x4*)(sA - 128); }
                    const int hc = h * 64 + c8;
                    float v[8];
                    lerp8(cR, qR, *(const f32x4*)(mu + hc), *(const f32x4*)(mu + hc + 4), v);
                    *(LAS f32x4*)(B + O_R / 4 + o) = (f32x4){v[0], v[1], v[2], v[3]}; *(LAS f32x4*)(B + O_R / 4 + o + 4) = (f32x4){v[4], v[5], v[6], v[7]};
                    const f32x4 r0 = (f32x4){v[0], v[1], v[2], v[3]}, r1 = (f32x4){v[4], v[5], v[6], v[7]};
                    lerp8(cV, qV, *(const f32x4*)(mu + 2048 + hc), *(const f32x4*)(mu + 2048 + hc + 4), v);
                    *(LAS f32x4*)(aV + o) = (f32x4){v[0], v[1], v[2], v[3]}; *(LAS f32x4*)(aV + o + 4) = (f32x4){v[4], v[5], v[6], v[7]};
                    lerp8(cW, qW, *(const f32x4*)(mu + 3072 + c8), *(const f32x4*)(mu + 3072 + c8 + 4), v);
#pragma unroll
                    for (int i = 0; i < 8; ++i) v[i] = 1.f - 2.f / (1.f + __expf(2.f * v[i]));
                    { u32x4 ow; ow.x = pk2(v[0], v[1]); ow.y = pk2(v[2], v[3]); ow.z = pk2(v[4], v[5]); ow.w = pk2(v[6], v[7]); *(LAS u32x4*)(stw + ptt * WLS + c8 * 2) = ow; }
                    lerp8(cA, qA, *(const f32x4*)(mu + 3136 + c8), *(const f32x4*)(mu + 3136 + c8 + 4), v);
                    { u32x4 ow; ow.x = pk2(v[0], v[1]); ow.y = pk2(v[2], v[3]); ow.z = pk2(v[4], v[5]); ow.w = pk2(v[6], v[7]); *(LAS u32x4*)(sta + ptt * WLS + c8 * 2) = ow; }
                    lerp8(cK, qK, *(const f32x4*)(mu + 1024 + hc), *(const f32x4*)(mu + 1024 + hc + 4), v);
                    const f32x4 k0 = (f32x4){v[0], v[1], v[2], v[3]}, k1 = (f32x4){v[4], v[5], v[6], v[7]};
                    {
                        bf16x8 aw[2], aa[2];
#pragma unroll
                        for (int ks = 0; ks < 2; ++ks) { aw[ks] = *(const LAS bf16x8*)(stw + fr * WLS + (ks * 32 + fq * 8) * 2); aa[ks] = *(const LAS bf16x8*)(sta + fr * WLS + (ks * 32 + fq * 8) * 2); }
#pragma unroll
                        for (int nt = 0; nt < 4; ++nt) {
                            f32x4 accw = (f32x4){0.f, 0.f, 0.f, 0.f}, acca = (f32x4){0.f, 0.f, 0.f, 0.f};
#pragma unroll
                            for (int ks = 0; ks < 2; ++ks) { accw = __builtin_amdgcn_mfma_f32_16x16x32_bf16(aw[ks], bw[nt][ks], accw, 0, 0, 0);
                                                             acca = __builtin_amdgcn_mfma_f32_16x16x32_bf16(aa[ks], ba[nt][ks], acca, 0, 0, 0); }
                            if (fq < 2) {
#pragma unroll
                                for (int j = 0; j < 4; ++j) { const int oo = (pw * 8 + fq * 4 + j) * 64 + nt * 16 + fr; B[O_DEC / 4 + oo] = accw[j]; B[O_BV / 4 + oo] = acca[j]; }
                            }
                        }
                    }
                    {
                        const f32x4 wr0 = *(const LAS f32x4*)(B + O_DEC / 4 + o), wr1 = *(const LAS f32x4*)(B + O_DEC / 4 + o + 4), ar0 = *(const LAS f32x4*)(B + O_BV / 4 + o), ar1 = *(const LAS f32x4*)(B + O_BV / 4 + o + 4);
                        const f32x4 w00 = *(const f32x4*)(g_w0 + hc), w01 = *(const f32x4*)(g_w0 + hc + 4), a00 = *(const f32x4*)(g_a0 + hc), a01 = *(const f32x4*)(g_a0 + hc + 4);
                        const f32x4 kk0 = *(const f32x4*)(g_kk + hc), kk1 = *(const f32x4*)(g_kk + hc + 4), ka0 = *(const f32x4*)(g_ka + hc), ka1 = *(const f32x4*)(g_ka + hc + 4);
                        const f32x4 rk0 = *(const f32x4*)(g_rk + hc), rk1 = *(const f32x4*)(g_rk + hc + 4);
                        f32x4 dec0, dec1, a0v, a1v;
#pragma unroll
                        for (int i = 0; i < 4; ++i) {
                            { const float z = -(w00[i] + wr0[i]); const float sp = fmaxf(z, 0.f) + __logf(1.f + __expf(-fabsf(z))); dec0[i] = __expf(-__expf(-sp - 0.5f)); a0v[i] = 1.f / (1.f + __expf(-(a00[i] + ar0[i]))); }
                            { const float z = -(w01[i] + wr1[i]); const float sp = fmaxf(z, 0.f) + __logf(1.f + __expf(-fabsf(z))); dec1[i] = __expf(-__expf(-sp - 0.5f)); a1v[i] = 1.f / (1.f + __expf(-(a01[i] + ar1[i]))); }
                        }
                        f32x4 n0 = k0 * kk0, n1 = k1 * kk1;
                        const float ss = allreduce8((n0.x * n0.x + n0.y * n0.y) + (n0.z * n0.z + n0.w * n0.w) + (n1.x * n1.x + n1.y * n1.y) + (n1.z * n1.z + n1.w * n1.w));
                        const float inv = 1.f / fmaxf(sqrtf(ss), 1e-12f);
                        n0 = n0 * inv; n1 = n1 * inv;
                        const f32x4 kp0 = k0 * (1.f + (a0v - 1.f) * ka0), kp1 = k1 * (1.f + (a1v - 1.f) * ka1);
                        const f32x4 bq0 = r0 * kp0 * rk0, bq1 = r1 * kp1 * rk1;
                        const float bon = allreduce8((bq0.x + bq0.y) + (bq0.z + bq0.w) + (bq1.x + bq1.y) + (bq1.z + bq1.w));
                        *(LAS f32x4*)(B + O_DEC / 4 + o) = dec0; *(LAS f32x4*)(B + O_DEC / 4 + o + 4) = dec1;
                        *(LAS f32x4*)(B + O_K / 4 + o) = kp0; *(LAS f32x4*)(B + O_K / 4 + o + 4) = kp1;
                        *(LAS f32x4*)(B + O_AV / 4 + o) = -n0; *(LAS f32x4*)(B + O_AV / 4 + o + 4) = -n1;
                        *(LAS f32x4*)(B + O_BV / 4 + o) = n0 * a0v; *(LAS f32x4*)(B + O_BV / 4 + o + 4) = n1 * a1v;
                        if ((lane & 7) == 0) ((LAS float*)(lds + L_BON))[(cn % 3) * T + trow] = bon;
                    }
                }
            }
            __syncthreads();
        }
    }
}

namespace att { constexpr int KST = 144, NSL = 3, VST = NSL * 256 + 16, L_K = 0, L_V = NSL * 128 * KST; static_assert(L_V + 64 * VST <= LDS_BYTES, "att LDS"); constexpr size_t SEC = (size_t)256 * 2048 * 64; }

__device__ __forceinline__ void attn_phase(LAS unsigned char* lds, const Ptrs& P, int tid) {
    using namespace att;
    const int wv = __builtin_amdgcn_readfirstlane(tid >> 6), lane = tid & 63, fr = lane & 15, fq = lane >> 4;
    const float NEG = -__builtin_inff();
    bf16* const po1 = P.o1; bf16* const po2 = P.o2; bf16* const po3 = P.o3; float* const plse = P.lse; bf16* const mix = P.mix;
    for (int i = tid; i < 64 * VST / 16; i += NTHR) *(LAS u32x4*)(lds + L_V + i * 16) = (u32x4){0u, 0u, 0u, 0u};
    __syncthreads();
    const int i0 = wv * 16, qi = i0 + fr, ks0 = i0 < 96 ? i0 : 96;
    const int kkey0 = tid >> 3, kpc = tid & 7, vpc = tid >> 6, vkp = tid & 63;
    for (int bh = blockIdx.x; bh < NBATCH * NH; bh += gridDim.x) {
        const int b = bh >> 4, h = bh & 15;
        const bf16* pQ = P.P + (size_t)bh * 2048 * 64; const bf16* pK = pQ + SEC; const bf16* pV = pQ + 2 * SEC; const bf16* pG = pQ + 3 * SEC;
        u32x4 rk0, rk1, rv0, rv1; bf16x8 rq0, rq1;
#define ATT_LOAD(G) do { const int p_ = (G) >> 4, u_ = (G) & 15, sh_ = 2 * p_, r_ = u_ >> (4 - sh_), n_ = u_ & ((16 >> sh_) - 1); \
            const int lb_ = n_ * 128; \
            rk0 = *(const u32x4*)(pK + (size_t)(((lb_ + kkey0) << sh_) + r_) * 64 + kpc * 8); rk1 = *(const u32x4*)(pK + (size_t)(((lb_ + 64 + kkey0) << sh_) + r_) * 64 + kpc * 8); \
            rv0 = *(const u32x4*)(pV + (size_t)(((lb_ + 2 * vkp) << sh_) + r_) * 64 + vpc * 8); rv1 = *(const u32x4*)(pV + (size_t)(((lb_ + 2 * vkp + 1) << sh_) + r_) * 64 + vpc * 8); \
            const size_t tq_ = (size_t)(((lb_ + qi) << sh_) + r_); rq0 = *(const bf16x8*)(pQ + tq_ * 64 + fq * 8); rq1 = *(const bf16x8*)(pQ + tq_ * 64 + 32 + fq * 8); } while (0)
        ATT_LOAD(0);
        for (int g = 0; g < 48; ++g) {
            const int p = g >> 4, u = g & 15, sh = 2 * p, r = u >> (4 - sh), n = u & ((16 >> sh) - 1);
            const int scur = g % 3, sprev = (g + 2) % 3;
            *(LAS u32x4*)(lds + L_K + (scur * 128 + kkey0) * KST + kpc * 16) = rk0;
            *(LAS u32x4*)(lds + L_K + (scur * 128 + 64 + kkey0) * KST + kpc * 16) = rk1;
#pragma unroll
            for (int m = 0; m < 4; ++m) {
                const unsigned lo = (rv0[m] & 0xffffu) | (rv1[m] << 16), hi = (rv0[m] >> 16) | (rv1[m] & 0xffff0000u);
                *(LAS unsigned*)(lds + L_V + (vpc * 8 + 2 * m) * VST + (scur * 128 + 2 * vkp) * 2) = lo;
                *(LAS unsigned*)(lds + L_V + (vpc * 8 + 2 * m + 1) * VST + (scur * 128 + 2 * vkp) * 2) = hi;
            }
            const bf16x8 qf0 = rq0, qf1 = rq1;
            __syncthreads();
            if (g + 1 < 48) ATT_LOAD(g + 1);
            const size_t tokq = (size_t)(((n * 128 + qi) << sh) + r);
            bf16* OP = ((p == 0) ? po1 : (p == 1 ? po2 : po3)) + (size_t)bh * 2048 * 64;
            float* LSE = plse + (size_t)p * MTOK * 16 + (size_t)bh * 2048;
            f32x4 st[10];
#pragma unroll
            for (int kt = 0; kt < 10; ++kt) {
                const int kb = ks0 + kt * 16, pos = ((kb >> 7) ? scur : sprev) * 128 + (kb & 127);
                const LAS unsigned char* kp = lds + L_K + (pos + fr) * KST + fq * 16;
                f32x4 acc = (f32x4){0.f, 0.f, 0.f, 0.f};
                acc = __builtin_amdgcn_mfma_f32_16x16x32_bf16(*(const LAS bf16x8*)kp, qf0, acc, 0, 0, 0);
                acc = __builtin_amdgcn_mfma_f32_16x16x32_bf16(*(const LAS bf16x8*)(kp + 64), qf1, acc, 0, 0, 0);
                st[kt] = acc;
            }
            const int lo = (n == 0 && qi < 128) ? 128 : qi;
            const int dl = ks0 + 4 * fq - lo; const unsigned span = (unsigned)(qi + 128 - lo);
            float m = NEG;
#pragma unroll
            for (int kt = 0; kt < 10; ++kt)
#pragma unroll
                for (int j = 0; j < 4; ++j) {
                    const bool valid = (unsigned)(dl + kt * 16 + j) <= span;
                    const float s = valid ? st[kt][j] : NEG;
                    st[kt][j] = s; m = fmaxf(m, s);
                }
            m = fmaxf(m, __shfl_xor(m, 16)); m = fmaxf(m, __shfl_xor(m, 32));
            const float C = 0.125f * 1.4426950408889634f, mc = m * C;
            float ls = 0.f;
#pragma unroll
            for (int kt = 0; kt < 10; ++kt)
#pragma unroll
                for (int j = 0; j < 4; ++j) { const float pe = __builtin_amdgcn_exp2f(st[kt][j] * C - mc); st[kt][j] = pe; ls += pe; }
            ls += __shfl_xor(ls, 16); ls += __shfl_xor(ls, 32);
            f32x4 oacc[4];
#pragma unroll
            for (int dt = 0; dt < 4; ++dt) oacc[dt] = (f32x4){0.f, 0.f, 0.f, 0.f};
#pragma unroll
            for (int s5 = 0; s5 < 5; ++s5) {
                u32x4 pw; pw.x = pk2(st[2 * s5][0], st[2 * s5][1]); pw.y = pk2(st[2 * s5][2], st[2 * s5][3]);
                pw.z = pk2(st[2 * s5 + 1][0], st[2 * s5 + 1][1]); pw.w = pk2(st[2 * s5 + 1][2], st[2 * s5 + 1][3]);
                const bf16x8 pb = __builtin_bit_cast(bf16x8, pw);
                const int kb0 = ks0 + 32 * s5, kb1 = kb0 + 16;
                const int pos0 = ((kb0 >> 7) ? scur : sprev) * 128 + (kb0 & 127) + 4 * fq, pos1 = ((kb1 >> 7) ? scur : sprev) * 128 + (kb1 & 127) + 4 * fq;
#pragma unroll
                for (int dt = 0; dt < 4; ++dt) {
                    const LAS unsigned char* vp = lds + L_V + (dt * 16 + fr) * VST;
                    const u32x2 lo2 = *(const LAS u32x2*)(vp + pos0 * 2), hi2 = *(const LAS u32x2*)(vp + pos1 * 2);
                    const u32x4 aw = (u32x4){lo2.x, lo2.y, hi2.x, hi2.y};
                    oacc[dt] = __builtin_amdgcn_mfma_f32_16x16x32_bf16(__builtin_bit_cast(bf16x8, aw), pb, oacc[dt], 0, 0, 0);
                }
            }
            const float inv = 1.f / ls;
#pragma unroll
            for (int dt = 0; dt < 4; ++dt) {
                u32x2 ow; ow.x = pk2(oacc[dt][0] * inv, oacc[dt][1] * inv); ow.y = pk2(oacc[dt][2] * inv, oacc[dt][3] * inv);
                *(u32x2*)(OP + tokq * 64 + dt * 16 + 4 * fq) = ow;
            }
            if (fq == 0) LSE[tokq] = m * 0.125f + __logf(ls);
        }
#undef ATT_LOAD
        __syncthreads();
        for (int pass = 0; pass < SEQ / 64; ++pass) {
            const int t = pass * 64 + (tid >> 3), pc = tid & 7; const size_t row = (size_t)bh * 2048 + t;
            const float l1 = plse[row], l2 = plse[(size_t)MTOK * 16 + row], l3 = plse[(size_t)2 * MTOK * 16 + row];
            const float mx = fmaxf(l1, fmaxf(l2, l3));
            float e1 = __expf(l1 - mx), e2 = __expf(l2 - mx), e3 = __expf(l3 - mx);
            const float inv = 1.f / (e1 + e2 + e3); e1 *= inv; e2 *= inv; e3 *= inv;
            const u32x4 a = *(const u32x4*)(po1 + row * 64 + pc * 8), bb = *(const u32x4*)(po2 + row * 64 + pc * 8), c = *(const u32x4*)(po3 + row * 64 + pc * 8);
            const u32x4 gt = *(const u32x4*)(pG + (size_t)t * 64 + pc * 8);
            u32x4 ov;
#pragma unroll
            for (int i = 0; i < 4; ++i) {
                const float lo = (e1 * bflo(a[i]) + e2 * bflo(bb[i]) + e3 * bflo(c[i])) * silu(bflo(gt[i]));
                const float hi = (e1 * bfhi(a[i]) + e2 * bfhi(bb[i]) + e3 * bfhi(c[i])) * silu(bfhi(gt[i]));
                ov[i] = pk2(lo, hi);
            }
            *(u32x4*)(mix + ((size_t)b * SEQ + t) * MIXW + 1024 + h * 64 + pc * 8) = ov;
        }
        __syncthreads();
    }
}

__device__ __forceinline__ void final_norm(const Ptrs& P, int tid) {
    const int wave = tid >> 6, lane = tid & 63;
    const int gw = blockIdx.x * NWAVES + wave, NGW = gridDim.x * NWAVES;
    for (int m = gw; m < MTOK; m += NGW) {
        float ps = (lane < 16) ? P.part[(size_t)m * 16 + lane] : 0.f;
        ps += __shfl_xor(ps, 1); ps += __shfl_xor(ps, 2); ps += __shfl_xor(ps, 4); ps += __shfl_xor(ps, 8);
        const float ss = __shfl(ps, 0);
        const float rstd = 1.f / sqrtf(ss * (1.f / DM) + RMS_EPS);
        f32x4* o = (f32x4*)(P.out + (size_t)m * DM) + lane; const f32x4* w = (const f32x4*)P.fin_w + lane;
#pragma unroll
        for (int j = 0; j < 4; ++j) { const f32x4 v = o[64 * j]; o[64 * j] = v * rstd * w[64 * j]; }
    }
}

#define XB_TMO      128
#define XB_XCNT(j)  (256  + 64 * (j))
#define XB_XSUB(j)  (1280 + 64 * (j))
#define XB_XGEN(j)  (2304 + 64 * (j))
#define XB_TOP      3328
#define XB_TOPGEN   3392
#define XCD_BAR_WORDS 3456
#define XB_SPIN_CAP (1u << 18)

__device__ __forceinline__ unsigned xb_ld(unsigned* p)              { return __hip_atomic_load(p, __ATOMIC_RELAXED, __HIP_MEMORY_SCOPE_AGENT); }
__device__ __forceinline__ unsigned xb_add(unsigned* p, unsigned v) { return __hip_atomic_fetch_add(p, v, __ATOMIC_RELAXED, __HIP_MEMORY_SCOPE_AGENT); }
__device__ __forceinline__ unsigned xb_xcc_id() { return (unsigned)__builtin_amdgcn_s_getreg((3 << 11) | 20) & 0xFu; }
#define XB_SPIN(cond, bar) do { unsigned _sp = 0; while (cond) { __builtin_amdgcn_s_sleep(1); \
    if ((++_sp & 255u) == 0u) { if (xb_ld(&(bar)[XB_TMO])) break; if (_sp > XB_SPIN_CAP) { atomicAdd(&(bar)[XB_TMO], 1u); break; } } } } while (0)

struct XcdBarrier {
    unsigned* bar; unsigned x;
    volatile LAS unsigned* st;
};

__device__ __forceinline__ XcdBarrier xcd_barrier_post(unsigned* bar, volatile LAS unsigned* st) {
    XcdBarrier b; b.bar = bar; b.x = xb_xcc_id(); b.st = st;
    if (threadIdx.x == 0) (void)xb_add(&bar[XB_XCNT(b.x)], 1u);
    return b;
}
__device__ __forceinline__ void xcd_barrier_complete(unsigned* bar, unsigned x, unsigned& nloc, unsigned& nx) {
    const unsigned G = gridDim.x * gridDim.y * gridDim.z;
    unsigned sum, cnt, mine, sp = 0u;
    for (;;) {
        sum = 0u; cnt = 0u; mine = 0u;
#pragma unroll
        for (unsigned j = 0; j < 16; ++j) { const unsigned c = xb_ld(&bar[XB_XCNT(j)]); sum += c; cnt += (c > 0u) ? 1u : 0u; mine = (j == x) ? c : mine; }
        if (sum == G) break;
        __builtin_amdgcn_s_sleep(1);
        if ((++sp & 255u) == 0u) { if (xb_ld(&bar[XB_TMO])) break; if (sp > XB_SPIN_CAP) { atomicAdd(&bar[XB_TMO], 1u); break; } }
    }
    nloc = mine > 0u ? mine : 1u; nx = cnt > 0u ? cnt : 1u;
}

__device__ __forceinline__ void xcd_barrier(const XcdBarrier& b) {
    asm volatile("s_waitcnt vmcnt(0)" ::: "memory");
    __syncthreads();
    if (threadIdx.x == 0) {
        unsigned* bar = b.bar;
        __builtin_amdgcn_s_waitcnt(0);
        unsigned nloc = b.st[0], nx = b.st[1];
        if (nloc == 0u) { xcd_barrier_complete(bar, b.x, nloc, nx); b.st[0] = nloc; b.st[1] = nx; }
        const unsigned old = xb_add(&bar[XB_XSUB(b.x)], 1u);
        const unsigned gen = old / nloc;
        if (old + 1u == (gen + 1u) * nloc) {
            __builtin_amdgcn_fence(__ATOMIC_RELEASE, "agent");
            asm volatile("s_waitcnt vmcnt(0)" ::: "memory");
            const unsigned og = xb_add(&bar[XB_TOP], 1u);
            const unsigned tg = og / nx;
            if (og + 1u == (tg + 1u) * nx) xb_add(&bar[XB_TOPGEN], 1u);
            else XB_SPIN(xb_ld(&bar[XB_TOPGEN]) == tg, bar);
            __builtin_amdgcn_fence(__ATOMIC_ACQUIRE, "agent");
            xb_add(&bar[XB_XGEN(b.x)], 1u);
            asm volatile("s_waitcnt vmcnt(0)" ::: "memory");
        } else {
            XB_SPIN(xb_ld(&bar[XB_XGEN(b.x)]) == gen, bar);
            __builtin_amdgcn_fence(__ATOMIC_ACQUIRE, "agent");
            asm volatile("s_waitcnt vmcnt(0)" ::: "memory");
        }
    }
    __syncthreads();
}

struct Args { const float* in[15]; float* out; unsigned char* ws; int mask; int sync; };
#ifndef MK_MULTI
#define MK_MULTI 0
#endif
#ifndef MK_REP
#define MK_REP 0
#endif
#ifndef MK_MASK
#define MK_MASK 0x7f
#endif
__global__ void __launch_bounds__(NTHR, 2) fwd_kernel(Args a) {
    extern __shared__ __attribute__((aligned(16))) unsigned char lds_[];
    LAS unsigned char* lds = (LAS unsigned char*)lds_;
    cg::grid_group grid = cg::this_grid();
    const int tid = threadIdx.x;
    Ptrs P;
    P.x = a.in[0]; P.norm_w = a.in[1]; P.w_in = a.in[2]; P.mu = a.in[3]; P.w0 = a.in[4]; P.w_up = a.in[5]; P.a0 = a.in[6]; P.a_up = a.in[7];
    P.k_k = a.in[8]; P.k_a = a.in[9]; P.r_k = a.in[10]; P.ln_w = a.in[11]; P.ln_b = a.in[12]; P.w_out = a.in[13]; P.fin_w = a.in[14];
    P.out = a.out; unsigned char* ws = a.ws;
    P.part = (float*)(ws + WS_PART); P.lse = (float*)(ws + WS_LSE);
    P.wtin = (bf16*)(ws + WS_WTIN); P.wtout = (bf16*)(ws + WS_WTOUT); P.wupT = (bf16*)(ws + WS_WUPT); P.aupT = (bf16*)(ws + WS_AUPT);
    P.mix = (bf16*)(ws + WS_MIX); P.P = (bf16*)(ws + WS_P); P.xb = (bf16*)(ws + WS_XB);
    P.o1 = (bf16*)a.out; P.o2 = (bf16*)a.out + (size_t)MTOK * DM; P.o3 = (bf16*)(ws + WS_XB);
    const int mask = a.mask;
    volatile LAS unsigned* xst = (volatile LAS unsigned*)(lds + LDS_BYTES - 64);
    if (tid < 16) xst[tid] = 0u;
    __syncthreads();
    XcdBarrier xbar; xbar.bar = (unsigned*)(ws + WS_CTL) + 4096; xbar.x = 0; xbar.st = xst;
    if (a.sync) xbar = xcd_barrier_post((unsigned*)(ws + WS_CTL) + 4096, xst);
#define SEAM() do { if (a.sync) xcd_barrier(xbar); } while (0)
#define SEAM_CG() do { if (a.sync) grid.sync(); } while (0)
    if (mask & 1) p0_prologue(lds, P, tid, (mask & 0x80) != 0);
    SEAM_CG();
    if (mask & 2) {
        pg8::Gemm g{P.xb, P.wtin, MTOK, PA, DM}; pg8::StaticOrder S; S.init(MTOK, PA, gridDim.x, (int)blockIdx.x);
        pg8::EpiHM<1> E{P.P};
        pg8::gemm_phase<pg8::EpiHM<1>, pg8::StaticOrder, true, true>(lds, g, S, E);
    }
    SEAM();
    if (mask & 4) for (int rep = 0; rep < ((MK_REP & 4) ? 2 : 1); ++rep) rwkv_phase(lds, P, tid);
    SEAM();
    if (mask & 8) {
        pg8::Gemm g{P.xb, P.wtin + (size_t)PA * DM, MTOK, PB, DM}; pg8::StaticOrder S; S.init(MTOK, PB, gridDim.x, (int)blockIdx.x);
        pg8::EpiHM<0> E{P.P};
        pg8::gemm_phase<pg8::EpiHM<0>, pg8::StaticOrder, true, true>(lds, g, S, E);
    }
    SEAM();
    if (mask & 16) for (int rep = 0; rep < ((MK_REP & 16) ? 2 : 1); ++rep) attn_phase(lds, P, tid);
    SEAM();
    if (mask & 32) {
        pg8::Gemm g{P.mix, P.wtout, MTOK, DM, MIXW}; pg8::StaticOrder S; S.init(MTOK, DM, gridDim.x, (int)blockIdx.x);
        pg8::EpiResF32 E{P.x, P.out, P.part, DM};
        pg8::gemm_phase<pg8::EpiResF32, pg8::StaticOrder, true, true>(lds, g, S, E);
    }
    SEAM();
    if (mask & 64) final_norm(P, tid);
}

extern "C" void kernel_launch(void* const* d_in, const int* in_sizes, int n_in, void* d_out, int out_size, void* d_ws, size_t ws_size, hipStream_t stream) {
    static int grid = 0;
    if (grid == 0) {
        if (n_in != 15 || in_sizes[0] != MTOK * DM || out_size != MTOK * DM || ws_size < WS_END) {
            fprintf(stderr, "kernel_launch: unexpected shapes / workspace (n_in %d, ws %zu, need %zu); nothing launched\n", n_in, ws_size, (size_t)WS_END); grid = -1; return; }
        int dev = 0, cus = 0, per_cu = 0;
        if (hipGetDevice(&dev) != hipSuccess || hipDeviceGetAttribute(&cus, hipDeviceAttributeMultiprocessorCount, dev) != hipSuccess) { grid = -1; return; }
        if (hipFuncSetAttribute((const void*)fwd_kernel, hipFuncAttributeMaxDynamicSharedMemorySize, LDS_BYTES) != hipSuccess) { fprintf(stderr, "kernel_launch: hipFuncSetAttribute failed\n"); grid = -1; return; }
        if (hipOccupancyMaxActiveBlocksPerMultiprocessor(&per_cu, (const void*)fwd_kernel, NTHR, LDS_BYTES) != hipSuccess || per_cu < 1) { fprintf(stderr, "kernel_launch: occupancy query says %d blocks per CU\n", per_cu); grid = -1; return; }
        grid = cus;
    }
    if (grid < 0) return;
    if (hipMemsetAsync((char*)d_ws + WS_CTL, 0, 64 * 1024, stream) != hipSuccess) { fprintf(stderr, "kernel_launch: hipMemsetAsync failed\n"); return; }
    Args a{};
    for (int i = 0; i < 15; ++i) a.in[i] = (const float*)d_in[i];
    a.out = (float*)d_out; a.ws = (unsigned char*)d_ws;
#if MK_MULTI
    for (int ph = 0; ph < 7; ++ph) {
        a.mask = (1 << ph) & (MK_MASK); if (ph == 0) a.mask |= (MK_MASK & 0x80); a.sync = 0;
        if (!(a.mask & 0x7f)) continue;
        hipLaunchKernelGGL(fwd_kernel, dim3(grid), dim3(NTHR), LDS_BYTES, stream, a);
    }
#else
    a.mask = MK_MASK; a.sync = 1;
    void* args[] = {&a};
    hipError_t e = hipLaunchCooperativeKernel((void*)fwd_kernel, dim3(grid), dim3(NTHR), args, LDS_BYTES, stream);
    if (e != hipSuccess) fprintf(stderr, "cooperative launch failed: %s (grid %d)\n", hipGetErrorString(e), grid);
#endif
}
```

```cpp
#include <hip/hip_runtime.h>
#include <hip/hip_cooperative_groups.h>
#include <cstdio>
#include <cstdint>
namespace cg = cooperative_groups;
#define MK_MULTI 0
#define MK_MASK 0x7f
#define MK_REP 0
namespace pg8 {
#define PG8_LAS __attribute__((address_space(3)))
typedef unsigned short bf16_t;
typedef short bf16x8 __attribute__((ext_vector_type(8)));
typedef float f32x4 __attribute__((ext_vector_type(4)));
typedef unsigned u32x4 __attribute__((ext_vector_type(4)));
constexpr int BM = 256, BK = 64, HALF = 128, HTB = HALF * BK * 2  , STAGE_BYTES = 8 * HTB, NXCD = 8, WGM = 8;

__host__ __device__ __forceinline__ int lds_byte(int r, int c) { const int st = (r >> 4) * 2 + (c >> 5), rr = r & 15, cc = c & 31, ob = rr * 64 + cc * 2; return st * 1024 + (ob ^ (((ob >> 9) & 1) << 5)); }
__host__ __device__ __forceinline__ void stage_rc(int b, int& R, int& C) { const int st = b / 1024, sb = b % 1024, swz = sb ^ (((sb >> 9) & 1) << 5); R = (st >> 1) * 16 + swz / 64; C = (st & 1) * 32 + (swz % 64) / 2; }
__host__ __device__ __forceinline__ int perm32(int rho) { const int n = rho >> 4, i = rho & 15; return 8 * (i >> 2) + 4 * n + (i & 3); }

struct Unit { int pm, pn; };
struct Gemm { const bf16_t* A; const bf16_t* Bt; int M, N, K; };

struct StaticOrder {
    int nM, nN, nwg, G, c;
    __host__ __device__ void init(int M, int N, int G_, int c_) { nM = M / BM; nN = N / BM; nwg = nM * nN; G = G_; c = c_; }
    __host__ __device__ bool next(int i, Unit& u) const {
        const long L = (long)i * G + c; if (L >= nwg) return false;
        int wgid = (int)L; { const int q = nwg / NXCD, r = nwg % NXCD, xcd = wgid % NXCD, off = wgid / NXCD; wgid = (xcd < r ? xcd * (q + 1) : r * (q + 1) + (xcd - r) * q) + off; }
        const int nig = WGM * nN, gid = wgid / nig, fm = gid * WGM, gsz = (nM - fm) < WGM ? (nM - fm) : WGM;
        u.pm = fm + ((wgid % nig) % gsz); u.pn = (wgid % nig) / gsz; return true;
    }
    __device__ __forceinline__ void a_ready(const Unit&) const {}
    __device__ __forceinline__ void done(const Unit&) const {}
};

__device__ __forceinline__ unsigned cvt_pk_bf16(float lo, float hi) { unsigned r; asm volatile("v_cvt_pk_bf16_f32 %0, %1, %2" : "=v"(r) : "v"(lo), "v"(hi)); return r; }
typedef float f32x2 __attribute__((ext_vector_type(2)));
__device__ __forceinline__ f32x2 gelu_pk(f32x2 v) {
    const f32x2 av = __builtin_elementwise_abs(v), d = av * 0.2316418882f + 1.0f;
    f32x2 t; t.x = __builtin_amdgcn_rcpf(d.x); t.y = __builtin_amdgcn_rcpf(d.y);
    f32x2 q = t * 0.5307027145f + (-0.7265760135f); q = q * t + 0.7107068705f; q = q * t + (-0.142248368f); q = q * t + 0.127414796f; q = q * t;
    const f32x2 s = (v * v) * (-0.72134752044f);
    f32x2 e; e.x = __builtin_amdgcn_exp2f(s.x); e.y = __builtin_amdgcn_exp2f(s.y);
    const f32x2 m = v * (q * e), r = v - m;
    f32x2 o; o.x = v.x < 0.f ? m.x : r.x; o.y = v.y < 0.f ? m.y : r.y; return o;
}

template <int ACT  > struct EpiBf16 {
    static constexpr bool PERM = true, AFTER_DRAIN = false; static_assert(ACT == 0 || ACT == 1, "EpiBf16: ACT is 0 (none) or 1 (gelu_pk)");
    bf16_t* O; int ldc; const float* bias; int split_cols; size_t split_stride; float scale0;
    __device__ __forceinline__ void operator()(const f32x4 (&acc)[2][2][4][2], const Unit& u, int wr, int wc, int fr, int fq) const {
        const int row0 = u.pm * BM + wr * 64 + fr; int colt = u.pn * BM; bf16_t* base = O;
        float sc = 1.f; if (split_cols) { const int t = colt / split_cols; base += (size_t)t * split_stride; colt -= t * split_cols; if (t == 0) sc = scale0; }
        const int col0 = colt + wc * 32 + 8 * fq, bcol0 = u.pn * BM + wc * 32 + 8 * fq;
        f32x4 bv[2][2];
#pragma unroll
        for (int bj = 0; bj < 2; ++bj)
#pragma unroll
            for (int n = 0; n < 2; ++n) bv[bj][n] = bias ? *(const f32x4*)(bias + bcol0 + bj * HALF + 4 * n) : (f32x4){0.f, 0.f, 0.f, 0.f};
#pragma unroll
        for (int ai = 0; ai < 2; ++ai)
#pragma unroll
            for (int m = 0; m < 4; ++m) { bf16_t* rowp = base + (size_t)(row0 + ai * HALF + m * 16) * ldc + col0;
#pragma unroll
                for (int bj = 0; bj < 2; ++bj) { f32x4 v0 = acc[ai][bj][m][0] + bv[bj][0], v1 = acc[ai][bj][m][1] + bv[bj][1];
                    if (ACT == 1) { f32x2 a = gelu_pk((f32x2){v0[0], v0[1]}), b = gelu_pk((f32x2){v0[2], v0[3]}), c = gelu_pk((f32x2){v1[0], v1[1]}), d = gelu_pk((f32x2){v1[2], v1[3]});
                        v0 = (f32x4){a.x, a.y, b.x, b.y}; v1 = (f32x4){c.x, c.y, d.x, d.y}; }
                    v0 = v0 * sc; v1 = v1 * sc; u32x4 w; w.x = cvt_pk_bf16(v0[0], v0[1]); w.y = cvt_pk_bf16(v0[2], v0[3]); w.z = cvt_pk_bf16(v1[0], v1[1]); w.w = cvt_pk_bf16(v1[2], v1[3]);
                    *(u32x4*)(rowp + bj * HALF) = w; } }
    }
};
struct EpiResF32 {
    static constexpr bool PERM = false, AFTER_DRAIN = false;
    const float* base; float* out; float* part; int ldc;
    __device__ __forceinline__ void operator()(const f32x4 (&acc)[2][2][4][2], const Unit& u, int wr, int wc, int fr, int fq) const {
        const int col0 = u.pn * BM + wc * 32 + 4 * fq;
#pragma unroll
        for (int ai = 0; ai < 2; ++ai)
#pragma unroll
            for (int m = 0; m < 4; ++m) {
                const int row = u.pm * BM + ai * HALF + wr * 64 + m * 16 + fr;
                const size_t off = (size_t)row * ldc + col0;
                float ss = 0.f;
#pragma unroll
                for (int bj = 0; bj < 2; ++bj)
#pragma unroll
                    for (int n = 0; n < 2; ++n) {
                        const f32x4 b = *(const f32x4*)(base + off + bj * HALF + n * 16);
                        const f32x4 h = b + acc[ai][bj][m][n];
                        *(f32x4*)(out + off + bj * HALF + n * 16) = h;
                        ss += (h[0] * h[0] + h[1] * h[1]) + (h[2] * h[2] + h[3] * h[3]);
                    }
                ss += __shfl_xor(ss, 16); ss += __shfl_xor(ss, 32);
                if (fq == 0) part[(size_t)row * 16 + u.pn * 4 + wc] = ss;
            }
    }
};
template <int MODE> struct EpiHM {
    static constexpr bool PERM = true, AFTER_DRAIN = false;
    static constexpr size_t SEC = (size_t)256 * 2048 * 64;
    bf16_t* O;
    __device__ __forceinline__ void operator()(const f32x4 (&acc)[2][2][4][2], const Unit& u, int wr, int wc, int fr, int fq) const {
        const int row0 = u.pm * BM + wr * 64 + fr;
        const size_t bterm = (size_t)(row0 >> 11) * (16 * 2048 * 64);
#pragma unroll
        for (int bj = 0; bj < 2; ++bj) {
            const int c0 = u.pn * BM + bj * HALF + wc * 32 + 8 * fq;
            bf16_t* base; bool hm = true, skip = false;
            if (MODE == 0 || c0 < 3072) { base = O + (size_t)(c0 >> 10) * SEC + (size_t)((c0 >> 6) & 15) * (2048 * 64) + (c0 & 63); }
            else if (c0 < 3200) { base = O + 4 * SEC + (c0 - 3072); hm = false; }
            else if (c0 < 4224) { const int c1 = c0 - 3200; base = O + 3 * SEC + (size_t)(c1 >> 6) * (2048 * 64) + (c1 & 63); }
            else { base = O; skip = true; }
            if (skip) continue;
#pragma unroll
            for (int ai = 0; ai < 2; ++ai)
#pragma unroll
                for (int m = 0; m < 4; ++m) {
                    const int row = row0 + ai * HALF + m * 16;
                    bf16_t* p = hm ? base + bterm + (size_t)(row & 2047) * 64 : base + (size_t)row * 128;
                    const f32x4 v0 = acc[ai][bj][m][0], v1 = acc[ai][bj][m][1];
                    u32x4 w; w.x = cvt_pk_bf16(v0[0], v0[1]); w.y = cvt_pk_bf16(v0[2], v0[3]); w.z = cvt_pk_bf16(v1[0], v1[1]); w.w = cvt_pk_bf16(v1[2], v1[3]);
                    *(u32x4*)p = w;
                }
        }
    }
};
template <class Epi, class Sched, bool ALIGN_EPI = false, bool SP2 = false>
__device__ __forceinline__ void gemm_phase(PG8_LAS unsigned char* lds, const Gemm g, const Sched& S, const Epi& E) {
    const int tid = threadIdx.x, wid = __builtin_amdgcn_readfirstlane(tid >> 6), lane = tid & 63, wr = wid >> 2, wc = wid & 3, fr = lane & 15, fq = lane >> 4;
    const int K = g.K, nt = K / BK;
    unsigned voffA[2], voffB[2];
#pragma unroll
    for (int i = 0; i < 2; ++i) { int R, C; stage_rc(tid * 16 + i * 8192, R, C); const int Rb = Epi::PERM ? ((R & ~31) + perm32(R & 31)) : R;
        voffA[i] = (unsigned)(R * K + C) * 2u; voffB[i] = (unsigned)(Rb * K + C) * 2u; }
    const size_t kstep = (size_t)(BK * 2);
    const size_t hstep = (size_t)HALF * K * 2;
    const size_t tstep = 2 * hstep;
    const unsigned ldsw = (unsigned)wid * 1024u;
    const int aoff = lds_byte(wr * 64 + fr, fq * 8), boff = lds_byte(wc * 32 + fr, fq * 8);
#define PG8_SA(b, h) (((b) * 2 + (h)) * HTB)
#define PG8_SB(b, h) ((4 + (b) * 2 + (h)) * HTB)
#define PG8_STAGE(bufoff, gbase, voff) do { _Pragma("unroll") for (int _i = 0; _i < 2; ++_i) \
        __builtin_amdgcn_global_load_lds((const unsigned*)((const char*)(gbase) + (voff)[_i]), (PG8_LAS unsigned*)(lds + (bufoff) + ldsw + _i * 8192), 16, 0, 0); } while (0)
#define PG8_LDA(dst, b, h) do { _Pragma("unroll") for (int m = 0; m < 4; ++m) _Pragma("unroll") for (int k = 0; k < 2; ++k) dst[m][k] = *(const PG8_LAS bf16x8*)(lds + PG8_SA(b, h) + aoff + m * 2048 + k * 1024); } while (0)
#define PG8_LDB(dst, b, h) do { _Pragma("unroll") for (int n = 0; n < 2; ++n) _Pragma("unroll") for (int k = 0; k < 2; ++k) dst[n][k] = *(const PG8_LAS bf16x8*)(lds + PG8_SB(b, h) + boff + n * 2048 + k * 1024); } while (0)
#define PG8_MMA(ai, bj, At, Bt) do { __builtin_amdgcn_s_setprio(1); _Pragma("unroll") for (int m = 0; m < 4; ++m) _Pragma("unroll") for (int n = 0; n < 2; ++n) _Pragma("unroll") for (int k = 0; k < 2; ++k) \
        acc[ai][bj][m][n] = __builtin_amdgcn_mfma_f32_16x16x32_bf16(Bt[n][k], At[m][k], acc[ai][bj][m][n], 0, 0, 0); __builtin_amdgcn_s_setprio(0); } while (0)
#define PG8_WAIT_V(n) asm volatile("s_waitcnt vmcnt(" #n ")" ::: "memory")
#define PG8_WAIT_L(n) asm volatile("s_waitcnt lgkmcnt(" #n ")" ::: "memory")
#define PG8_BAR __builtin_amdgcn_s_barrier()
#define PG8_SCHED __builtin_amdgcn_sched_barrier(0)
    Unit cur, nxt; int ui = 0;
    if (!S.next(0, cur)) return;
    f32x4 acc[2][2][4][2];
#pragma unroll
    for (int a = 0; a < 2; ++a)
#pragma unroll
        for (int b = 0; b < 2; ++b)
#pragma unroll
            for (int m = 0; m < 4; ++m)
#pragma unroll
                for (int n = 0; n < 2; ++n) acc[a][b][m][n] = (f32x4){0.f, 0.f, 0.f, 0.f};
    bf16x8 At[4][2], B0[2][2], B1[2][2];
    const char* cA = (const char*)g.A + (size_t)cur.pm * tstep; const char* cB = (const char*)g.Bt + (size_t)cur.pn * tstep;
    S.a_ready(cur);
    if constexpr (SP2) {
        PG8_STAGE(PG8_SB(0, 0), cB, voffB); PG8_STAGE(PG8_SB(0, 1), cB + hstep, voffB); PG8_STAGE(PG8_SA(0, 0), cA, voffA); PG8_STAGE(PG8_SA(0, 1), cA + hstep, voffA);
        if (wr == 1) PG8_BAR;
        PG8_WAIT_V(2); PG8_BAR;
        PG8_STAGE(PG8_SB(1, 0), cB + kstep, voffB); PG8_STAGE(PG8_SA(1, 0), cA + kstep, voffA); PG8_STAGE(PG8_SB(1, 1), cB + hstep + kstep, voffB);
        PG8_WAIT_V(6); PG8_BAR;
    } else {
        PG8_STAGE(PG8_SB(0, 0), cB, voffB); PG8_STAGE(PG8_SA(0, 0), cA, voffA); PG8_STAGE(PG8_SB(0, 1), cB + hstep, voffB); PG8_STAGE(PG8_SA(0, 1), cA + hstep, voffA);
        if (wr == 1) PG8_BAR;
        PG8_WAIT_V(4); PG8_BAR;
        PG8_STAGE(PG8_SB(1, 0), cB + kstep, voffB); PG8_STAGE(PG8_SA(1, 0), cA + kstep, voffA); PG8_STAGE(PG8_SB(1, 1), cB + hstep + kstep, voffB);
        PG8_WAIT_V(6); PG8_BAR;
    }
    for (;;) {
        const bool has_next = S.next(ui + 1, nxt);
        const char* nA = has_next ? (const char*)g.A + (size_t)nxt.pm * tstep : cA; const char* nB = has_next ? (const char*)g.Bt + (size_t)nxt.pn * tstep : cB;
        for (int t = 0; t < nt; t += 2) {
            const bool last = (t == nt - 2);
            const char* a1 = cA + (size_t)(t + 1) * kstep;
            const char* a2 = last ? nA : cA + (size_t)(t + 2) * kstep; const char* b2 = last ? nB : cB + (size_t)(t + 2) * kstep;
            const char* a3 = a2 + kstep; const char* b3 = b2 + kstep;
            if (last && has_next) S.a_ready(nxt);
            if constexpr (SP2) {
            PG8_LDB(B0, 0, 0); PG8_LDB(B1, 0, 1); PG8_SCHED; PG8_LDA(At, 0, 0); PG8_STAGE(PG8_SA(1, 1), a1 + hstep, voffA);
            PG8_WAIT_V(8); PG8_WAIT_L(0); PG8_BAR; PG8_MMA(0, 0, At, B0); PG8_MMA(0, 1, At, B1); PG8_BAR; PG8_SCHED;
            PG8_LDA(At, 0, 1); PG8_STAGE(PG8_SB(0, 0), b2, voffB); PG8_STAGE(PG8_SB(0, 1), b2 + hstep, voffB); PG8_STAGE(PG8_SA(0, 0), a2, voffA);
            PG8_WAIT_V(8); PG8_WAIT_L(0); PG8_BAR; PG8_MMA(1, 0, At, B0); PG8_MMA(1, 1, At, B1); PG8_BAR; PG8_SCHED;
            PG8_LDB(B0, 1, 0); PG8_LDB(B1, 1, 1); PG8_SCHED; PG8_LDA(At, 1, 0); PG8_STAGE(PG8_SA(0, 1), a2 + hstep, voffA);
            PG8_WAIT_V(8); PG8_WAIT_L(0); PG8_BAR; PG8_MMA(0, 0, At, B0); PG8_MMA(0, 1, At, B1); PG8_BAR; PG8_SCHED;
            PG8_LDA(At, 1, 1); PG8_STAGE(PG8_SB(1, 0), b3, voffB); PG8_STAGE(PG8_SB(1, 1), b3 + hstep, voffB); PG8_STAGE(PG8_SA(1, 0), a3, voffA);
            PG8_WAIT_V(8); PG8_WAIT_L(0); PG8_BAR; PG8_MMA(1, 0, At, B0); PG8_MMA(1, 1, At, B1); PG8_BAR; PG8_SCHED;
            } else {
            PG8_LDB(B0, 0, 0); PG8_SCHED; PG8_LDA(At, 0, 0); PG8_STAGE(PG8_SA(1, 1), a1 + hstep, voffA);
            PG8_WAIT_L(8); PG8_BAR; PG8_WAIT_L(0); PG8_MMA(0, 0, At, B0); PG8_BAR; PG8_SCHED;
            PG8_LDB(B1, 0, 1); PG8_STAGE(PG8_SB(0, 0), b2, voffB);
            PG8_BAR; PG8_WAIT_L(0); PG8_MMA(0, 1, At, B1); PG8_BAR;
            PG8_LDA(At, 0, 1); PG8_STAGE(PG8_SA(0, 0), a2, voffA);
            PG8_BAR; PG8_WAIT_L(0); PG8_MMA(1, 0, At, B0); PG8_BAR; PG8_SCHED;
            PG8_STAGE(PG8_SB(0, 1), b2 + hstep, voffB);
            PG8_WAIT_V(6); PG8_BAR; PG8_MMA(1, 1, At, B1); PG8_BAR;
            PG8_LDB(B0, 1, 0); PG8_SCHED; PG8_LDA(At, 1, 0); PG8_STAGE(PG8_SA(0, 1), a2 + hstep, voffA);
            PG8_WAIT_L(8); PG8_BAR; PG8_WAIT_L(0); PG8_MMA(0, 0, At, B0); PG8_BAR; PG8_SCHED;
            PG8_LDB(B1, 1, 1); PG8_STAGE(PG8_SB(1, 0), b3, voffB);
            PG8_BAR; PG8_WAIT_L(0); PG8_MMA(0, 1, At, B1); PG8_BAR;
            PG8_LDA(At, 1, 1); PG8_STAGE(PG8_SA(1, 0), a3, voffA);
            PG8_BAR; PG8_WAIT_L(0); PG8_MMA(1, 0, At, B0); PG8_BAR; PG8_SCHED;
            PG8_STAGE(PG8_SB(1, 1), b3 + hstep, voffB);
            PG8_WAIT_V(6); PG8_BAR; PG8_MMA(1, 1, At, B1); PG8_BAR;
            }
        }
        if constexpr (ALIGN_EPI) { if (wr == 0) PG8_BAR; }
        if constexpr (!Epi::AFTER_DRAIN) { E(acc, cur, wr, wc, fr, fq); S.done(cur); }
        if (!has_next) break;
#pragma unroll
        for (int a = 0; a < 2; ++a)
#pragma unroll
            for (int b = 0; b < 2; ++b)
#pragma unroll
                for (int m = 0; m < 4; ++m)
#pragma unroll
                    for (int n = 0; n < 2; ++n) acc[a][b][m][n] = (f32x4){0.f, 0.f, 0.f, 0.f};
        cur = nxt; cA = nA; cB = nB; ++ui;
        if constexpr (ALIGN_EPI) { if (wr == 1) PG8_BAR; }
    }
    PG8_WAIT_V(0);
    if constexpr (!ALIGN_EPI) { if (wr == 0) PG8_BAR; }
    PG8_BAR;
    if constexpr (Epi::AFTER_DRAIN) { E.fused(acc, cur, wr, wc, fr, fq, lds, wid, lane); S.done(cur); }
#undef PG8_SA
#undef PG8_SB
#undef PG8_STAGE
#undef PG8_LDA
#undef PG8_LDB
#undef PG8_MMA
#undef PG8_WAIT_V
#undef PG8_WAIT_L
#undef PG8_BAR
#undef PG8_SCHED
}
}

#define LAS __attribute__((address_space(3)))
typedef unsigned short bf16;
typedef unsigned u32x4 __attribute__((ext_vector_type(4)));
typedef unsigned u32x2 __attribute__((ext_vector_type(2)));
typedef float f32x4 __attribute__((ext_vector_type(4)));
typedef short bf16x8 __attribute__((ext_vector_type(8)));
typedef float f32x2 __attribute__((ext_vector_type(2)));
constexpr int DM = 1024, NBATCH = 16, SEQ = 2048, MTOK = NBATCH * SEQ, NH = 16;
constexpr int N_IN = 8320, RW_COLS = 4224, PA = 4352, PB = 4096, MIXW = 2048;
constexpr float RMS_EPS = 1e-5f, GN_EPS = 64e-5f;
constexpr size_t MiB = 1u << 20;
constexpr size_t WS_CTL = 0, WS_PART = 1 * MiB, WS_WTIN = 3 * MiB, WS_WTOUT = 20 * MiB, WS_WUPT = 24 * MiB, WS_AUPT = 24 * MiB + 256 * 1024, WS_LSE = 25 * MiB,
                 WS_MIX = 32 * MiB, WS_P = 160 * MiB, WS_XB = 432 * MiB, WS_END = 496 * MiB;
constexpr int LDS_BYTES = 147456;
constexpr int NWAVES = 8, NTHR = 512;

struct Ptrs {
    const float *x, *norm_w, *w_in, *mu, *w0, *w_up, *a0, *a_up, *k_k, *k_a, *r_k, *ln_w, *ln_b, *w_out, *fin_w;
    float* out; float* part; float* lse;
    bf16 *wtin, *wtout, *wupT, *aupT, *mix, *P, *xb, *o1, *o2, *o3;
};

__device__ __forceinline__ unsigned f2bf(float f) { unsigned u = __builtin_bit_cast(unsigned, f); return (u + 0x7fffu + ((u >> 16) & 1u)) >> 16; }
typedef __bf16 bf16x2_t __attribute__((ext_vector_type(2)));
__device__ __forceinline__ unsigned pk2(float lo, float hi) { const f32x2 v = (f32x2){lo, hi}; const bf16x2_t bq = __builtin_convertvector(v, bf16x2_t); return __builtin_bit_cast(unsigned, bq); }
__device__ __forceinline__ float bflo(unsigned w) { return __builtin_bit_cast(float, w << 16); }
__device__ __forceinline__ float bfhi(unsigned w) { return __builtin_bit_cast(float, w & 0xffff0000u); }
__device__ __forceinline__ float wave_sum(float v) {
#pragma unroll
    for (int o = 1; o < 64; o <<= 1) v += __shfl_xor(v, o);
    return v;
}
__device__ __forceinline__ float silu(float g) { return g / (1.f + __expf(-g)); }

__device__ __forceinline__ void p0_transpose_item(const float* W, int K, int N, bf16* WT, int split, LAS float* scr, int item, int lane) {
    const int nblk = N / 32, kb = item / nblk, nb = item % nblk, k0 = 64 * kb, n0 = 32 * nb;
    const int row_off = (n0 >= split) ? 128 : 0;
#pragma unroll 8
    for (int i = 0; i < 32; ++i) { const int kk = 2 * i + (lane >> 5); scr[kk * 33 + (lane & 31)] = W[(size_t)(k0 + kk) * N + n0 + (lane & 31)]; }
    asm volatile("s_waitcnt lgkmcnt(0)" ::: "memory");
    const int c = lane & 7;
#pragma unroll
    for (int j = 0; j < 4; ++j) { const int n = (lane >> 3) + 8 * j; const LAS float* s = scr + (8 * c) * 33 + n;
        u32x4 o; o.x = pk2(s[0 * 33], s[1 * 33]); o.y = pk2(s[2 * 33], s[3 * 33]); o.z = pk2(s[4 * 33], s[5 * 33]); o.w = pk2(s[6 * 33], s[7 * 33]);
        *(u32x4*)(WT + (size_t)(row_off + n0 + n) * K + k0 + 8 * c) = o; }
    asm volatile("s_waitcnt lgkmcnt(0)" ::: "memory");
}
__device__ __forceinline__ void p0_prologue(LAS unsigned char* lds, const Ptrs& P, int tid, bool zero_mix) {
    const int wave = __builtin_amdgcn_readfirstlane(tid >> 6), lane = tid & 63;
    LAS float* scr = (LAS float*)(lds + wave * 16384);
    const int gw = blockIdx.x * NWAVES + wave, NGW = gridDim.x * NWAVES;
    constexpr int I_IN = (DM / 64) * (N_IN / 32), I_OUT = (MIXW / 64) * (DM / 32), I_UP = DM / 32;
    constexpr int NITEMS = I_IN + I_OUT + 2 * I_UP;
    for (int it = gw; it < NITEMS; it += NGW) {
        int r = it;
        if (r < I_IN) { p0_transpose_item(P.w_in, DM, N_IN, P.wtin, RW_COLS, scr, r, lane); continue; } r -= I_IN;
        if (r < I_OUT) { p0_transpose_item(P.w_out, MIXW, DM, P.wtout, 1 << 30, scr, r, lane); continue; } r -= I_OUT;
        if (r < I_UP) { p0_transpose_item(P.w_up, 64, DM, P.wupT, 1 << 30, scr, r, lane); continue; } r -= I_UP;
        p0_transpose_item(P.a_up, 64, DM, P.aupT, 1 << 30, scr, r, lane);
    }
    { const int gt = blockIdx.x * NTHR + tid, NGT = gridDim.x * NTHR; u32x4* z = (u32x4*)(P.wtin + (size_t)RW_COLS * DM);
      for (int i = gt; i < 128 * DM * 2 / 16; i += NGT) z[i] = (u32x4){0u, 0u, 0u, 0u};
      if (zero_mix) { u32x4* zm = (u32x4*)P.mix; for (size_t i = gt; i < (size_t)MTOK * MIXW * 2 / 16; i += NGT) zm[i] = (u32x4){0u, 0u, 0u, 0u}; } }
    for (int m = gw; m < MTOK; m += NGW) {
        const f32x4* xr = (const f32x4*)(P.x + (size_t)m * DM) + lane; const f32x4* wr = (const f32x4*)P.norm_w + lane;
        f32x4 v[4]; float s = 0.f;
#pragma unroll
        for (int j = 0; j < 4; ++j) { v[j] = xr[64 * j]; s += (v[j].x * v[j].x + v[j].y * v[j].y) + (v[j].z * v[j].z + v[j].w * v[j].w); }
        const float rstd = 1.f / sqrtf(wave_sum(s) * (1.f / DM) + RMS_EPS);
        unsigned long long* o8 = (unsigned long long*)(P.xb + (size_t)m * DM) + lane;
#pragma unroll
        for (int j = 0; j < 4; ++j) { const f32x4 w = wr[64 * j];
            o8[64 * j] = (unsigned long long)pk2(v[j].x * rstd * w.x, v[j].y * rstd * w.y) | ((unsigned long long)pk2(v[j].z * rstd * w.z, v[j].w * rstd * w.w) << 32); }
    }
}

namespace rw {
constexpr int T = 32, NCH = SEQ / T;
constexpr size_t SEC = (size_t)256 * 2048 * 64;
constexpr int O_DEC = 0, O_BV = 8192, O_K = 16384, O_R = 24576, O_AV = 32768, BUF = 40960;
constexpr int L_B = 0, L_V = 2 * BUF, L_Y = L_V + 3 * 8192, L_ST = L_Y + 2 * 8192, WLS = 144, ST_W = 16 * WLS, L_BON = L_ST + 4 * 2 * ST_W, L_END = L_BON + 3 * T * 4;
static_assert(L_END <= LDS_BYTES, "rwkv LDS");
template <int CTRL> __device__ __forceinline__ float dpp_add(float x) {
    const int y = __builtin_amdgcn_update_dpp(0, __builtin_bit_cast(int, x), CTRL, 0xf, 0xf, false);
    return x + __builtin_bit_cast(float, y);
}
__device__ __forceinline__ float allreduce16(float x) {
    x = dpp_add<0xB1>(x);
    x = dpp_add<0x4E>(x);
    x = dpp_add<0x141>(x);
    x = dpp_add<0x140>(x);
    return x;
}
__device__ __forceinline__ float allreduce8(float x) {
    x = dpp_add<0xB1>(x); x = dpp_add<0x4E>(x); x = dpp_add<0x141>(x);
    return x;
}
__device__ __forceinline__ void lerp8(const u32x4 cur, const u32x4 prv, const f32x4 m0, const f32x4 m1, float (&v)[8]) {
#pragma unroll
    for (int i = 0; i < 4; ++i) { const float cl = bflo(cur[i]), ch = bfhi(cur[i]), pl = bflo(prv[i]), ph = bfhi(prv[i]);
        const float ma = (i < 2) ? m0[2 * i] : m1[2 * i - 4], mb = (i < 2) ? m0[2 * i + 1] : m1[2 * i - 3];
        v[2 * i] = cl + (pl - cl) * ma; v[2 * i + 1] = ch + (ph - ch) * mb; }
}
}

__device__ __forceinline__ void rwkv_phase(LAS unsigned char* lds, const Ptrs& P, int tid) {
    using namespace rw;
    const int wv = __builtin_amdgcn_readfirstlane(tid >> 6), lane = tid & 63, fr = lane & 15, fq = lane >> 4;
    const bf16* Pb = P.P;
    const float* mu = P.mu; const float* g_w0 = P.w0; const float* g_a0 = P.a0; const float* g_kk = P.k_k; const float* g_ka = P.k_a; const float* g_rk = P.r_k;
    const float* g_lw = P.ln_w; const float* g_lb = P.ln_b; bf16* mix = P.mix;
    const int pw = wv & 3;
    const int ptt = lane >> 3, c8 = (lane & 7) * 8;
    const int trow = pw * 8 + ptt;
    LAS unsigned char* stw = lds + L_ST + pw * 2 * ST_W; LAS unsigned char* sta = stw + ST_W;
    for (int bh = blockIdx.x; bh < NBATCH * NH; bh += gridDim.x) {
        const int b = bh >> 4, h = bh & 15;
        const bf16* pR = Pb + (size_t)bh * 2048 * 64; const bf16* pK = pR + SEC; const bf16* pV = pR + 2 * SEC; const bf16* pG = pR + 3 * SEC;
        const bf16* pL = Pb + 4 * SEC + (size_t)b * 2048 * 128;
        bf16x8 bw[4][2], ba[4][2];
        if (wv >= 4) {
#pragma unroll
            for (int nt = 0; nt < 4; ++nt)
#pragma unroll
                for (int ks = 0; ks < 2; ++ks) { bw[nt][ks] = *(const bf16x8*)(P.wupT + (size_t)(h * 64 + nt * 16 + fr) * 64 + ks * 32 + fq * 8);
                                                 ba[nt][ks] = *(const bf16x8*)(P.aupT + (size_t)(h * 64 + nt * 16 + fr) * 64 + ks * 32 + fq * 8); }
        }
        f32x2 S2[2][4];
#pragma unroll
        for (int i = 0; i < 2; ++i)
#pragma unroll
            for (int q = 0; q < 4; ++q) S2[i][q] = (f32x2){0.f, 0.f};
        for (int c = -1; c <= NCH; ++c) {
            if (wv < 4) {
                if (c >= 0 && c < NCH) {
                    __builtin_amdgcn_s_setprio(3);
                    const int rg = lane >> 3, kg = lane & 7;
                    const LAS float* bb = (const LAS float*)(lds + L_B + (c & 1) * BUF) + kg * 8;
                    const LAS float* pv = (const LAS float*)(lds + L_V + (c % 3) * 8192) + wv * 16 + rg * 2;
                    LAS float* py = (LAS float*)(lds + L_Y + (c & 1) * 8192) + wv * 16 + rg * 2;
                    const bool hi4 = (kg & 4) != 0; const int yrow = (kg >> 2) & 1;
#define RW_LD8(dst, off, tt) do { dst[0] = *(const LAS f32x4*)(bb + (off) / 4 + (tt) * 64); dst[1] = *(const LAS f32x4*)(bb + (off) / 4 + (tt) * 64 + 4); } while (0)
                    f32x4 n_dec[2], n_bv[2], n_kk[2], n_rr[2], n_av[2]; f32x2 n_vv;
                    RW_LD8(n_dec, O_DEC, 0); RW_LD8(n_bv, O_BV, 0); RW_LD8(n_kk, O_K, 0); RW_LD8(n_rr, O_R, 0); RW_LD8(n_av, O_AV, 0); n_vv = *(const LAS f32x2*)pv;
#pragma unroll 2
                    for (int t = 0; t < T; ++t) {
                        f32x2 de[4], bv[4], kk[4], rr[4], av[4];
#pragma unroll
                        for (int q = 0; q < 2; ++q) {
                            de[2 * q] = (f32x2){n_dec[q][0], n_dec[q][1]}; de[2 * q + 1] = (f32x2){n_dec[q][2], n_dec[q][3]};
                            bv[2 * q] = (f32x2){n_bv[q][0], n_bv[q][1]}; bv[2 * q + 1] = (f32x2){n_bv[q][2], n_bv[q][3]};
                            kk[2 * q] = (f32x2){n_kk[q][0], n_kk[q][1]}; kk[2 * q + 1] = (f32x2){n_kk[q][2], n_kk[q][3]};
                            rr[2 * q] = (f32x2){n_rr[q][0], n_rr[q][1]}; rr[2 * q + 1] = (f32x2){n_rr[q][2], n_rr[q][3]};
                            av[2 * q] = (f32x2){n_av[q][0], n_av[q][1]}; av[2 * q + 1] = (f32x2){n_av[q][2], n_av[q][3]};
                        }
                        const f32x2 vv = n_vv;
                        const int tn = (t + 1 < T) ? t + 1 : t;
                        RW_LD8(n_dec, O_DEC, tn); RW_LD8(n_bv, O_BV, tn); RW_LD8(n_kk, O_K, tn); RW_LD8(n_rr, O_R, tn); RW_LD8(n_av, O_AV, tn); n_vv = *(const LAS f32x2*)(pv + tn * 64);
                        float sa[2];
#pragma unroll
                        for (int i = 0; i < 2; ++i) { const f32x2 q = (S2[i][0] * av[0] + S2[i][1] * av[1]) + (S2[i][2] * av[2] + S2[i][3] * av[3]); sa[i] = q.x + q.y; }
#pragma unroll
                        for (int i = 0; i < 2; ++i) sa[i] = allreduce8(sa[i]);
#pragma unroll
                        for (int i = 0; i < 2; ++i) {
                            const f32x2 s2 = (f32x2){sa[i], sa[i]}, v2 = (f32x2){vv[i], vv[i]};
#pragma unroll
                            for (int q = 0; q < 4; ++q) S2[i][q] = S2[i][q] * de[q] + s2 * bv[q] + v2 * kk[q];
                        }
                        float y[2];
#pragma unroll
                        for (int i = 0; i < 2; ++i) { const f32x2 q = (S2[i][0] * rr[0] + S2[i][1] * rr[1]) + (S2[i][2] * rr[2] + S2[i][3] * rr[3]); y[i] = q.x + q.y; }
                        const float e0 = dpp_add<0x141>(y[0]), e1 = dpp_add<0x141>(y[1]);
                        float w = hi4 ? e1 : e0;
                        w = dpp_add<0xB1>(w); w = dpp_add<0x4E>(w);
                        if ((kg & 3) == 0) py[t * 64 + yrow] = w;
                    }
#undef RW_LD8
                    __builtin_amdgcn_s_setprio(0);
                }
            } else {
                if (c >= 1) {
                    const int cp = c - 1, t = cp * T + trow, o = trow * 64 + c8;
                    const LAS float* aY = (const LAS float*)(lds + L_Y + (cp & 1) * 8192); const LAS float* aV = (const LAS float*)(lds + L_V + (cp % 3) * 8192);
                    const u32x4 g = *(const u32x4*)(pG + (size_t)t * 64 + c8);
                    const f32x4 lw0 = *(const f32x4*)(g_lw + h * 64 + c8), lw1 = *(const f32x4*)(g_lw + h * 64 + c8 + 4);
                    const f32x4 lb0 = *(const f32x4*)(g_lb + h * 64 + c8), lb1 = *(const f32x4*)(g_lb + h * 64 + c8 + 4);
                    const f32x4 y0 = *(const LAS f32x4*)(aY + o), y1 = *(const LAS f32x4*)(aY + o + 4), v0 = *(const LAS f32x4*)(aV + o), v1 = *(const LAS f32x4*)(aV + o + 4);
                    const float bon = ((const LAS float*)(lds + L_BON))[(cp % 3) * T + trow];
                    const float s = allreduce8((y0.x + y0.y) + (y0.z + y0.w) + (y1.x + y1.y) + (y1.z + y1.w));
                    const float mean = s * (1.f / 64.f);
                    const f32x4 d0 = y0 - mean, d1 = y1 - mean;
                    const float q = allreduce8((d0.x * d0.x + d0.y * d0.y) + (d0.z * d0.z + d0.w * d0.w) + (d1.x * d1.x + d1.y * d1.y) + (d1.z * d1.z + d1.w * d1.w));
                    const float rstd = 1.f / sqrtf(q * (1.f / 64.f) + GN_EPS);
                    const f32x4 e0 = d0 * rstd * lw0 + lb0 + bon * v0, e1 = d1 * rstd * lw1 + lb1 + bon * v1;
                    u32x4 ov;
                    ov.x = pk2(e0.x * silu(bflo(g.x)), e0.y * silu(bfhi(g.x))); ov.y = pk2(e0.z * silu(bflo(g.y)), e0.w * silu(bfhi(g.y)));
                    ov.z = pk2(e1.x * silu(bflo(g.z)), e1.y * silu(bfhi(g.z))); ov.w = pk2(e1.z * silu(bflo(g.w)), e1.w * silu(bfhi(g.w)));
                    *(u32x4*)(mix + ((size_t)b * SEQ + t) * MIXW + h * 64 + c8) = ov;
                }
                if (c + 1 < NCH) {
                    const int cn = c + 1, t = cn * T + trow, o = trow * 64 + c8;
                    LAS float* B = (LAS float*)(lds + L_B + (cn & 1) * BUF);
                    LAS float* aV = (LAS float*)(lds + L_V + (cn % 3) * 8192);
                    const bf16* sR = pR + (size_t)t * 64 + c8; const bf16* sK = pK + (size_t)t * 64 + c8; const bf16* sV = pV + (size_t)t * 64 + c8;
                    const bf16* sW = pL + (size_t)t * 128 + c8; const bf16* sA = sW + 64;
                    const u32x4 zz = (u32x4){0u, 0u, 0u, 0u};
                    const u32x4 cR = *(const u32x4*)sR, cK = *(const u32x4*)sK, cV = *(const u32x4*)sV, cW = *(const u32x4*)sW, cA = *(const u32x4*)sA;
                    u32x4 qR = zz, qK = zz, qV = zz, qW = zz, qA = zz;
                    if (t > 0) { qR = *(const u32x4*)(sR - 64); qK = *(const u32x4*)(sK - 64); qV = *(const u32x4*)(sV - 64); qW = *(const u32x4*)(sW - 128); qA = *(const u32x4*)(sA - 128); }
                    const int hc = h * 64 + c8;
                    float v[8];
                    lerp8(cR, qR, *(const f32x4*)(mu + hc), *(const f32x4*)(mu + hc + 4), v);
                    *(LAS f32x4*)(B + O_R / 4 + o) = (f32x4){v[0], v[1], v[2], v[3]}; *(LAS f32x4*)(B + O_R / 4 + o + 4) = (f32x4){v[4], v[5], v[6], v[7]};
                    const f32x4 r0 = (f32x4){v[0], v[1], v[2], v[3]}, r1 = (f32x4){v[4], v[5], v[6], v[7]};
                    lerp8(cV, qV, *(const f32x4*)(mu + 2048 + hc), *(const f32x4*)(mu + 2048 + hc + 4), v);
                    *(LAS f32x4*)(aV + o) = (f32x4){v[0], v[1], v[2], v[3]}; *(LAS f32x4*)(aV + o + 4) = (f32x4){v[4], v[5], v[6], v[7]};
                    lerp8(cW, qW, *(const f32x4*)(mu + 3072 + c8), *(const f32x4*)(mu + 3072 + c8 + 4), v);
#pragma unroll
                    for (int i = 0; i < 8; ++i) v[i] = 1.f - 2.f / (1.f + __expf(2.f * v[i]));
                    { u32x4 ow; ow.x = pk2(v[0], v[1]); ow.y = pk2(v[2], v[3]); ow.z = pk2(v[4], v[5]); ow.w = pk2(v[6], v[7]); *(LAS u32x4*)(stw + ptt * WLS + c8 * 2) = ow; }
                    lerp8(cA, qA, *(const f32x4*)(mu + 3136 + c8), *(const f32x4*)(mu + 3136 + c8 + 4), v);
                    { u32x4 ow; ow.x = pk2(v[0], v[1]); ow.y = pk2(v[2], v[3]); ow.z = pk2(v[4], v[5]); ow.w = pk2(v[6], v[7]); *(LAS u32x4*)(sta + ptt * WLS + c8 * 2) = ow; }
                    lerp8(cK, qK, *(const f32x4*)(mu + 1024 + hc), *(const f32x4*)(mu + 1024 + hc + 4), v);
                    const f32x4 k0 = (f32x4){v[0], v[1], v[2], v[3]}, k1 = (f32x4){v[4], v[5], v[6], v[7]};
                    {
                        bf16x8 aw[2], aa[2];
#pragma unroll
                        for (int ks = 0; ks < 2; ++ks) { aw[ks] = *(const LAS bf16x8*)(stw + fr * WLS + (ks * 32 + fq * 8) * 2); aa[ks] = *(const LAS bf16x8*)(sta + fr * WLS + (ks * 32 + fq * 8) * 2); }
#pragma unroll
                        for (int nt = 0; nt < 4; ++nt) {
                            f32x4 accw = (f32x4){0.f, 0.f, 0.f, 0.f}, acca = (f32x4){0.f, 0.f, 0.f, 0.f};
#pragma unroll
                            for (int ks = 0; ks < 2; ++ks) { accw = __builtin_amdgcn_mfma_f32_16x16x32_bf16(aw[ks], bw[nt][ks], accw, 0, 0, 0);
                                                             acca = __builtin_amdgcn_mfma_f32_16x16x32_bf16(aa[ks], ba[nt][ks], acca, 0, 0, 0); }
                            if (fq < 2) {
#pragma unroll
                                for (int j = 0; j < 4; ++j) { const int oo = (pw * 8 + fq * 4 + j) * 64 + nt * 16 + fr; B[O_DEC / 4 + oo] = accw[j]; B[O_BV / 4 + oo] = acca[j]; }
                            }
                        }
                    }
                    {
                        const f32x4 wr0 = *(const LAS f32x4*)(B + O_DEC / 4 + o), wr1 = *(const LAS f32x4*)(B + O_DEC / 4 + o + 4), ar0 = *(const LAS f32x4*)(B + O_BV / 4 + o), ar1 = *(const LAS f32x4*)(B + O_BV / 4 + o + 4);
                        const f32x4 w00 = *(const f32x4*)(g_w0 + hc), w01 = *(const f32x4*)(g_w0 + hc + 4), a00 = *(const f32x4*)(g_a0 + hc), a01 = *(const f32x4*)(g_a0 + hc + 4);
                        const f32x4 kk0 = *(const f32x4*)(g_kk + hc), kk1 = *(const f32x4*)(g_kk + hc + 4), ka0 = *(const f32x4*)(g_ka + hc), ka1 = *(const f32x4*)(g_ka + hc + 4);
                        const f32x4 rk0 = *(const f32x4*)(g_rk + hc), rk1 = *(const f32x4*)(g_rk + hc + 4);
                        f32x4 dec0, dec1, a0v, a1v;
#pragma unroll
                        for (int i = 0; i < 4; ++i) {
                            { const float z = -(w00[i] + wr0[i]); const float sp = fmaxf(z, 0.f) + __logf(1.f + __expf(-fabsf(z))); dec0[i] = __expf(-__expf(-sp - 0.5f)); a0v[i] = 1.f / (1.f + __expf(-(a00[i] + ar0[i]))); }
                            { const float z = -(w01[i] + wr1[i]); const float sp = fmaxf(z, 0.f) + __logf(1.f + __expf(-fabsf(z))); dec1[i] = __expf(-__expf(-sp - 0.5f)); a1v[i] = 1.f / (1.f + __expf(-(a01[i] + ar1[i]))); }
                        }
                        f32x4 n0 = k0 * kk0, n1 = k1 * kk1;
                        const float ss = allreduce8((n0.x * n0.x + n0.y * n0.y) + (n0.z * n0.z + n0.w * n0.w) + (n1.x * n1.x + n1.y * n1.y) + (n1.z * n1.z + n1.w * n1.w));
                        const float inv = 1.f / fmaxf(sqrtf(ss), 1e-12f);
                        n0 = n0 * inv; n1 = n1 * inv;
                        const f32x4 kp0 = k0 * (1.f + (a0v - 1.f) * ka0), kp1 = k1 * (1.f + (a1v - 1.f) * ka1);
                        const f32x4 bq0 = r0 * kp0 * rk0, bq1 = r1 * kp1 * rk1;
                        const float bon = allreduce8((bq0.x + bq0.y) + (bq0.z + bq0.w) + (bq1.x + bq1.y) + (bq1.z + bq1.w));
                        *(LAS f32x4*)(B + O_DEC / 4 + o) = dec0; *(LAS f32x4*)(B + O_DEC / 4 + o + 4) = dec1;
                        *(LAS f32x4*)(B + O_K / 4 + o) = kp0; *(LAS f32x4*)(B + O_K / 4 + o + 4) = kp1;
                        *(LAS f32x4*)(B + O_AV / 4 + o) = -n0; *(LAS f32x4*)(B + O_AV / 4 + o + 4) = -n1;
                        *(LAS f32x4*)(B + O_BV / 4 + o) = n0 * a0v; *(LAS f32x4*)(B + O_BV / 4 + o + 4) = n1 * a1v;
                        if ((lane & 7) == 0) ((LAS float*)(lds + L_BON))[(cn % 3) * T + trow] = bon;
                    }
                }
            }
            __syncthreads();
        }
    }
}

namespace att { constexpr int KST = 144, NSL = 3, VST = NSL * 256 + 16, L_K = 0, L_V = NSL * 128 * KST; static_assert(L_V + 64 * VST <= LDS_BYTES, "att LDS"); constexpr size_t SEC = (size_t)256 * 2048 * 64; }

__device__ __forceinline__ void attn_phase(LAS unsigned char* lds, const Ptrs& P, int tid) {
    using namespace att;
    const int wv = __builtin_amdgcn_readfirstlane(tid >> 6), lane = tid & 63, fr = lane & 15, fq = lane >> 4;
    const float NEG = -__builtin_inff();
    bf16* const po1 = P.o1; bf16* const po2 = P.o2; bf16* const po3 = P.o3; float* const plse = P.lse; bf16* const mix = P.mix;
    for (int i = tid; i < 64 * VST / 16; i += NTHR) *(LAS u32x4*)(lds + L_V + i * 16) = (u32x4){0u, 0u, 0u, 0u};
    __syncthreads();
    const int i0 = wv * 16, qi = i0 + fr, ks0 = i0 < 96 ? i0 : 96;
    const int kkey0 = tid >> 3, kpc = tid & 7, vpc = tid >> 6, vkp = tid & 63;
    for (int bh = blockIdx.x; bh < NBATCH * NH; bh += gridDim.x) {
        const int b = bh >> 4, h = bh & 15;
        const bf16* pQ = P.P + (size_t)bh * 2048 * 64; const bf16* pK = pQ + SEC; const bf16* pV = pQ + 2 * SEC; const bf16* pG = pQ + 3 * SEC;
        u32x4 rk0, rk1, rv0, rv1; bf16x8 rq0, rq1;
#define ATT_LOAD(G) do { const int p_ = (G) >> 4, u_ = (G) & 15, sh_ = 2 * p_, r_ = u_ >> (4 - sh_), n_ = u_ & ((16 >> sh_) - 1); \
            const int lb_ = n_ * 128; \
            rk0 = *(const u32x4*)(pK + (size_t)(((lb_ + kkey0) << sh_) + r_) * 64 + kpc * 8); rk1 = *(const u32x4*)(pK + (size_t)(((lb_ + 64 + kkey0) << sh_) + r_) * 64 + kpc * 8); \
            rv0 = *(const u32x4*)(pV + (size_t)(((lb_ + 2 * vkp) << sh_) + r_) * 64 + vpc * 8); rv1 = *(const u32x4*)(pV + (size_t)(((lb_ + 2 * vkp + 1) << sh_) + r_) * 64 + vpc * 8); \
            const size_t tq_ = (size_t)(((lb_ + qi) << sh_) + r_); rq0 = *(const bf16x8*)(pQ + tq_ * 64 + fq * 8); rq1 = *(const bf16x8*)(pQ + tq_ * 64 + 32 + fq * 8); } while (0)
        ATT_LOAD(0);
        for (int g = 0; g < 48; ++g) {
            const int p = g >> 4, u = g & 15, sh = 2 * p, r = u >> (4 - sh), n = u & ((16 >> sh) - 1);
            const int scur = g % 3, sprev = (g + 2) % 3;
            *(LAS u32x4*)(lds + L_K + (scur * 128 + kkey0) * KST + kpc * 16) = rk0;
            *(LAS u32x4*)(lds + L_K + (scur * 128 + 64 + kkey0) * KST + kpc * 16) = rk1;
#pragma unroll
            for (int m = 0; m < 4; ++m) {
                const unsigned lo = (rv0[m] & 0xffffu) | (rv1[m] << 16), hi = (rv0[m] >> 16) | (rv1[m] & 0xffff0000u);
                *(LAS unsigned*)(lds + L_V + (vpc * 8 + 2 * m) * VST + (scur * 128 + 2 * vkp) * 2) = lo;
                *(LAS unsigned*)(lds + L_V + (vpc * 8 + 2 * m + 1) * VST + (scur * 128 + 2 * vkp) * 2) = hi;
            }
            const bf16x8 qf0 = rq0, qf1 = rq1;
            __syncthreads();
            if (g + 1 < 48) ATT_LOAD(g + 1);
            const size_t tokq = (size_t)(((n * 128 + qi) << sh) + r);
            bf16* OP = ((p == 0) ? po1 : (p == 1 ? po2 : po3)) + (size_t)bh * 2048 * 64;
            float* LSE = plse + (size_t)p * MTOK * 16 + (size_t)bh * 2048;
            f32x4 st[10];
#pragma unroll
            for (int kt = 0; kt < 10; ++kt) {
                const int kb = ks0 + kt * 16, pos = ((kb >> 7) ? scur : sprev) * 128 + (kb & 127);
                const LAS unsigned char* kp = lds + L_K + (pos + fr) * KST + fq * 16;
                f32x4 acc = (f32x4){0.f, 0.f, 0.f, 0.f};
                acc = __builtin_amdgcn_mfma_f32_16x16x32_bf16(*(const LAS bf16x8*)kp, qf0, acc, 0, 0, 0);
                acc = __builtin_amdgcn_mfma_f32_16x16x32_bf16(*(const LAS bf16x8*)(kp + 64), qf1, acc, 0, 0, 0);
                st[kt] = acc;
            }
            const int lo = (n == 0 && qi < 128) ? 128 : qi;
            const int dl = ks0 + 4 * fq - lo; const unsigned span = (unsigned)(qi + 128 - lo);
            float m = NEG;
#pragma unroll
            for (int kt = 0; kt < 10; ++kt)
#pragma unroll
                for (int j = 0; j < 4; ++j) {
                    const bool valid = (unsigned)(dl + kt * 16 + j) <= span;
                    const float s = valid ? st[kt][j] : NEG;
                    st[kt][j] = s; m = fmaxf(m, s);
                }
            m = fmaxf(m, __shfl_xor(m, 16)); m = fmaxf(m, __shfl_xor(m, 32));
            const float C = 0.125f * 1.4426950408889634f, mc = m * C;
            float ls = 0.f;
#pragma unroll
            for (int kt = 0; kt < 10; ++kt)
#pragma unroll
                for (int j = 0; j < 4; ++j) { const float pe = __builtin_amdgcn_exp2f(st[kt][j] * C - mc); st[kt][j] = pe; ls += pe; }
            ls += __shfl_xor(ls, 16); ls += __shfl_xor(ls, 32);
            f32x4 oacc[4];
#pragma unroll
            for (int dt = 0; dt < 4; ++dt) oacc[dt] = (f32x4){0.f, 0.f, 0.f, 0.f};
#pragma unroll
            for (int s5 = 0; s5 < 5; ++s5) {
                u32x4 pw; pw.x = pk2(st[2 * s5][0], st[2 * s5][1]); pw.y = pk2(st[2 * s5][2], st[2 * s5][3]);
                pw.z = pk2(st[2 * s5 + 1][0], st[2 * s5 + 1][1]); pw.w = pk2(st[2 * s5 + 1][2], st[2 * s5 + 1][3]);
                const bf16x8 pb = __builtin_bit_cast(bf16x8, pw);
                const int kb0 = ks0 + 32 * s5, kb1 = kb0 + 16;
                const int pos0 = ((kb0 >> 7) ? scur : sprev) * 128 + (kb0 & 127) + 4 * fq, pos1 = ((kb1 >> 7) ? scur : sprev) * 128 + (kb1 & 127) + 4 * fq;
#pragma unroll
                for (int dt = 0; dt < 4; ++dt) {
                    const LAS unsigned char* vp = lds + L_V + (dt * 16 + fr) * VST;
                    const u32x2 lo2 = *(const LAS u32x2*)(vp + pos0 * 2), hi2 = *(const LAS u32x2*)(vp + pos1 * 2);
                    const u32x4 aw = (u32x4){lo2.x, lo2.y, hi2.x, hi2.y};
                    oacc[dt] = __builtin_amdgcn_mfma_f32_16x16x32_bf16(__builtin_bit_cast(bf16x8, aw), pb, oacc[dt], 0, 0, 0);
                }
            }
            const float inv = 1.f / ls;
#pragma unroll
            for (int dt = 0; dt < 4; ++dt) {
                u32x2 ow; ow.x = pk2(oacc[dt][0] * inv, oacc[dt][1] * inv); ow.y = pk2(oacc[dt][2] * inv, oacc[dt][3] * inv);
                *(u32x2*)(OP + tokq * 64 + dt * 16 + 4 * fq) = ow;
            }
            if (fq == 0) LSE[tokq] = m * 0.125f + __logf(ls);
        }
#undef ATT_LOAD
        __syncthreads();
        for (int pass = 0; pass < SEQ / 64; ++pass) {
            const int t = pass * 64 + (tid >> 3), pc = tid & 7; const size_t row = (size_t)bh * 2048 + t;
            const float l1 = plse[row], l2 = plse[(size_t)MTOK * 16 + row], l3 = plse[(size_t)2 * MTOK * 16 + row];
            const float mx = fmaxf(l1, fmaxf(l2, l3));
            float e1 = __expf(l1 - mx), e2 = __expf(l2 - mx), e3 = __expf(l3 - mx);
            const float inv = 1.f / (e1 + e2 + e3); e1 *= inv; e2 *= inv; e3 *= inv;
            const u32x4 a = *(const u32x4*)(po1 + row * 64 + pc * 8), bb = *(const u32x4*)(po2 + row * 64 + pc * 8), c = *(const u32x4*)(po3 + row * 64 + pc * 8);
            const u32x4 gt = *(const u32x4*)(pG + (size_t)t * 64 + pc * 8);
            u32x4 ov;
#pragma unroll
            for (int i = 0; i < 4; ++i) {
                const float lo = (e1 * bflo(a[i]) + e2 * bflo(bb[i]) + e3 * bflo(c[i])) * silu(bflo(gt[i]));
                const float hi = (e1 * bfhi(a[i]) + e2 * bfhi(bb[i]) + e3 * bfhi(c[i])) * silu(bfhi(gt[i]));
                ov[i] = pk2(lo, hi);
            }
            *(u32x4*)(mix + ((size_t)b * SEQ + t) * MIXW + 1024 + h * 64 + pc * 8) = ov;
        }
        __syncthreads();
    }
}

__device__ __forceinline__ void final_norm(const Ptrs& P, int tid) {
    const int wave = tid >> 6, lane = tid & 63;
    const int gw = blockIdx.x * NWAVES + wave, NGW = gridDim.x * NWAVES;
    for (int m = gw; m < MTOK; m += NGW) {
        float ps = (lane < 16) ? P.part[(size_t)m * 16 + lane] : 0.f;
        ps += __shfl_xor(ps, 1); ps += __shfl_xor(ps, 2); ps += __shfl_xor(ps, 4); ps += __shfl_xor(ps, 8);
        const float ss = __shfl(ps, 0);
        const float rstd = 1.f / sqrtf(ss * (1.f / DM) + RMS_EPS);
        f32x4* o = (f32x4*)(P.out + (size_t)m * DM) + lane; const f32x4* w = (const f32x4*)P.fin_w + lane;
#pragma unroll
        for (int j = 0; j < 4; ++j) { const f32x4 v = o[64 * j]; o[64 * j] = v * rstd * w[64 * j]; }
    }
}

#define XB_TMO      128
#define XB_XCNT(j)  (256  + 64 * (j))
#define XB_XSUB(j)  (1280 + 64 * (j))
#define XB_XGEN(j)  (2304 + 64 * (j))
#define XB_TOP      3328
#define XB_TOPGEN   3392
#define XCD_BAR_WORDS 3456
#define XB_SPIN_CAP (1u << 18)

__device__ __forceinline__ unsigned xb_ld(unsigned* p)              { return __hip_atomic_load(p, __ATOMIC_RELAXED, __HIP_MEMORY_SCOPE_AGENT); }
__device__ __forceinline__ unsigned xb_add(unsigned* p, unsigned v) { return __hip_atomic_fetch_add(p, v, __ATOMIC_RELAXED, __HIP_MEMORY_SCOPE_AGENT); }
__device__ __forceinline__ unsigned xb_xcc_id() { return (unsigned)__builtin_amdgcn_s_getreg((3 << 11) | 20) & 0xFu; }
#define XB_SPIN(cond, bar) do { unsigned _sp = 0; while (cond) { __builtin_amdgcn_s_sleep(1); \
    if ((++_sp & 255u) == 0u) { if (xb_ld(&(bar)[XB_TMO])) break; if (_sp > XB_SPIN_CAP) { atomicAdd(&(bar)[XB_TMO], 1u); break; } } } } while (0)

struct XcdBarrier {
    unsigned* bar; unsigned x;
    volatile LAS unsigned* st;
};

__device__ __forceinline__ XcdBarrier xcd_barrier_post(unsigned* bar, volatile LAS unsigned* st) {
    XcdBarrier b; b.bar = bar; b.x = xb_xcc_id(); b.st = st;
    if (threadIdx.x == 0) (void)xb_add(&bar[XB_XCNT(b.x)], 1u);
    return b;
}
__device__ __forceinline__ void xcd_barrier_complete(unsigned* bar, unsigned x, unsigned& nloc, unsigned& nx) {
    const unsigned G = gridDim.x * gridDim.y * gridDim.z;
    unsigned sum, cnt, mine, sp = 0u;
    for (;;) {
        sum = 0u; cnt = 0u; mine = 0u;
#pragma unroll
        for (unsigned j = 0; j < 16; ++j) { const unsigned c = xb_ld(&bar[XB_XCNT(j)]); sum += c; cnt += (c > 0u) ? 1u : 0u; mine = (j == x) ? c : mine; }
        if (sum == G) break;
        __builtin_amdgcn_s_sleep(1);
        if ((++sp & 255u) == 0u) { if (xb_ld(&bar[XB_TMO])) break; if (sp > XB_SPIN_CAP) { atomicAdd(&bar[XB_TMO], 1u); break; } }
    }
    nloc = mine > 0u ? mine : 1u; nx = cnt > 0u ? cnt : 1u;
}

__device__ __forceinline__ void xcd_barrier(const XcdBarrier& b) {
    asm volatile("s_waitcnt vmcnt(0)" ::: "memory");
    __syncthreads();
    if (threadIdx.x == 0) {
        unsigned* bar = b.bar;
        __builtin_amdgcn_s_waitcnt(0);
        unsigned nloc = b.st[0], nx = b.st[1];
        if (nloc == 0u) { xcd_barrier_complete(bar, b.x, nloc, nx); b.st[0] = nloc; b.st[1] = nx; }
        const unsigned old = xb_add(&bar[XB_XSUB(b.x)], 1u);
        const unsigned gen = old / nloc;
        if (old + 1u == (gen + 1u) * nloc) {
            __builtin_amdgcn_fence(__ATOMIC_RELEASE, "agent");
            asm volatile("s_waitcnt vmcnt(0)" ::: "memory");
            const unsigned og = xb_add(&bar[XB_TOP], 1u);
            const unsigned tg = og / nx;
            if (og + 1u == (tg + 1u) * nx) xb_add(&bar[XB_TOPGEN], 1u);
            else XB_SPIN(xb_ld(&bar[XB_TOPGEN]) == tg, bar);
            __builtin_amdgcn_fence(__ATOMIC_ACQUIRE, "agent");
            xb_add(&bar[XB_XGEN(b.x)], 1u);
            asm volatile("s_waitcnt vmcnt(0)" ::: "memory");
        } else {
            XB_SPIN(xb_ld(&bar[XB_XGEN(b.x)]) == gen, bar);
            __builtin_amdgcn_fence(__ATOMIC_ACQUIRE, "agent");
            asm volatile("s_waitcnt vmcnt(0)" ::: "memory");
        }
    }
    __syncthreads();
}

struct Args { const float* in[15]; float* out; unsigned char* ws; int mask; int sync; };
#ifndef MK_MULTI
#define MK_MULTI 0
#endif
#ifndef MK_REP
#define MK_REP 0
#endif
#ifndef MK_MASK
#define MK_MASK 0x7f
#endif
__global__ void __launch_bounds__(NTHR, 2) fwd_kernel(Args a) {
    extern __shared__ __attribute__((aligned(16))) unsigned char lds_[];
    LAS unsigned char* lds = (LAS unsigned char*)lds_;
    cg::grid_group grid = cg::this_grid();
    const int tid = threadIdx.x;
    Ptrs P;
    P.x = a.in[0]; P.norm_w = a.in[1]; P.w_in = a.in[2]; P.mu = a.in[3]; P.w0 = a.in[4]; P.w_up = a.in[5]; P.a0 = a.in[6]; P.a_up = a.in[7];
    P.k_k = a.in[8]; P.k_a = a.in[9]; P.r_k = a.in[10]; P.ln_w = a.in[11]; P.ln_b = a.in[12]; P.w_out = a.in[13]; P.fin_w = a.in[14];
    P.out = a.out; unsigned char* ws = a.ws;
    P.part = (float*)(ws + WS_PART); P.lse = (float*)(ws + WS_LSE);
    P.wtin = (bf16*)(ws + WS_WTIN); P.wtout = (bf16*)(ws + WS_WTOUT); P.wupT = (bf16*)(ws + WS_WUPT); P.aupT = (bf16*)(ws + WS_AUPT);
    P.mix = (bf16*)(ws + WS_MIX); P.P = (bf16*)(ws + WS_P); P.xb = (bf16*)(ws + WS_XB);
    P.o1 = (bf16*)a.out; P.o2 = (bf16*)a.out + (size_t)MTOK * DM; P.o3 = (bf16*)(ws + WS_XB);
    const int mask = a.mask;
    volatile LAS unsigned* xst = (volatile LAS unsigned*)(lds + LDS_BYTES - 64);
    if (tid < 16) xst[tid] = 0u;
    __syncthreads();
    XcdBarrier xbar; xbar.bar = (unsigned*)(ws + WS_CTL) + 4096; xbar.x = 0; xbar.st = xst;
    if (a.sync) xbar = xcd_barrier_post((unsigned*)(ws + WS_CTL) + 4096, xst);
#define SEAM() do { if (a.sync) xcd_barrier(xbar); } while (0)
#define SEAM_CG() do { if (a.sync) grid.sync(); } while (0)
    if (mask & 1) p0_prologue(lds, P, tid, (mask & 0x80) != 0);
    SEAM_CG();
    if (mask & 2) {
        pg8::Gemm g{P.xb, P.wtin, MTOK, PA, DM}; pg8::StaticOrder S; S.init(MTOK, PA, gridDim.x, (int)blockIdx.x);
        pg8::EpiHM<1> E{P.P};
        pg8::gemm_phase<pg8::EpiHM<1>, pg8::StaticOrder, true, true>(lds, g, S, E);
    }
    SEAM();
    if (mask & 4) for (int rep = 0; rep < ((MK_REP & 4) ? 2 : 1); ++rep) rwkv_phase(lds, P, tid);
    SEAM();
    if (mask & 8) {
        pg8::Gemm g{P.xb, P.wtin + (size_t)PA * DM, MTOK, PB, DM}; pg8::StaticOrder S; S.init(MTOK, PB, gridDim.x, (int)blockIdx.x);
        pg8::EpiHM<0> E{P.P};
        pg8::gemm_phase<pg8::EpiHM<0>, pg8::StaticOrder, true, true>(lds, g, S, E);
    }
    SEAM();
    if (mask & 16) for (int rep = 0; rep < ((MK_REP & 16) ? 2 : 1); ++rep) attn_phase(lds, P, tid);
    SEAM();
    if (mask & 32) {
        pg8::Gemm g{P.mix, P.wtout, MTOK, DM, MIXW}; pg8::StaticOrder S; S.init(MTOK, DM, gridDim.x, (int)blockIdx.x);
        pg8::EpiResF32 E{P.x, P.out, P.part, DM};
        pg8::gemm_phase<pg8::EpiResF32, pg8::StaticOrder, true, true>(lds, g, S, E);
    }
    SEAM();
    if (mask & 64) final_norm(P, tid);
}

extern "C" void kernel_launch(void* const* d_in, const int* in_sizes, int n_in, void* d_out, int out_size, void* d_ws, size_t ws_size, hipStream_t stream) {
    static int grid = 0;
    if (grid == 0) {
        if (n_in != 15 || in_sizes[0] != MTOK * DM || out_size != MTOK * DM || ws_size < WS_END) {
            fprintf(stderr, "kernel_launch: unexpected shapes / workspace (n_in %d, ws %zu, need %zu); nothing launched\n", n_in, ws_size, (size_t)WS_END); grid = -1; return; }
        int dev = 0, cus = 0, per_cu = 0;
        if (hipGetDevice(&dev) != hipSuccess || hipDeviceGetAttribute(&cus, hipDeviceAttributeMultiprocessorCount, dev) != hipSuccess) { grid = -1; return; }
        if (hipFuncSetAttribute((const void*)fwd_kernel, hipFuncAttributeMaxDynamicSharedMemorySize, LDS_BYTES) != hipSuccess) { fprintf(stderr, "kernel_launch: hipFuncSetAttribute failed\n"); grid = -1; return; }
        if (hipOccupancyMaxActiveBlocksPerMultiprocessor(&per_cu, (const void*)fwd_kernel, NTHR, LDS_BYTES) != hipSuccess || per_cu < 1) { fprintf(stderr, "kernel_launch: occupancy query says %d blocks per CU\n", per_cu); grid = -1; return; }
        grid = cus;
    }
    if (grid < 0) return;
    if (hipMemsetAsync((char*)d_ws + WS_CTL, 0, 64 * 1024, stream) != hipSuccess) { fprintf(stderr, "kernel_launch: hipMemsetAsync failed\n"); return; }
    Args a{};
    for (int i = 0; i < 15; ++i) a.in[i] = (const float*)d_in[i];
    a.out = (float*)d_out; a.ws = (unsigned char*)d_ws;
#if MK_MULTI
    for (int ph = 0; ph < 7; ++ph) {
        a.mask = (1 << ph) & (MK_MASK); if (ph == 0) a.mask |= (MK_MASK & 0x80); a.sync = 0;
        if (!(a.mask & 0x7f)) continue;
        hipLaunchKernelGGL(fwd_kernel, dim3(grid), dim3(NTHR), LDS_BYTES, stream, a);
    }
#else
    a.mask = MK_MASK; a.sync = 1;
    void* args[] = {&a};
    hipError_t e = hipLaunchCooperativeKernel((void*)fwd_kernel, dim3(grid), dim3(NTHR), args, LDS_BYTES, stream);
    if (e != hipSuccess) fprintf(stderr, "cooperative launch failed: %s (grid %d)\n", hipGetErrorString(e), grid);
#endif
}
```

```cpp
#include <hip/hip_runtime.h>
#include <hip/hip_cooperative_groups.h>
#include <cstdio>
#include <cstdint>
namespace cg = cooperative_groups;
#define MK_MULTI 0
#define MK_MASK 0x7f
#define MK_REP 0
namespace pg8 {
#define PG8_LAS __attribute__((address_space(3)))
typedef unsigned short bf16_t;
typedef short bf16x8 __attribute__((ext_vector_type(8)));
typedef float f32x4 __attribute__((ext_vector_type(4)));
typedef unsigned u32x4 __attribute__((ext_vector_type(4)));
constexpr int BM = 256, BK = 64, HALF = 128, HTB = HALF * BK * 2  , STAGE_BYTES = 8 * HTB, NXCD = 8, WGM = 8;

__host__ __device__ __forceinline__ int lds_byte(int r, int c) { const int st = (r >> 4) * 2 + (c >> 5), rr = r & 15, cc = c & 31, ob = rr * 64 + cc * 2; return st * 1024 + (ob ^ (((ob >> 9) & 1) << 5)); }
__host__ __device__ __forceinline__ void stage_rc(int b, int& R, int& C) { const int st = b / 1024, sb = b % 1024, swz = sb ^ (((sb >> 9) & 1) << 5); R = (st >> 1) * 16 + swz / 64; C = (st & 1) * 32 + (swz % 64) / 2; }
__host__ __device__ __forceinline__ int perm32(int rho) { const int n = rho >> 4, i = rho & 15; return 8 * (i >> 2) + 4 * n + (i & 3); }

struct Unit { int pm, pn; };
struct Gemm { const bf16_t* A; const bf16_t* Bt; int M, N, K; };

struct StaticOrder {
    int nM, nN, nwg, G, c;
    __host__ __device__ void init(int M, int N, int G_, int c_) { nM = M / BM; nN = N / BM; nwg = nM * nN; G = G_; c = c_; }
    __host__ __device__ bool next(int i, Unit& u) const {
        const long L = (long)i * G + c; if (L >= nwg) return false;
        int wgid = (int)L; { const int q = nwg / NXCD, r = nwg % NXCD, xcd = wgid % NXCD, off = wgid / NXCD; wgid = (xcd < r ? xcd * (q + 1) : r * (q + 1) + (xcd - r) * q) + off; }
        const int nig = WGM * nN, gid = wgid / nig, fm = gid * WGM, gsz = (nM - fm) < WGM ? (nM - fm) : WGM;
        u.pm = fm + ((wgid % nig) % gsz); u.pn = (wgid % nig) / gsz; return true;
    }
    __device__ __forceinline__ void a_ready(const Unit&) const {}
    __device__ __forceinline__ void done(const Unit&) const {}
};

__device__ __forceinline__ unsigned cvt_pk_bf16(float lo, float hi) { unsigned r; asm volatile("v_cvt_pk_bf16_f32 %0, %1, %2" : "=v"(r) : "v"(lo), "v"(hi)); return r; }
typedef float f32x2 __attribute__((ext_vector_type(2)));
__device__ __forceinline__ f32x2 gelu_pk(f32x2 v) {
    const f32x2 av = __builtin_elementwise_abs(v), d = av * 0.2316418882f + 1.0f;
    f32x2 t; t.x = __builtin_amdgcn_rcpf(d.x); t.y = __builtin_amdgcn_rcpf(d.y);
    f32x2 q = t * 0.5307027145f + (-0.7265760135f); q = q * t + 0.7107068705f; q = q * t + (-0.142248368f); q = q * t + 0.127414796f; q = q * t;
    const f32x2 s = (v * v) * (-0.72134752044f);
    f32x2 e; e.x = __builtin_amdgcn_exp2f(s.x); e.y = __builtin_amdgcn_exp2f(s.y);
    const f32x2 m = v * (q * e), r = v - m;
    f32x2 o; o.x = v.x < 0.f ? m.x : r.x; o.y = v.y < 0.f ? m.y : r.y; return o;
}

template <int ACT  > struct EpiBf16 {
    static constexpr bool PERM = true, AFTER_DRAIN = false; static_assert(ACT == 0 || ACT == 1, "EpiBf16: ACT is 0 (none) or 1 (gelu_pk)");
    bf16_t* O; int ldc; const float* bias; int split_cols; size_t split_stride; float scale0;
    __device__ __forceinline__ void operator()(const f32x4 (&acc)[2][2][4][2], const Unit& u, int wr, int wc, int fr, int fq) const {
        const int row0 = u.pm * BM + wr * 64 + fr; int colt = u.pn * BM; bf16_t* base = O;
        float sc = 1.f; if (split_cols) { const int t = colt / split_cols; base += (size_t)t * split_stride; colt -= t * split_cols; if (t == 0) sc = scale0; }
        const int col0 = colt + wc * 32 + 8 * fq, bcol0 = u.pn * BM + wc * 32 + 8 * fq;
        f32x4 bv[2][2];
#pragma unroll
        for (int bj = 0; bj < 2; ++bj)
#pragma unroll
            for (int n = 0; n < 2; ++n) bv[bj][n] = bias ? *(const f32x4*)(bias + bcol0 + bj * HALF + 4 * n) : (f32x4){0.f, 0.f, 0.f, 0.f};
#pragma unroll
        for (int ai = 0; ai < 2; ++ai)
#pragma unroll
            for (int m = 0; m < 4; ++m) { bf16_t* rowp = base + (size_t)(row0 + ai * HALF + m * 16) * ldc + col0;
#pragma unroll
                for (int bj = 0; bj < 2; ++bj) { f32x4 v0 = acc[ai][bj][m][0] + bv[bj][0], v1 = acc[ai][bj][m][1] + bv[bj][1];
                    if (ACT == 1) { f32x2 a = gelu_pk((f32x2){v0[0], v0[1]}), b = gelu_pk((f32x2){v0[2], v0[3]}), c = gelu_pk((f32x2){v1[0], v1[1]}), d = gelu_pk((f32x2){v1[2], v1[3]});
                        v0 = (f32x4){a.x, a.y, b.x, b.y}; v1 = (f32x4){c.x, c.y, d.x, d.y}; }
                    v0 = v0 * sc; v1 = v1 * sc; u32x4 w; w.x = cvt_pk_bf16(v0[0], v0[1]); w.y = cvt_pk_bf16(v0[2], v0[3]); w.z = cvt_pk_bf16(v1[0], v1[1]); w.w = cvt_pk_bf16(v1[2], v1[3]);
                    *(u32x4*)(rowp + bj * HALF) = w; } }
    }
};
struct EpiResF32 {
    static constexpr bool PERM = false, AFTER_DRAIN = false;
    const float* base; float* out; float* part; int ldc;
    __device__ __forceinline__ void operator()(const f32x4 (&acc)[2][2][4][2], const Unit& u, int wr, int wc, int fr, int fq) const {
        const int col0 = u.pn * BM + wc * 32 + 4 * fq;
#pragma unroll
        for (int ai = 0; ai < 2; ++ai)
#pragma unroll
            for (int m = 0; m < 4; ++m) {
                const int row = u.pm * BM + ai * HALF + wr * 64 + m * 16 + fr;
                const size_t off = (size_t)row * ldc + col0;
                float ss = 0.f;
#pragma unroll
                for (int bj = 0; bj < 2; ++bj)
#pragma unroll
                    for (int n = 0; n < 2; ++n) {
                        const f32x4 b = *(const f32x4*)(base + off + bj * HALF + n * 16);
                        const f32x4 h = b + acc[ai][bj][m][n];
                        *(f32x4*)(out + off + bj * HALF + n * 16) = h;
                        ss += (h[0] * h[0] + h[1] * h[1]) + (h[2] * h[2] + h[3] * h[3]);
                    }
                ss += __shfl_xor(ss, 16); ss += __shfl_xor(ss, 32);
                if (fq == 0) part[(size_t)row * 16 + u.pn * 4 + wc] = ss;
            }
    }
};
template <int MODE> struct EpiHM {
    static constexpr bool PERM = true, AFTER_DRAIN = false;
    static constexpr size_t SEC = (size_t)256 * 2048 * 64;
    bf16_t* O;
    __device__ __forceinline__ void operator()(const f32x4 (&acc)[2][2][4][2], const Unit& u, int wr, int wc, int fr, int fq) const {
        const int row0 = u.pm * BM + wr * 64 + fr;
        const size_t bterm = (size_t)(row0 >> 11) * (16 * 2048 * 64);
#pragma unroll
        for (int bj = 0; bj < 2; ++bj) {
            const int c0 = u.pn * BM + bj * HALF + wc * 32 + 8 * fq;
            bf16_t* base; bool hm = true, skip = false;
            if (MODE == 0 || c0 < 3072) { base = O + (size_t)(c0 >> 10) * SEC + (size_t)((c0 >> 6) & 15) * (2048 * 64) + (c0 & 63); }
            else if (c0 < 3200) { base = O + 4 * SEC + (c0 - 3072); hm = false; }
            else if (c0 < 4224) { const int c1 = c0 - 3200; base = O + 3 * SEC + (size_t)(c1 >> 6) * (2048 * 64) + (c1 & 63); }
            else { base = O; skip = true; }
            if (skip) continue;
#pragma unroll
            for (int ai = 0; ai < 2; ++ai)
#pragma unroll
                for (int m = 0; m < 4; ++m) {
                    const int row = row0 + ai * HALF + m * 16;
                    bf16_t* p = hm ? base + bterm + (size_t)(row & 2047) * 64 : base + (size_t)row * 128;
                    const f32x4 v0 = acc[ai][bj][m][0], v1 = acc[ai][bj][m][1];
                    u32x4 w; w.x = cvt_pk_bf16(v0[0], v0[1]); w.y = cvt_pk_bf16(v0[2], v0[3]); w.z = cvt_pk_bf16(v1[0], v1[1]); w.w = cvt_pk_bf16(v1[2], v1[3]);
                    *(u32x4*)p = w;
                }
        }
    }
};
template <class Epi, class Sched, bool ALIGN_EPI = false, bool SP2 = false>
__device__ __forceinline__ void gemm_phase(PG8_LAS unsigned char* lds, const Gemm g, const Sched& S, const Epi& E) {
    const int tid = threadIdx.x, wid = __builtin_amdgcn_readfirstlane(tid >> 6), lane = tid & 63, wr = wid >> 2, wc = wid & 3, fr = lane & 15, fq = lane >> 4;
    const int K = g.K, nt = K / BK;
    unsigned voffA[2], voffB[2];
#pragma unroll
    for (int i = 0; i < 2; ++i) { int R, C; stage_rc(tid * 16 + i * 8192, R, C); const int Rb = Epi::PERM ? ((R & ~31) + perm32(R & 31)) : R;
        voffA[i] = (unsigned)(R * K + C) * 2u; voffB[i] = (unsigned)(Rb * K + C) * 2u; }
    const size_t kstep = (size_t)(BK * 2);
    const size_t hstep = (size_t)HALF * K * 2;
    const size_t tstep = 2 * hstep;
    const unsigned ldsw = (unsigned)wid * 1024u;
    const int aoff = lds_byte(wr * 64 + fr, fq * 8), boff = lds_byte(wc * 32 + fr, fq * 8);
#define PG8_SA(b, h) (((b) * 2 + (h)) * HTB)
#define PG8_SB(b, h) ((4 + (b) * 2 + (h)) * HTB)
#define PG8_STAGE(bufoff, gbase, voff) do { _Pragma("unroll") for (int _i = 0; _i < 2; ++_i) \
        __builtin_amdgcn_global_load_lds((const unsigned*)((const char*)(gbase) + (voff)[_i]), (PG8_LAS unsigned*)(lds + (bufoff) + ldsw + _i * 8192), 16, 0, 0); } while (0)
#define PG8_LDA(dst, b, h) do { _Pragma("unroll") for (int m = 0; m < 4; ++m) _Pragma("unroll") for (int k = 0; k < 2; ++k) dst[m][k] = *(const PG8_LAS bf16x8*)(lds + PG8_SA(b, h) + aoff + m * 2048 + k * 1024); } while (0)
#define PG8_LDB(dst, b, h) do { _Pragma("unroll") for (int n = 0; n < 2; ++n) _Pragma("unroll") for (int k = 0; k < 2; ++k) dst[n][k] = *(const PG8_LAS bf16x8*)(lds + PG8_SB(b, h) + boff + n * 2048 + k * 1024); } while (0)
#define PG8_MMA(ai, bj, At, Bt) do { __builtin_amdgcn_s_setprio(1); _Pragma("unroll") for (int m = 0; m < 4; ++m) _Pragma("unroll") for (int n = 0; n < 2; ++n) _Pragma("unroll") for (int k = 0; k < 2; ++k) \
        acc[ai][bj][m][n] = __builtin_amdgcn_mfma_f32_16x16x32_bf16(Bt[n][k], At[m][k], acc[ai][bj][m][n], 0, 0, 0); __builtin_amdgcn_s_setprio(0); } while (0)
#define PG8_WAIT_V(n) asm volatile("s_waitcnt vmcnt(" #n ")" ::: "memory")
#define PG8_WAIT_L(n) asm volatile("s_waitcnt lgkmcnt(" #n ")" ::: "memory")
#define PG8_BAR __builtin_amdgcn_s_barrier()
#define PG8_SCHED __builtin_amdgcn_sched_barrier(0)
    Unit cur, nxt; int ui = 0;
    if (!S.next(0, cur)) return;
    f32x4 acc[2][2][4][2];
#pragma unroll
    for (int a = 0; a < 2; ++a)
#pragma unroll
        for (int b = 0; b < 2; ++b)
#pragma unroll
            for (int m = 0; m < 4; ++m)
#pragma unroll
                for (int n = 0; n < 2; ++n) acc[a][b][m][n] = (f32x4){0.f, 0.f, 0.f, 0.f};
    bf16x8 At[4][2], B0[2][2], B1[2][2];
    const char* cA = (const char*)g.A + (size_t)cur.pm * tstep; const char* cB = (const char*)g.Bt + (size_t)cur.pn * tstep;
    S.a_ready(cur);
    if constexpr (SP2) {
        PG8_STAGE(PG8_SB(0, 0), cB, voffB); PG8_STAGE(PG8_SB(0, 1), cB + hstep, voffB); PG8_STAGE(PG8_SA(0, 0), cA, voffA); PG8_STAGE(PG8_SA(0, 1), cA + hstep, voffA);
        if (wr == 1) PG8_BAR;
        PG8_WAIT_V(2); PG8_BAR;
        PG8_STAGE(PG8_SB(1, 0), cB + kstep, voffB); PG8_STAGE(PG8_SA(1, 0), cA + kstep, voffA); PG8_STAGE(PG8_SB(1, 1), cB + hstep + kstep, voffB);
        PG8_WAIT_V(6); PG8_BAR;
    } else {
        PG8_STAGE(PG8_SB(0, 0), cB, voffB); PG8_STAGE(PG8_SA(0, 0), cA, voffA); PG8_STAGE(PG8_SB(0, 1), cB + hstep, voffB); PG8_STAGE(PG8_SA(0, 1), cA + hstep, voffA);
        if (wr == 1) PG8_BAR;
        PG8_WAIT_V(4); PG8_BAR;
        PG8_STAGE(PG8_SB(1, 0), cB + kstep, voffB); PG8_STAGE(PG8_SA(1, 0), cA + kstep, voffA); PG8_STAGE(PG8_SB(1, 1), cB + hstep + kstep, voffB);
        PG8_WAIT_V(6); PG8_BAR;
    }
    for (;;) {
        const bool has_next = S.next(ui + 1, nxt);
        const char* nA = has_next ? (const char*)g.A + (size_t)nxt.pm * tstep : cA; const char* nB = has_next ? (const char*)g.Bt + (size_t)nxt.pn * tstep : cB;
        for (int t = 0; t < nt; t += 2) {
            const bool last = (t == nt - 2);
            const char* a1 = cA + (size_t)(t + 1) * kstep;
            const char* a2 = last ? nA : cA + (size_t)(t + 2) * kstep; const char* b2 = last ? nB : cB + (size_t)(t + 2) * kstep;
            const char* a3 = a2 + kstep; const char* b3 = b2 + kstep;
            if (last && has_next) S.a_ready(nxt);
            if constexpr (SP2) {
            PG8_LDB(B0, 0, 0); PG8_LDB(B1, 0, 1); PG8_SCHED; PG8_LDA(At, 0, 0); PG8_STAGE(PG8_SA(1, 1), a1 + hstep, voffA);
            PG8_WAIT_V(8); PG8_WAIT_L(0); PG8_BAR; PG8_MMA(0, 0, At, B0); PG8_MMA(0, 1, At, B1); PG8_BAR; PG8_SCHED;
            PG8_LDA(At, 0, 1); PG8_STAGE(PG8_SB(0, 0), b2, voffB); PG8_STAGE(PG8_SB(0, 1), b2 + hstep, voffB); PG8_STAGE(PG8_SA(0, 0), a2, voffA);
            PG8_WAIT_V(8); PG8_WAIT_L(0); PG8_BAR; PG8_MMA(1, 0, At, B0); PG8_MMA(1, 1, At, B1); PG8_BAR; PG8_SCHED;
            PG8_LDB(B0, 1, 0); PG8_LDB(B1, 1, 1); PG8_SCHED; PG8_LDA(At, 1, 0); PG8_STAGE(PG8_SA(0, 1), a2 + hstep, voffA);
            PG8_WAIT_V(8); PG8_WAIT_L(0); PG8_BAR; PG8_MMA(0, 0, At, B0); PG8_MMA(0, 1, At, B1); PG8_BAR; PG8_SCHED;
            PG8_LDA(At, 1, 1); PG8_STAGE(PG8_SB(1, 0), b3, voffB); PG8_STAGE(PG8_SB(1, 1), b3 + hstep, voffB); PG8_STAGE(PG8_SA(1, 0), a3, voffA);
            PG8_WAIT_V(8); PG8_WAIT_L(0); PG8_BAR; PG8_MMA(1, 0, At, B0); PG8_MMA(1, 1, At, B1); PG8_BAR; PG8_SCHED;
            } else {
            PG8_LDB(B0, 0, 0); PG8_SCHED; PG8_LDA(At, 0, 0); PG8_STAGE(PG8_SA(1, 1), a1 + hstep, voffA);
            PG8_WAIT_L(8); PG8_BAR; PG8_WAIT_L(0); PG8_MMA(0, 0, At, B0); PG8_BAR; PG8_SCHED;
            PG8_LDB(B1, 0, 1); PG8_STAGE(PG8_SB(0, 0), b2, voffB);
            PG8_BAR; PG8_WAIT_L(0); PG8_MMA(0, 1, At, B1); PG8_BAR;
            PG8_LDA(At, 0, 1); PG8_STAGE(PG8_SA(0, 0), a2, voffA);
            PG8_BAR; PG8_WAIT_L(0); PG8_MMA(1, 0, At, B0); PG8_BAR; PG8_SCHED;
            PG8_STAGE(PG8_SB(0, 1), b2 + hstep, voffB);
            PG8_WAIT_V(6); PG8_BAR; PG8_MMA(1, 1, At, B1); PG8_BAR;
            PG8_LDB(B0, 1, 0); PG8_SCHED; PG8_LDA(At, 1, 0); PG8_STAGE(PG8_SA(0, 1), a2 + hstep, voffA);
            PG8_WAIT_L(8); PG8_BAR; PG8_WAIT_L(0); PG8_MMA(0, 0, At, B0); PG8_BAR; PG8_SCHED;
            PG8_LDB(B1, 1, 1); PG8_STAGE(PG8_SB(1, 0), b3, voffB);
            PG8_BAR; PG8_WAIT_L(0); PG8_MMA(0, 1, At, B1); PG8_BAR;
            PG8_LDA(At, 1, 1); PG8_STAGE(PG8_SA(1, 0), a3, voffA);
            PG8_BAR; PG8_WAIT_L(0); PG8_MMA(1, 0, At, B0); PG8_BAR; PG8_SCHED;
            PG8_STAGE(PG8_SB(1, 1), b3 + hstep, voffB);
            PG8_WAIT_V(6); PG8_BAR; PG8_MMA(1, 1, At, B1); PG8_BAR;
            }
        }
        if constexpr (ALIGN_EPI) { if (wr == 0) PG8_BAR; }
        if constexpr (!Epi::AFTER_DRAIN) { E(acc, cur, wr, wc, fr, fq); S.done(cur); }
        if (!has_next) break;
#pragma unroll
        for (int a = 0; a < 2; ++a)
#pragma unroll
            for (int b = 0; b < 2; ++b)
#pragma unroll
                for (int m = 0; m < 4; ++m)
#pragma unroll
                    for (int n = 0; n < 2; ++n) acc[a][b][m][n] = (f32x4){0.f, 0.f, 0.f, 0.f};
        cur = nxt; cA = nA; cB = nB; ++ui;
        if constexpr (ALIGN_EPI) { if (wr == 1) PG8_BAR; }
    }
    PG8_WAIT_V(0);
    if constexpr (!ALIGN_EPI) { if (wr == 0) PG8_BAR; }
    PG8_BAR;
    if constexpr (Epi::AFTER_DRAIN) { E.fused(acc, cur, wr, wc, fr, fq, lds, wid, lane); S.done(cur); }
#undef PG8_SA
#undef PG8_SB
#undef PG8_STAGE
#undef PG8_LDA
#undef PG8_LDB
#undef PG8_MMA
#undef PG8_WAIT_V
#undef PG8_WAIT_L
#undef PG8_BAR
#undef PG8_SCHED
}
}

#define LAS __attribute__((address_space(3)))
typedef unsigned short bf16;
typedef unsigned u32x4 __attribute__((ext_vector_type(4)));
typedef unsigned u32x2 __attribute__((ext_vector_type(2)));
typedef float f32x4 __attribute__((ext_vector_type(4)));
typedef short bf16x8 __attribute__((ext_vector_type(8)));
typedef float f32x2 __attribute__((ext_vector_type(2)));
constexpr int DM = 1024, NBATCH = 16, SEQ = 2048, MTOK = NBATCH * SEQ, NH = 16;
constexpr int N_IN = 8320, RW_COLS = 4224, PA = 4352, PB = 4096, MIXW = 2048;
constexpr float RMS_EPS = 1e-5f, GN_EPS = 64e-5f;
constexpr size_t MiB = 1u << 20;
constexpr size_t WS_CTL = 0, WS_PART = 1 * MiB, WS_WTIN = 3 * MiB, WS_WTOUT = 20 * MiB, WS_WUPT = 24 * MiB, WS_AUPT = 24 * MiB + 256 * 1024, WS_LSE = 25 * MiB,
                 WS_MIX = 32 * MiB, WS_P = 160 * MiB, WS_XB = 432 * MiB, WS_END = 496 * MiB;
constexpr int LDS_BYTES = 147456;
constexpr int NWAVES = 8, NTHR = 512;

struct Ptrs {
    const float *x, *norm_w, *w_in, *mu, *w0, *w_up, *a0, *a_up, *k_k, *k_a, *r_k, *ln_w, *ln_b, *w_out, *fin_w;
    float* out; float* part; float* lse;
    bf16 *wtin, *wtout, *wupT, *aupT, *mix, *P, *xb, *o1, *o2, *o3;
};

__device__ __forceinline__ unsigned f2bf(float f) { unsigned u = __builtin_bit_cast(unsigned, f); return (u + 0x7fffu + ((u >> 16) & 1u)) >> 16; }
typedef __bf16 bf16x2_t __attribute__((ext_vector_type(2)));
__device__ __forceinline__ unsigned pk2(float lo, float hi) { const f32x2 v = (f32x2){lo, hi}; const bf16x2_t bq = __builtin_convertvector(v, bf16x2_t); return __builtin_bit_cast(unsigned, bq); }
__device__ __forceinline__ float bflo(unsigned w) { return __builtin_bit_cast(float, w << 16); }
__device__ __forceinline__ float bfhi(unsigned w) { return __builtin_bit_cast(float, w & 0xffff0000u); }
__device__ __forceinline__ float wave_sum(float v) {
#pragma unroll
    for (int o = 1; o < 64; o <<= 1) v += __shfl_xor(v, o);
    return v;
}
__device__ __forceinline__ float silu(float g) { return g / (1.f + __expf(-g)); }

__device__ __forceinline__ void p0_transpose_item(const float* W, int K, int N, bf16* WT, int split, LAS float* scr, int item, int lane) {
    const int nblk = N / 32, kb = item / nblk, nb = item % nblk, k0 = 64 * kb, n0 = 32 * nb;
    const int row_off = (n0 >= split) ? 128 : 0;
#pragma unroll 8
    for (int i = 0; i < 32; ++i) { const int kk = 2 * i + (lane >> 5); scr[kk * 33 + (lane & 31)] = W[(size_t)(k0 + kk) * N + n0 + (lane & 31)]; }
    asm volatile("s_waitcnt lgkmcnt(0)" ::: "memory");
    const int c = lane & 7;
#pragma unroll
    for (int j = 0; j < 4; ++j) { const int n = (lane >> 3) + 8 * j; const LAS float* s = scr + (8 * c) * 33 + n;
        u32x4 o; o.x = pk2(s[0 * 33], s[1 * 33]); o.y = pk2(s[2 * 33], s[3 * 33]); o.z = pk2(s[4 * 33], s[5 * 33]); o.w = pk2(s[6 * 33], s[7 * 33]);
        *(u32x4*)(WT + (size_t)(row_off + n0 + n) * K + k0 + 8 * c) = o; }
    asm volatile("s_waitcnt lgkmcnt(0)" ::: "memory");
}
__device__ __forceinline__ void p0_prologue(LAS unsigned char* lds, const Ptrs& P, int tid, bool zero_mix) {
    const int wave = __builtin_amdgcn_readfirstlane(tid >> 6), lane = tid & 63;
    LAS float* scr = (LAS float*)(lds + wave * 16384);
    const int gw = blockIdx.x * NWAVES + wave, NGW = gridDim.x * NWAVES;
    constexpr int I_IN = (DM / 64) * (N_IN / 32), I_OUT = (MIXW / 64) * (DM / 32), I_UP = DM / 32;
    constexpr int NITEMS = I_IN + I_OUT + 2 * I_UP;
    for (int it = gw; it < NITEMS; it += NGW) {
        int r = it;
        if (r < I_IN) { p0_transpose_item(P.w_in, DM, N_IN, P.wtin, RW_COLS, scr, r, lane); continue; } r -= I_IN;
        if (r < I_OUT) { p0_transpose_item(P.w_out, MIXW, DM, P.wtout, 1 << 30, scr, r, lane); continue; } r -= I_OUT;
        if (r < I_UP) { p0_transpose_item(P.w_up, 64, DM, P.wupT, 1 << 30, scr, r, lane); continue; } r -= I_UP;
        p0_transpose_item(P.a_up, 64, DM, P.aupT, 1 << 30, scr, r, lane);
    }
    { const int gt = blockIdx.x * NTHR + tid, NGT = gridDim.x * NTHR; u32x4* z = (u32x4*)(P.wtin + (size_t)RW_COLS * DM);
      for (int i = gt; i < 128 * DM * 2 / 16; i += NGT) z[i] = (u32x4){0u, 0u, 0u, 0u};
      if (zero_mix) { u32x4* zm = (u32x4*)P.mix; for (size_t i = gt; i < (size_t)MTOK * MIXW * 2 / 16; i += NGT) zm[i] = (u32x4){0u, 0u, 0u, 0u}; } }
    for (int m = gw; m < MTOK; m += NGW) {
        const f32x4* xr = (const f32x4*)(P.x + (size_t)m * DM) + lane; const f32x4* wr = (const f32x4*)P.norm_w + lane;
        f32x4 v[4]; float s = 0.f;
#pragma unroll
        for (int j = 0; j < 4; ++j) { v[j] = xr[64 * j]; s += (v[j].x * v[j].x + v[j].y * v[j].y) + (v[j].z * v[j].z + v[j].w * v[j].w); }
        const float rstd = 1.f / sqrtf(wave_sum(s) * (1.f / DM) + RMS_EPS);
        unsigned long long* o8 = (unsigned long long*)(P.xb + (size_t)m * DM) + lane;
#pragma unroll
        for (int j = 0; j < 4; ++j) { const f32x4 w = wr[64 * j];
            o8[64 * j] = (unsigned long long)pk2(v[j].x * rstd * w.x, v[j].y * rstd * w.y) | ((unsigned long long)pk2(v[j].z * rstd * w.z, v[j].w * rstd * w.w) << 32); }
    }
}

namespace rw {
constexpr int T = 32, NCH = SEQ / T;
constexpr size_t SEC = (size_t)256 * 2048 * 64;
constexpr int O_DEC = 0, O_BV = 8192, O_K = 16384, O_R = 24576, O_AV = 32768, BUF = 40960;
constexpr int L_B = 0, L_V = 2 * BUF, L_Y = L_V + 3 * 8192, L_ST = L_Y + 2 * 8192, WLS = 144, ST_W = 16 * WLS, L_BON = L_ST + 4 * 2 * ST_W, L_END = L_BON + 3 * T * 4;
static_assert(L_END <= LDS_BYTES, "rwkv LDS");
template <int CTRL> __device__ __forceinline__ float dpp_add(float x) {
    const int y = __builtin_amdgcn_update_dpp(0, __builtin_bit_cast(int, x), CTRL, 0xf, 0xf, false);
    return x + __builtin_bit_cast(float, y);
}
__device__ __forceinline__ float allreduce16(float x) {
    x = dpp_add<0xB1>(x);
    x = dpp_add<0x4E>(x);
    x = dpp_add<0x141>(x);
    x = dpp_add<0x140>(x);
    return x;
}
__device__ __forceinline__ float allreduce8(float x) {
    x = dpp_add<0xB1>(x); x = dpp_add<0x4E>(x); x = dpp_add<0x141>(x);
    return x;
}
__device__ __forceinline__ void lerp8(const u32x4 cur, const u32x4 prv, const f32x4 m0, const f32x4 m1, float (&v)[8]) {
#pragma unroll
    for (int i = 0; i < 4; ++i) { const float cl = bflo(cur[i]), ch = bfhi(cur[i]), pl = bflo(prv[i]), ph = bfhi(prv[i]);
        const float ma = (i < 2) ? m0[2 * i] : m1[2 * i - 4], mb = (i < 2) ? m0[2 * i + 1] : m1[2 * i - 3];
        v[2 * i] = cl + (pl - cl) * ma; v[2 * i + 1] = ch + (ph - ch) * mb; }
}
}

__device__ __forceinline__ void rwkv_phase(LAS unsigned char* lds, const Ptrs& P, int tid) {
    using namespace rw;
    const int wv = __builtin_amdgcn_readfirstlane(tid >> 6), lane = tid & 63, fr = lane & 15, fq = lane >> 4;
    const bf16* Pb = P.P;
    const float* mu = P.mu; const float* g_w0 = P.w0; const float* g_a0 = P.a0; const float* g_kk = P.k_k; const float* g_ka = P.k_a; const float* g_rk = P.r_k;
    const float* g_lw = P.ln_w; const float* g_lb = P.ln_b; bf16* mix = P.mix;
    const int pw = wv & 3;
    const int ptt = lane >> 3, c8 = (lane & 7) * 8;
    const int trow = pw * 8 + ptt;
    LAS unsigned char* stw = lds + L_ST + pw * 2 * ST_W; LAS unsigned char* sta = stw + ST_W;
    for (int bh = blockIdx.x; bh < NBATCH * NH; bh += gridDim.x) {
        const int b = bh >> 4, h = bh & 15;
        const bf16* pR = Pb + (size_t)bh * 2048 * 64; const bf16* pK = pR + SEC; const bf16* pV = pR + 2 * SEC; const bf16* pG = pR + 3 * SEC;
        const bf16* pL = Pb + 4 * SEC + (size_t)b * 2048 * 128;
        bf16x8 bw[4][2], ba[4][2];
        if (wv >= 4) {
#pragma unroll
            for (int nt = 0; nt < 4; ++nt)
#pragma unroll
                for (int ks = 0; ks < 2; ++ks) { bw[nt][ks] = *(const bf16x8*)(P.wupT + (size_t)(h * 64 + nt * 16 + fr) * 64 + ks * 32 + fq * 8);
                                                 ba[nt][ks] = *(const bf16x8*)(P.aupT + (size_t)(h * 64 + nt * 16 + fr) * 64 + ks * 32 + fq * 8); }
        }
        f32x2 S2[2][4];
#pragma unroll
        for (int i = 0; i < 2; ++i)
#pragma unroll
            for (int q = 0; q < 4; ++q) S2[i][q] = (f32x2){0.f, 0.f};
        for (int c = -1; c <= NCH; ++c) {
            if (wv < 4) {
                if (c >= 0 && c < NCH) {
                    __builtin_amdgcn_s_setprio(3);
                    const int rg = lane >> 3, kg = lane & 7;
                    const LAS float* bb = (const LAS float*)(lds + L_B + (c & 1) * BUF) + kg * 8;
                    const LAS float* pv = (const LAS float*)(lds + L_V + (c % 3) * 8192) + wv * 16 + rg * 2;
                    LAS float* py = (LAS float*)(lds + L_Y + (c & 1) * 8192) + wv * 16 + rg * 2;
                    const bool hi4 = (kg & 4) != 0; const int yrow = (kg >> 2) & 1;
#define RW_LD8(dst, off, tt) do { dst[0] = *(const LAS f32x4*)(bb + (off) / 4 + (tt) * 64); dst[1] = *(const LAS f32x4*)(bb + (off) / 4 + (tt) * 64 + 4); } while (0)
                    f32x4 n_dec[2], n_bv[2], n_kk[2], n_rr[2], n_av[2]; f32x2 n_vv;
                    RW_LD8(n_dec, O_DEC, 0); RW_LD8(n_bv, O_BV, 0); RW_LD8(n_kk, O_K, 0); RW_LD8(n_rr, O_R, 0); RW_LD8(n_av, O_AV, 0); n_vv = *(const LAS f32x2*)pv;
#pragma unroll 2
                    for (int t = 0; t < T; ++t) {
                        f32x2 de[4], bv[4], kk[4], rr[4], av[4];
#pragma unroll
                        for (int q = 0; q < 2; ++q) {
                            de[2 * q] = (f32x2){n_dec[q][0], n_dec[q][1]}; de[2 * q + 1] = (f32x2){n_dec[q][2], n_dec[q][3]};
                            bv[2 * q] = (f32x2){n_bv[q][0], n_bv[q][1]}; bv[2 * q + 1] = (f32x2){n_bv[q][2], n_bv[q][3]};
                            kk[2 * q] = (f32x2){n_kk[q][0], n_kk[q][1]}; kk[2 * q + 1] = (f32x2){n_kk[q][2], n_kk[q][3]};
                            rr[2 * q] = (f32x2){n_rr[q][0], n_rr[q][1]}; rr[2 * q + 1] = (f32x2){n_rr[q][2], n_rr[q][3]};
                            av[2 * q] = (f32x2){n_av[q][0], n_av[q][1]}; av[2 * q + 1] = (f32x2){n_av[q][2], n_av[q][3]};
                        }
                        const f32x2 vv = n_vv;
                        const int tn = (t + 1 < T) ? t + 1 : t;
                        RW_LD8(n_dec, O_DEC, tn); RW_LD8(n_bv, O_BV, tn); RW_LD8(n_kk, O_K, tn); RW_LD8(n_rr, O_R, tn); RW_LD8(n_av, O_AV, tn); n_vv = *(const LAS f32x2*)(pv + tn * 64);
                        float sa[2];
#pragma unroll
                        for (int i = 0; i < 2; ++i) { const f32x2 q = (S2[i][0] * av[0] + S2[i][1] * av[1]) + (S2[i][2] * av[2] + S2[i][3] * av[3]); sa[i] = q.x + q.y; }
#pragma unroll
                        for (int i = 0; i < 2; ++i) sa[i] = allreduce8(sa[i]);
#pragma unroll
                        for (int i = 0; i < 2; ++i) {
                            const f32x2 s2 = (f32x2){sa[i], sa[i]}, v2 = (f32x2){vv[i], vv[i]};
#pragma unroll
                            for (int q = 0; q < 4; ++q) S2[i][q] = S2[i][q] * de[q] + s2 * bv[q] + v2 * kk[q];
                        }
                        float y[2];
#pragma unroll
                        for (int i = 0; i < 2; ++i) { const f32x2 q = (S2[i][0] * rr[0] + S2[i][1] * rr[1]) + (S2[i][2] * rr[2] + S2[i][3] * rr[3]); y[i] = q.x + q.y; }
                        const float e0 = dpp_add<0x141>(y[0]), e1 = dpp_add<0x141>(y[1]);
                        float w = hi4 ? e1 : e0;
                        w = dpp_add<0xB1>(w); w = dpp_add<0x4E>(w);
                        if ((kg & 3) == 0) py[t * 64 + yrow] = w;
                    }
#undef RW_LD8
                    __builtin_amdgcn_s_setprio(0);
                }
            } else {
                if (c >= 1) {
                    const int cp = c - 1, t = cp * T + trow, o = trow * 64 + c8;
                    const LAS float* aY = (const LAS float*)(lds + L_Y + (cp & 1) * 8192); const LAS float* aV = (const LAS float*)(lds + L_V + (cp % 3) * 8192);
                    const u32x4 g = *(const u32x4*)(pG + (size_t)t * 64 + c8);
                    const f32x4 lw0 = *(const f32x4*)(g_lw + h * 64 + c8), lw1 = *(const f32x4*)(g_lw + h * 64 + c8 + 4);
                    const f32x4 lb0 = *(const f32x4*)(g_lb + h * 64 + c8), lb1 = *(const f32x4*)(g_lb + h * 64 + c8 + 4);
                    const f32x4 y0 = *(const LAS f32x4*)(aY + o), y1 = *(const LAS f32x4*)(aY + o + 4), v0 = *(const LAS f32x4*)(aV + o), v1 = *(const LAS f32x4*)(aV + o + 4);
                    const float bon = ((const LAS float*)(lds + L_BON))[(cp % 3) * T + trow];
                    const float s = allreduce8((y0.x + y0.y) + (y0.z + y0.w) + (y1.x + y1.y) + (y1.z + y1.w));
                    const float mean = s * (1.f / 64.f);
                    const f32x4 d0 = y0 - mean, d1 = y1 - mean;
                    const float q = allreduce8((d0.x * d0.x + d0.y * d0.y) + (d0.z * d0.z + d0.w * d0.w) + (d1.x * d1.x + d1.y * d1.y) + (d1.z * d1.z + d1.w * d1.w));
                    const float rstd = 1.f / sqrtf(q * (1.f / 64.f) + GN_EPS);
                    const f32x4 e0 = d0 * rstd * lw0 + lb0 + bon * v0, e1 = d1 * rstd * lw1 + lb1 + bon * v1;
                    u32x4 ov;
                    ov.x = pk2(e0.x * silu(bflo(g.x)), e0.y * silu(bfhi(g.x))); ov.y = pk2(e0.z * silu(bflo(g.y)), e0.w * silu(bfhi(g.y)));
                    ov.z = pk2(e1.x * silu(bflo(g.z)), e1.y * silu(bfhi(g.z))); ov.w = pk2(e1.z * silu(bflo(g.w)), e1.w * silu(bfhi(g.w)));
                    *(u32x4*)(mix + ((size_t)b * SEQ + t) * MIXW + h * 64 + c8) = ov;
                }
                if (c + 1 < NCH) {
                    const int cn = c + 1, t = cn * T + trow, o = trow * 64 + c8;
                    LAS float* B = (LAS float*)(lds + L_B + (cn & 1) * BUF);
                    LAS float* aV = (LAS float*)(lds + L_V + (cn % 3) * 8192);
                    const bf16* sR = pR + (size_t)t * 64 + c8; const bf16* sK = pK + (size_t)t * 64 + c8; const bf16* sV = pV + (size_t)t * 64 + c8;
                    const bf16* sW = pL + (size_t)t * 128 + c8; const bf16* sA = sW + 64;
                    const u32x4 zz = (u32x4){0u, 0u, 0u, 0u};
                    const u32x4 cR = *(const u32x4*)sR, cK = *(const u32x4*)sK, cV = *(const u32x4*)sV, cW = *(const u32x4*)sW, cA = *(const u32x4*)sA;
                    u32x4 qR = zz, qK = zz, qV = zz, qW = zz, qA = zz;
                    if (t > 0) { qR = *(const u32x4*)(sR - 64); qK = *(const u32x4*)(sK - 64); qV = *(const u32x4*)(sV - 64); qW = *(const u32x4*)(sW - 128); qA = *(const u32x4*)(sA - 128); }
                    const int hc = h * 64 + c8;
                    float v[8];
                    lerp8(cR, qR, *(const f32x4*)(mu + hc), *(const f32x4*)(mu + hc + 4), v);
                    *(LAS f32x4*)(B + O_R / 4 + o) = (f32x4){v[0], v[1], v[2], v[3]}; *(LAS f32x4*)(B + O_R / 4 + o + 4) = (f32x4){v[4], v[5], v[6], v[7]};
                    const f32x4 r0 = (f32x4){v[0], v[1], v[2], v[3]}, r1 = (f32x4){v[4], v[5], v[6], v[7]};
                    lerp8(cV, qV, *(const f32x4*)(mu + 2048 + hc), *(const f32x4*)(mu + 2048 + hc + 4), v);
                    *(LAS f32x4*)(aV + o) = (f32x4){v[0], v[1], v[2], v[3]}; *(LAS f32x4*)(aV + o + 4) = (f32x4){v[4], v[5], v[6], v[7]};
                    lerp8(cW, qW, *(const f32x4*)(mu + 3072 + c8), *(const f32x4*)(mu + 3072 + c8 + 4), v);
#pragma unroll
                    for (int i = 0; i < 8; ++i) v[i] = 1.f - 2.f / (1.f + __expf(2.f * v[i]));
                    { u32x4 ow; ow.x = pk2(v[0], v[1]); ow.y = pk2(v[2], v[3]); ow.z = pk2(v[4], v[5]); ow.w = pk2(v[6], v[7]); *(LAS u32x4*)(stw + ptt * WLS + c8 * 2) = ow; }
                    lerp8(cA, qA, *(const f32x4*)(mu + 3136 + c8), *(const f32x4*)(mu + 3136 + c8 + 4), v);
                    { u32x4 ow; ow.x = pk2(v[0], v[1]); ow.y = pk2(v[2], v[3]); ow.z = pk2(v[4], v[5]); ow.w = pk2(v[6], v[7]); *(LAS u32x4*)(sta + ptt * WLS + c8 * 2) = ow; }
                    lerp8(cK, qK, *(const f32x4*)(mu + 1024 + hc), *(const f32x4*)(mu + 1024 + hc + 4), v);
                    const f32x4 k0 = (f32x4){v[0], v[1], v[2], v[3]}, k1 = (f32x4){v[4], v[5], v[6], v[7]};
                    {
                        bf16x8 aw[2], aa[2];
#pragma unroll
                        for (int ks = 0; ks < 2; ++ks) { aw[ks] = *(const LAS bf16x8*)(stw + fr * WLS + (ks * 32 + fq * 8) * 2); aa[ks] = *(const LAS bf16x8*)(sta + fr * WLS + (ks * 32 + fq * 8) * 2); }
#pragma unroll
                        for (int nt = 0; nt < 4; ++nt) {
                            f32x4 accw = (f32x4){0.f, 0.f, 0.f, 0.f}, acca = (f32x4){0.f, 0.f, 0.f, 0.f};
#pragma unroll
                            for (int ks = 0; ks < 2; ++ks) { accw = __builtin_amdgcn_mfma_f32_16x16x32_bf16(aw[ks], bw[nt][ks], accw, 0, 0, 0);
                                                             acca = __builtin_amdgcn_mfma_f32_16x16x32_bf16(aa[ks], ba[nt][ks], acca, 0, 0, 0); }
                            if (fq < 2) {
#pragma unroll
                                for (int j = 0; j < 4; ++j) { const int oo = (pw * 8 + fq * 4 + j) * 64 + nt * 16 + fr; B[O_DEC / 4 + oo] = accw[j]; B[O_BV / 4 + oo] = acca[j]; }
                            }
                        }
                    }
                    {
                        const f32x4 wr0 = *(const LAS f32x4*)(B + O_DEC / 4 + o), wr1 = *(const LAS f32x4*)(B + O_DEC / 4 + o + 4), ar0 = *(const LAS f32x4*)(B + O_BV / 4 + o), ar1 = *(const LAS f32x4*)(B + O_BV / 4 + o + 4);
                        const f32x4 w00 = *(const f32x4*)(g_w0 + hc), w01 = *(const f32x4*)(g_w0 + hc + 4), a00 = *(const f32x4*)(g_a0 + hc), a01 = *(const f32x4*)(g_a0 + hc + 4);
                        const f32x4 kk0 = *(const f32x4*)(g_kk + hc), kk1 = *(const f32x4*)(g_kk + hc + 4), ka0 = *(const f32x4*)(g_ka + hc), ka1 = *(const f32x4*)(g_ka + hc + 4);
                        const f32x4 rk0 = *(const f32x4*)(g_rk + hc), rk1 = *(const f32x4*)(g_rk + hc + 4);
                        f32x4 dec0, dec1, a0v, a1v;
#pragma unroll
                        for (int i = 0; i < 4; ++i) {
                            { const float z = -(w00[i] + wr0[i]); const float sp = fmaxf(z, 0.f) + __logf(1.f + __expf(-fabsf(z))); dec0[i] = __expf(-__expf(-sp - 0.5f)); a0v[i] = 1.f / (1.f + __expf(-(a00[i] + ar0[i]))); }
                            { const float z = -(w01[i] + wr1[i]); const float sp = fmaxf(z, 0.f) + __logf(1.f + __expf(-fabsf(z))); dec1[i] = __expf(-__expf(-sp - 0.5f)); a1v[i] = 1.f / (1.f + __expf(-(a01[i] + ar1[i]))); }
                        }
                        f32x4 n0 = k0 * kk0, n1 = k1 * kk1;
                        const float ss = allreduce8((n0.x * n0.x + n0.y * n0.y) + (n0.z * n0.z + n0.w * n0.w) + (n1.x * n1.x + n1.y * n1.y) + (n1.z * n1.z + n1.w * n1.w));
                        const float inv = 1.f / fmaxf(sqrtf(ss), 1e-12f);
                        n0 = n0 * inv; n1 = n1 * inv;
                        const f32x4 kp0 = k0 * (1.f + (a0v - 1.f) * ka0), kp1 = k1 * (1.f + (a1v - 1.f) * ka1);
                        const f32x4 bq0 = r0 * kp0 * rk0, bq1 = r1 * kp1 * rk1;
                        const float bon = allreduce8((bq0.x + bq0.y) + (bq0.z + bq0.w) + (bq1.x + bq1.y) + (bq1.z + bq1.w));
                        *(LAS f32x4*)(B + O_DEC / 4 + o) = dec0; *(LAS f32x4*)(B + O_DEC / 4 + o + 4) = dec1;
                        *(LAS f32x4*)(B + O_K / 4 + o) = kp0; *(LAS f32x4*)(B + O_K / 4 + o + 4) = kp1;
                        *(LAS f32x4*)(B + O_AV / 4 + o) = -n0; *(LAS f32x4*)(B + O_AV / 4 + o + 4) = -n1;
                        *(LAS f32x4*)(B + O_BV / 4 + o) = n0 * a0v; *(LAS f32x4*)(B + O_BV / 4 + o + 4) = n1 * a1v;
                        if ((lane & 7) == 0) ((LAS float*)(lds + L_BON))[(cn % 3) * T + trow] = bon;
                    }
                }
            }
            __syncthreads();
        }
    }
}

namespace att { constexpr int KST = 144, NSL = 3, VST = NSL * 256 + 16, L_K = 0, L_V = NSL * 128 * KST; static_assert(L_V + 64 * VST <= LDS_BYTES, "att LDS"); constexpr size_t SEC = (size_t)256 * 2048 * 64; }

__device__ __forceinline__ void attn_phase(LAS unsigned char* lds, const Ptrs& P, int tid) {
    using namespace att;
    const int wv = __builtin_amdgcn_readfirstlane(tid >> 6), lane = tid & 63, fr = lane & 15, fq = lane >> 4;
    const float NEG = -__builtin_inff();
    bf16* const po1 = P.o1; bf16* const po2 = P.o2; bf16* const po3 = P.o3; float* const plse = P.lse; bf16* const mix = P.mix;
    for (int i = tid; i < 64 * VST / 16; i += NTHR) *(LAS u32x4*)(lds + L_V + i * 16) = (u32x4){0u, 0u, 0u, 0u};
    __syncthreads();
    const int i0 = wv * 16, qi = i0 + fr, ks0 = i0 < 96 ? i0 : 96;
    const int kkey0 = tid >> 3, kpc = tid & 7, vpc = tid >> 6, vkp = tid & 63;
    for (int bh = blockIdx.x; bh < NBATCH * NH; bh += gridDim.x) {
        const int b = bh >> 4, h = bh & 15;
        const bf16* pQ = P.P + (size_t)bh * 2048 * 64; const bf16* pK = pQ + SEC; const bf16* pV = pQ + 2 * SEC; const bf16* pG = pQ + 3 * SEC;
        u32x4 rk0, rk1, rv0, rv1; bf16x8 rq0, rq1;
#define ATT_LOAD(G) do { const int p_ = (G) >> 4, u_ = (G) & 15, sh_ = 2 * p_, r_ = u_ >> (4 - sh_), n_ = u_ & ((16 >> sh_) - 1); \
            const int lb_ = n_ * 128; \
            rk0 = *(const u32x4*)(pK + (size_t)(((lb_ + kkey0) << sh_) + r_) * 64 + kpc * 8); rk1 = *(const u32x4*)(pK + (size_t)(((lb_ + 64 + kkey0) << sh_) + r_) * 64 + kpc * 8); \
            rv0 = *(const u32x4*)(pV + (size_t)(((lb_ + 2 * vkp) << sh_) + r_) * 64 + vpc * 8); rv1 = *(const u32x4*)(pV + (size_t)(((lb_ + 2 * vkp + 1) << sh_) + r_) * 64 + vpc * 8); \
            const size_t tq_ = (size_t)(((lb_ + qi) << sh_) + r_); rq0 = *(const bf16x8*)(pQ + tq_ * 64 + fq * 8); rq1 = *(const bf16x8*)(pQ + tq_ * 64 + 32 + fq * 8); } while (0)
        ATT_LOAD(0);
        for (int g = 0; g < 48; ++g) {
            const int p = g >> 4, u = g & 15, sh = 2 * p, r = u >> (4 - sh), n = u & ((16 >> sh) - 1);
            const int scur = g % 3, sprev = (g + 2) % 3;
            *(LAS u32x4*)(lds + L_K + (scur * 128 + kkey0) * KST + kpc * 16) = rk0;
            *(LAS u32x4*)(lds + L_K + (scur * 128 + 64 + kkey0) * KST + kpc * 16) = rk1;
#pragma unroll
            for (int m = 0; m < 4; ++m) {
                const unsigned lo = (rv0[m] & 0xffffu) | (rv1[m] << 16), hi = (rv0[m] >> 16) | (rv1[m] & 0xffff0000u);
                *(LAS unsigned*)(lds + L_V + (vpc * 8 + 2 * m) * VST + (scur * 128 + 2 * vkp) * 2) = lo;
                *(LAS unsigned*)(lds + L_V + (vpc * 8 + 2 * m + 1) * VST + (scur * 128 + 2 * vkp) * 2) = hi;
            }
            const bf16x8 qf0 = rq0, qf1 = rq1;
            __syncthreads();
            if (g + 1 < 48) ATT_LOAD(g + 1);
            const size_t tokq = (size_t)(((n * 128 + qi) << sh) + r);
            bf16* OP = ((p == 0) ? po1 : (p == 1 ? po2 : po3)) + (size_t)bh * 2048 * 64;
            float* LSE = plse + (size_t)p * MTOK * 16 + (size_t)bh * 2048;
            f32x4 st[10];
#pragma unroll
            for (int kt = 0; kt < 10; ++kt) {
                const int kb = ks0 + kt * 16, pos = ((kb >> 7) ? scur : sprev) * 128 + (kb & 127);
                const LAS unsigned char* kp = lds + L_K + (pos + fr) * KST + fq * 16;
                f32x4 acc = (f32x4){0.f, 0.f, 0.f, 0.f};
                acc = __builtin_amdgcn_mfma_f32_16x16x32_bf16(*(const LAS bf16x8*)kp, qf0, acc, 0, 0, 0);
                acc = __builtin_amdgcn_mfma_f32_16x16x32_bf16(*(const LAS bf16x8*)(kp + 64), qf1, acc, 0, 0, 0);
                st[kt] = acc;
            }
            const int lo = (n == 0 && qi < 128) ? 128 : qi;
            const int dl = ks0 + 4 * fq - lo; const unsigned span = (unsigned)(qi + 128 - lo);
            float m = NEG;
#pragma unroll
            for (int kt = 0; kt < 10; ++kt)
#pragma unroll
                for (int j = 0; j < 4; ++j) {
                    const bool valid = (unsigned)(dl + kt * 16 + j) <= span;
                    const float s = valid ? st[kt][j] : NEG;
                    st[kt][j] = s; m = fmaxf(m, s);
                }
            m = fmaxf(m, __shfl_xor(m, 16)); m = fmaxf(m, __shfl_xor(m, 32));
            const float C = 0.125f * 1.4426950408889634f, mc = m * C;
            float ls = 0.f;
#pragma unroll
            for (int kt = 0; kt < 10; ++kt)
#pragma unroll
                for (int j = 0; j < 4; ++j) { const float pe = __builtin_amdgcn_exp2f(st[kt][j] * C - mc); st[kt][j] = pe; ls += pe; }
            ls += __shfl_xor(ls, 16); ls += __shfl_xor(ls, 32);
            f32x4 oacc[4];
#pragma unroll
            for (int dt = 0; dt < 4; ++dt) oacc[dt] = (f32x4){0.f, 0.f, 0.f, 0.f};
#pragma unroll
            for (int s5 = 0; s5 < 5; ++s5) {
                u32x4 pw; pw.x = pk2(st[2 * s5][0], st[2 * s5][1]); pw.y = pk2(st[2 * s5][2], st[2 * s5][3]);
                pw.z = pk2(st[2 * s5 + 1][0], st[2 * s5 + 1][1]); pw.w = pk2(st[2 * s5 + 1][2], st[2 * s5 + 1][3]);
                const bf16x8 pb = __builtin_bit_cast(bf16x8, pw);
                const int kb0 = ks0 + 32 * s5, kb1 = kb0 + 16;
                const int pos0 = ((kb0 >> 7) ? scur : sprev) * 128 + (kb0 & 127) + 4 * fq, pos1 = ((kb1 >> 7) ? scur : sprev) * 128 + (kb1 & 127) + 4 * fq;
#pragma unroll
                for (int dt = 0; dt < 4; ++dt) {
                    const LAS unsigned char* vp = lds + L_V + (dt * 16 + fr) * VST;
                    const u32x2 lo2 = *(const LAS u32x2*)(vp + pos0 * 2), hi2 = *(const LAS u32x2*)(vp + pos1 * 2);
                    const u32x4 aw = (u32x4){lo2.x, lo2.y, hi2.x, hi2.y};
                    oacc[dt] = __builtin_amdgcn_mfma_f32_16x16x32_bf16(__builtin_bit_cast(bf16x8, aw), pb, oacc[dt], 0, 0, 0);
                }
            }
            const float inv = 1.f / ls;
            if (p < 2) {
#pragma unroll
                for (int dt = 0; dt < 4; ++dt) {
                    u32x2 ow; ow.x = pk2(oacc[dt][0] * inv, oacc[dt][1] * inv); ow.y = pk2(oacc[dt][2] * inv, oacc[dt][3] * inv);
                    *(u32x2*)(OP + tokq * 64 + dt * 16 + 4 * fq) = ow;
                }
                if (fq == 0) LSE[tokq] = m * 0.125f + __logf(ls);
            } else {
                const size_t row = (size_t)bh * 2048 + tokq;
                const float l1 = plse[row], l2 = plse[(size_t)MTOK * 16 + row], l3 = m * 0.125f + __logf(ls);
                const float mx = fmaxf(l1, fmaxf(l2, l3));
                float e1 = __expf(l1 - mx), e2 = __expf(l2 - mx), e3 = __expf(l3 - mx);
                const float winv = 1.f / (e1 + e2 + e3); e1 *= winv; e2 *= winv; e3 *= winv * inv;
                bf16* mrow = mix + ((size_t)b * SEQ + tokq) * MIXW + 1024 + h * 64 + 4 * fq;
#pragma unroll
                for (int dt = 0; dt < 4; ++dt) {
                    const u32x2 a1 = *(const u32x2*)(po1 + row * 64 + dt * 16 + 4 * fq), a2 = *(const u32x2*)(po2 + row * 64 + dt * 16 + 4 * fq);
                    const u32x2 gt = *(const u32x2*)(pG + tokq * 64 + dt * 16 + 4 * fq);
                    u32x2 ow;
                    ow.x = pk2((e1 * bflo(a1.x) + e2 * bflo(a2.x) + e3 * oacc[dt][0]) * silu(bflo(gt.x)), (e1 * bfhi(a1.x) + e2 * bfhi(a2.x) + e3 * oacc[dt][1]) * silu(bfhi(gt.x)));
                    ow.y = pk2((e1 * bflo(a1.y) + e2 * bflo(a2.y) + e3 * oacc[dt][2]) * silu(bflo(gt.y)), (e1 * bfhi(a1.y) + e2 * bfhi(a2.y) + e3 * oacc[dt][3]) * silu(bfhi(gt.y)));
                    *(u32x2*)(mrow + dt * 16) = ow;
                }
            }
        }
#undef ATT_LOAD
        __syncthreads();
        __syncthreads();
    }
}

__device__ __forceinline__ void final_norm(const Ptrs& P, int tid) {
    const int wave = tid >> 6, lane = tid & 63;
    const int gw = blockIdx.x * NWAVES + wave, NGW = gridDim.x * NWAVES;
    for (int m = gw; m < MTOK; m += NGW) {
        float ps = (lane < 16) ? P.part[(size_t)m * 16 + lane] : 0.f;
        ps += __shfl_xor(ps, 1); ps += __shfl_xor(ps, 2); ps += __shfl_xor(ps, 4); ps += __shfl_xor(ps, 8);
        const float ss = __shfl(ps, 0);
        const float rstd = 1.f / sqrtf(ss * (1.f / DM) + RMS_EPS);
        f32x4* o = (f32x4*)(P.out + (size_t)m * DM) + lane; const f32x4* w = (const f32x4*)P.fin_w + lane;
#pragma unroll
        for (int j = 0; j < 4; ++j) { const f32x4 v = o[64 * j]; o[64 * j] = v * rstd * w[64 * j]; }
    }
}

#define XB_TMO      128
#define XB_XCNT(j)  (256  + 64 * (j))
#define XB_XSUB(j)  (1280 + 64 * (j))
#define XB_XGEN(j)  (2304 + 64 * (j))
#define XB_TOP      3328
#define XB_TOPGEN   3392
#define XCD_BAR_WORDS 3456
#define XB_SPIN_CAP (1u << 18)

__device__ __forceinline__ unsigned xb_ld(unsigned* p)              { return __hip_atomic_load(p, __ATOMIC_RELAXED, __HIP_MEMORY_SCOPE_AGENT); }
__device__ __forceinline__ unsigned xb_add(unsigned* p, unsigned v) { return __hip_atomic_fetch_add(p, v, __ATOMIC_RELAXED, __HIP_MEMORY_SCOPE_AGENT); }
__device__ __forceinline__ unsigned xb_xcc_id() { return (unsigned)__builtin_amdgcn_s_getreg((3 << 11) | 20) & 0xFu; }
#define XB_SPIN(cond, bar) do { unsigned _sp = 0; while (cond) { __builtin_amdgcn_s_sleep(1); \
    if ((++_sp & 255u) == 0u) { if (xb_ld(&(bar)[XB_TMO])) break; if (_sp > XB_SPIN_CAP) { atomicAdd(&(bar)[XB_TMO], 1u); break; } } } } while (0)

struct XcdBarrier {
    unsigned* bar; unsigned x;
    volatile LAS unsigned* st;
};

__device__ __forceinline__ XcdBarrier xcd_barrier_post(unsigned* bar, volatile LAS unsigned* st) {
    XcdBarrier b; b.bar = bar; b.x = xb_xcc_id(); b.st = st;
    if (threadIdx.x == 0) (void)xb_add(&bar[XB_XCNT(b.x)], 1u);
    return b;
}
__device__ __forceinline__ void xcd_barrier_complete(unsigned* bar, unsigned x, unsigned& nloc, unsigned& nx) {
    const unsigned G = gridDim.x * gridDim.y * gridDim.z;
    unsigned sum, cnt, mine, sp = 0u;
    for (;;) {
        sum = 0u; cnt = 0u; mine = 0u;
#pragma unroll
        for (unsigned j = 0; j < 16; ++j) { const unsigned c = xb_ld(&bar[XB_XCNT(j)]); sum += c; cnt += (c > 0u) ? 1u : 0u; mine = (j == x) ? c : mine; }
        if (sum == G) break;
        __builtin_amdgcn_s_sleep(1);
        if ((++sp & 255u) == 0u) { if (xb_ld(&bar[XB_TMO])) break; if (sp > XB_SPIN_CAP) { atomicAdd(&bar[XB_TMO], 1u); break; } }
    }
    nloc = mine > 0u ? mine : 1u; nx = cnt > 0u ? cnt : 1u;
}

__device__ __forceinline__ void xcd_barrier(const XcdBarrier& b) {
    asm volatile("s_waitcnt vmcnt(0)" ::: "memory");
    __syncthreads();
    if (threadIdx.x == 0) {
        unsigned* bar = b.bar;
        __builtin_amdgcn_s_waitcnt(0);
        unsigned nloc = b.st[0], nx = b.st[1];
        if (nloc == 0u) { xcd_barrier_complete(bar, b.x, nloc, nx); b.st[0] = nloc; b.st[1] = nx; }
        const unsigned old = xb_add(&bar[XB_XSUB(b.x)], 1u);
        const unsigned gen = old / nloc;
        if (old + 1u == (gen + 1u) * nloc) {
            __builtin_amdgcn_fence(__ATOMIC_RELEASE, "agent");
            asm volatile("s_waitcnt vmcnt(0)" ::: "memory");
            const unsigned og = xb_add(&bar[XB_TOP], 1u);
            const unsigned tg = og / nx;
            if (og + 1u == (tg + 1u) * nx) xb_add(&bar[XB_TOPGEN], 1u);
            else XB_SPIN(xb_ld(&bar[XB_TOPGEN]) == tg, bar);
            __builtin_amdgcn_fence(__ATOMIC_ACQUIRE, "agent");
            xb_add(&bar[XB_XGEN(b.x)], 1u);
            asm volatile("s_waitcnt vmcnt(0)" ::: "memory");
        } else {
            XB_SPIN(xb_ld(&bar[XB_XGEN(b.x)]) == gen, bar);
            __builtin_amdgcn_fence(__ATOMIC_ACQUIRE, "agent");
            asm volatile("s_waitcnt vmcnt(0)" ::: "memory");
        }
    }
    __syncthreads();
}

struct Args { const float* in[15]; float* out; unsigned char* ws; int mask; int sync; };
#ifndef MK_MULTI
#define MK_MULTI 0
#endif
#ifndef MK_REP
#define MK_REP 0
#endif
#ifndef MK_MASK
#define MK_MASK 0x7f
#endif
__global__ void __launch_bounds__(NTHR, 2) fwd_kernel(Args a) {
    extern __shared__ __attribute__((aligned(16))) unsigned char lds_[];
    LAS unsigned char* lds = (LAS unsigned char*)lds_;
    cg::grid_group grid = cg::this_grid();
    const int tid = threadIdx.x;
    Ptrs P;
    P.x = a.in[0]; P.norm_w = a.in[1]; P.w_in = a.in[2]; P.mu = a.in[3]; P.w0 = a.in[4]; P.w_up = a.in[5]; P.a0 = a.in[6]; P.a_up = a.in[7];
    P.k_k = a.in[8]; P.k_a = a.in[9]; P.r_k = a.in[10]; P.ln_w = a.in[11]; P.ln_b = a.in[12]; P.w_out = a.in[13]; P.fin_w = a.in[14];
    P.out = a.out; unsigned char* ws = a.ws;
    P.part = (float*)(ws + WS_PART); P.lse = (float*)(ws + WS_LSE);
    P.wtin = (bf16*)(ws + WS_WTIN); P.wtout = (bf16*)(ws + WS_WTOUT); P.wupT = (bf16*)(ws + WS_WUPT); P.aupT = (bf16*)(ws + WS_AUPT);
    P.mix = (bf16*)(ws + WS_MIX); P.P = (bf16*)(ws + WS_P); P.xb = (bf16*)(ws + WS_XB);
    P.o1 = (bf16*)a.out; P.o2 = (bf16*)a.out + (size_t)MTOK * DM; P.o3 = (bf16*)(ws + WS_XB);
    const int mask = a.mask;
    volatile LAS unsigned* xst = (volatile LAS unsigned*)(lds + LDS_BYTES - 64);
    if (tid < 16) xst[tid] = 0u;
    __syncthreads();
    XcdBarrier xbar; xbar.bar = (unsigned*)(ws + WS_CTL) + 4096; xbar.x = 0; xbar.st = xst;
    if (a.sync) xbar = xcd_barrier_post((unsigned*)(ws + WS_CTL) + 4096, xst);
#define SEAM() do { if (a.sync) xcd_barrier(xbar); } while (0)
#define SEAM_CG() do { if (a.sync == 2) grid.sync(); else if (a.sync) xcd_barrier(xbar); } while (0)
    if (mask & 1) p0_prologue(lds, P, tid, (mask & 0x80) != 0);
    SEAM_CG();
    if (mask & 2) {
        pg8::Gemm g{P.xb, P.wtin, MTOK, PA, DM}; pg8::StaticOrder S; S.init(MTOK, PA, gridDim.x, (int)blockIdx.x);
        pg8::EpiHM<1> E{P.P};
        pg8::gemm_phase<pg8::EpiHM<1>, pg8::StaticOrder, true, true>(lds, g, S, E);
    }
    SEAM();
    if (mask & 4) for (int rep = 0; rep < ((MK_REP & 4) ? 2 : 1); ++rep) rwkv_phase(lds, P, tid);
    SEAM();
    if (mask & 8) {
        pg8::Gemm g{P.xb, P.wtin + (size_t)PA * DM, MTOK, PB, DM}; pg8::StaticOrder S; S.init(MTOK, PB, gridDim.x, (int)blockIdx.x);
        pg8::EpiHM<0> E{P.P};
        pg8::gemm_phase<pg8::EpiHM<0>, pg8::StaticOrder, true, true>(lds, g, S, E);
    }
    SEAM();
    if (mask & 16) for (int rep = 0; rep < ((MK_REP & 16) ? 2 : 1); ++rep) attn_phase(lds, P, tid);
    SEAM();
    if (mask & 32) {
        pg8::Gemm g{P.mix, P.wtout, MTOK, DM, MIXW}; pg8::StaticOrder S; S.init(MTOK, DM, gridDim.x, (int)blockIdx.x);
        pg8::EpiResF32 E{P.x, P.out, P.part, DM};
        pg8::gemm_phase<pg8::EpiResF32, pg8::StaticOrder, true, true>(lds, g, S, E);
    }
    SEAM();
    if (mask & 64) final_norm(P, tid);
}

extern "C" void kernel_launch(void* const* d_in, const int* in_sizes, int n_in, void* d_out, int out_size, void* d_ws, size_t ws_size, hipStream_t stream) {
    static int grid = 0;
    if (grid == 0) {
        if (n_in != 15 || in_sizes[0] != MTOK * DM || out_size != MTOK * DM || ws_size < WS_END) {
            fprintf(stderr, "kernel_launch: unexpected shapes / workspace (n_in %d, ws %zu, need %zu); nothing launched\n", n_in, ws_size, (size_t)WS_END); grid = -1; return; }
        int dev = 0, cus = 0, per_cu = 0;
        if (hipGetDevice(&dev) != hipSuccess || hipDeviceGetAttribute(&cus, hipDeviceAttributeMultiprocessorCount, dev) != hipSuccess) { grid = -1; return; }
        if (hipFuncSetAttribute((const void*)fwd_kernel, hipFuncAttributeMaxDynamicSharedMemorySize, LDS_BYTES) != hipSuccess) { fprintf(stderr, "kernel_launch: hipFuncSetAttribute failed\n"); grid = -1; return; }
        if (hipOccupancyMaxActiveBlocksPerMultiprocessor(&per_cu, (const void*)fwd_kernel, NTHR, LDS_BYTES) != hipSuccess || per_cu < 1) { fprintf(stderr, "kernel_launch: occupancy query says %d blocks per CU\n", per_cu); grid = -1; return; }
        grid = cus;
    }
    if (grid < 0) return;
    if (hipMemsetAsync((char*)d_ws + WS_CTL, 0, 64 * 1024, stream) != hipSuccess) { fprintf(stderr, "kernel_launch: hipMemsetAsync failed\n"); return; }
    Args a{};
    for (int i = 0; i < 15; ++i) a.in[i] = (const float*)d_in[i];
    a.out = (float*)d_out; a.ws = (unsigned char*)d_ws;
#if MK_MULTI
    for (int ph = 0; ph < 7; ++ph) {
        a.mask = (1 << ph) & (MK_MASK); if (ph == 0) a.mask |= (MK_MASK & 0x80); a.sync = 0;
        if (!(a.mask & 0x7f)) continue;
        hipLaunchKernelGGL(fwd_kernel, dim3(grid), dim3(NTHR), LDS_BYTES, stream, a);
    }
#else
    a.mask = MK_MASK; a.sync = 1;
    void* args[] = {&a};
    hipError_t e = hipLaunchCooperativeKernel((void*)fwd_kernel, dim3(grid), dim3(NTHR), args, LDS_BYTES, stream);
    if (e != hipSuccess) fprintf(stderr, "cooperative launch failed: %s (grid %d)\n", hipGetErrorString(e), grid);
#endif
}
```

```cpp
#include <hip/hip_runtime.h>
#include <hip/hip_cooperative_groups.h>
#include <cstdio>
#include <cstdint>
namespace cg = cooperative_groups;
#define MK_MULTI 0
#define MK_MASK 0x7f
#define MK_REP 0
namespace pg8 {
#define PG8_LAS __attribute__((address_space(3)))
typedef unsigned short bf16_t;
typedef short bf16x8 __attribute__((ext_vector_type(8)));
typedef float f32x4 __attribute__((ext_vector_type(4)));
typedef unsigned u32x4 __attribute__((ext_vector_type(4)));
constexpr int BM = 256, BK = 64, HALF = 128, HTB = HALF * BK * 2  , STAGE_BYTES = 8 * HTB, NXCD = 8, WGM = 8;

__host__ __device__ __forceinline__ int lds_byte(int r, int c) { const int st = (r >> 4) * 2 + (c >> 5), rr = r & 15, cc = c & 31, ob = rr * 64 + cc * 2; return st * 1024 + (ob ^ (((ob >> 9) & 1) << 5)); }
__host__ __device__ __forceinline__ void stage_rc(int b, int& R, int& C) { const int st = b / 1024, sb = b % 1024, swz = sb ^ (((sb >> 9) & 1) << 5); R = (st >> 1) * 16 + swz / 64; C = (st & 1) * 32 + (swz % 64) / 2; }
__host__ __device__ __forceinline__ int perm32(int rho) { const int n = rho >> 4, i = rho & 15; return 8 * (i >> 2) + 4 * n + (i & 3); }

struct Unit { int pm, pn; };
struct Gemm { const bf16_t* A; const bf16_t* Bt; int M, N, K; };

struct StaticOrder {
    int nM, nN, nwg, G, c;
    __host__ __device__ void init(int M, int N, int G_, int c_) { nM = M / BM; nN = N / BM; nwg = nM * nN; G = G_; c = c_; }
    __host__ __device__ bool next(int i, Unit& u) const {
        const long L = (long)i * G + c; if (L >= nwg) return false;
        int wgid = (int)L; { const int q = nwg / NXCD, r = nwg % NXCD, xcd = wgid % NXCD, off = wgid / NXCD; wgid = (xcd < r ? xcd * (q + 1) : r * (q + 1) + (xcd - r) * q) + off; }
        const int nig = WGM * nN, gid = wgid / nig, fm = gid * WGM, gsz = (nM - fm) < WGM ? (nM - fm) : WGM;
        u.pm = fm + ((wgid % nig) % gsz); u.pn = (wgid % nig) / gsz; return true;
    }
    __device__ __forceinline__ void a_ready(const Unit&) const {}
    __device__ __forceinline__ void done(const Unit&) const {}
};

__device__ __forceinline__ unsigned cvt_pk_bf16(float lo, float hi) { unsigned r; asm volatile("v_cvt_pk_bf16_f32 %0, %1, %2" : "=v"(r) : "v"(lo), "v"(hi)); return r; }
typedef float f32x2 __attribute__((ext_vector_type(2)));
__device__ __forceinline__ f32x2 gelu_pk(f32x2 v) {
    const f32x2 av = __builtin_elementwise_abs(v), d = av * 0.2316418882f + 1.0f;
    f32x2 t; t.x = __builtin_amdgcn_rcpf(d.x); t.y = __builtin_amdgcn_rcpf(d.y);
    f32x2 q = t * 0.5307027145f + (-0.7265760135f); q = q * t + 0.7107068705f; q = q * t + (-0.142248368f); q = q * t + 0.127414796f; q = q * t;
    const f32x2 s = (v * v) * (-0.72134752044f);
    f32x2 e; e.x = __builtin_amdgcn_exp2f(s.x); e.y = __builtin_amdgcn_exp2f(s.y);
    const f32x2 m = v * (q * e), r = v - m;
    f32x2 o; o.x = v.x < 0.f ? m.x : r.x; o.y = v.y < 0.f ? m.y : r.y; return o;
}

template <int ACT  > struct EpiBf16 {
    static constexpr bool PERM = true, AFTER_DRAIN = false; static_assert(ACT == 0 || ACT == 1, "EpiBf16: ACT is 0 (none) or 1 (gelu_pk)");
    bf16_t* O; int ldc; const float* bias; int split_cols; size_t split_stride; float scale0;
    __device__ __forceinline__ void operator()(const f32x4 (&acc)[2][2][4][2], const Unit& u, int wr, int wc, int fr, int fq) const {
        const int row0 = u.pm * BM + wr * 64 + fr; int colt = u.pn * BM; bf16_t* base = O;
        float sc = 1.f; if (split_cols) { const int t = colt / split_cols; base += (size_t)t * split_stride; colt -= t * split_cols; if (t == 0) sc = scale0; }
        const int col0 = colt + wc * 32 + 8 * fq, bcol0 = u.pn * BM + wc * 32 + 8 * fq;
        f32x4 bv[2][2];
#pragma unroll
        for (int bj = 0; bj < 2; ++bj)
#pragma unroll
            for (int n = 0; n < 2; ++n) bv[bj][n] = bias ? *(const f32x4*)(bias + bcol0 + bj * HALF + 4 * n) : (f32x4){0.f, 0.f, 0.f, 0.f};
#pragma unroll
        for (int ai = 0; ai < 2; ++ai)
#pragma unroll
            for (int m = 0; m < 4; ++m) { bf16_t* rowp = base + (size_t)(row0 + ai * HALF + m * 16) * ldc + col0;
#pragma unroll
                for (int bj = 0; bj < 2; ++bj) { f32x4 v0 = acc[ai][bj][m][0] + bv[bj][0], v1 = acc[ai][bj][m][1] + bv[bj][1];
                    if (ACT == 1) { f32x2 a = gelu_pk((f32x2){v0[0], v0[1]}), b = gelu_pk((f32x2){v0[2], v0[3]}), c = gelu_pk((f32x2){v1[0], v1[1]}), d = gelu_pk((f32x2){v1[2], v1[3]});
                        v0 = (f32x4){a.x, a.y, b.x, b.y}; v1 = (f32x4){c.x, c.y, d.x, d.y}; }
                    v0 = v0 * sc; v1 = v1 * sc; u32x4 w; w.x = cvt_pk_bf16(v0[0], v0[1]); w.y = cvt_pk_bf16(v0[2], v0[3]); w.z = cvt_pk_bf16(v1[0], v1[1]); w.w = cvt_pk_bf16(v1[2], v1[3]);
                    *(u32x4*)(rowp + bj * HALF) = w; } }
    }
};
struct EpiResF32 {
    static constexpr bool PERM = false, AFTER_DRAIN = false;
    const float* base; float* out; float* part; int ldc;
    __device__ __forceinline__ void operator()(const f32x4 (&acc)[2][2][4][2], const Unit& u, int wr, int wc, int fr, int fq) const {
        const int col0 = u.pn * BM + wc * 32 + 4 * fq;
#pragma unroll
        for (int ai = 0; ai < 2; ++ai)
#pragma unroll
            for (int m = 0; m < 4; ++m) {
                const int row = u.pm * BM + ai * HALF + wr * 64 + m * 16 + fr;
                const size_t off = (size_t)row * ldc + col0;
                float ss = 0.f;
#pragma unroll
                for (int bj = 0; bj < 2; ++bj)
#pragma unroll
                    for (int n = 0; n < 2; ++n) {
                        const f32x4 b = *(const f32x4*)(base + off + bj * HALF + n * 16);
                        const f32x4 h = b + acc[ai][bj][m][n];
                        *(f32x4*)(out + off + bj * HALF + n * 16) = h;
                        ss += (h[0] * h[0] + h[1] * h[1]) + (h[2] * h[2] + h[3] * h[3]);
                    }
                ss += __shfl_xor(ss, 16); ss += __shfl_xor(ss, 32);
                if (fq == 0) part[(size_t)row * 16 + u.pn * 4 + wc] = ss;
            }
    }
};
template <int MODE> struct EpiHM {
    static constexpr bool PERM = true, AFTER_DRAIN = false;
    static constexpr size_t SEC = (size_t)256 * 2048 * 64;
    bf16_t* O;
    __device__ __forceinline__ void operator()(const f32x4 (&acc)[2][2][4][2], const Unit& u, int wr, int wc, int fr, int fq) const {
        const int row0 = u.pm * BM + wr * 64 + fr;
        const size_t bterm = (size_t)(row0 >> 11) * (16 * 2048 * 64);
#pragma unroll
        for (int bj = 0; bj < 2; ++bj) {
            const int c0 = u.pn * BM + bj * HALF + wc * 32 + 8 * fq;
            bf16_t* base; bool hm = true, skip = false;
            if (MODE == 0 || c0 < 3072) { base = O + (size_t)(c0 >> 10) * SEC + (size_t)((c0 >> 6) & 15) * (2048 * 64) + (c0 & 63); }
            else if (c0 < 3200) { base = O + 4 * SEC + (c0 - 3072); hm = false; }
            else if (c0 < 4224) { const int c1 = c0 - 3200; base = O + 3 * SEC + (size_t)(c1 >> 6) * (2048 * 64) + (c1 & 63); }
            else { base = O; skip = true; }
            if (skip) continue;
#pragma unroll
            for (int ai = 0; ai < 2; ++ai)
#pragma unroll
                for (int m = 0; m < 4; ++m) {
                    const int row = row0 + ai * HALF + m * 16;
                    bf16_t* p = hm ? base + bterm + (size_t)(row & 2047) * 64 : base + (size_t)row * 128;
                    const f32x4 v0 = acc[ai][bj][m][0], v1 = acc[ai][bj][m][1];
                    u32x4 w; w.x = cvt_pk_bf16(v0[0], v0[1]); w.y = cvt_pk_bf16(v0[2], v0[3]); w.z = cvt_pk_bf16(v1[0], v1[1]); w.w = cvt_pk_bf16(v1[2], v1[3]);
                    *(u32x4*)p = w;
                }
        }
    }
};
template <class Epi, class Sched, bool ALIGN_EPI = false, bool SP2 = false>
__device__ __forceinline__ void gemm_phase(PG8_LAS unsigned char* lds, const Gemm g, const Sched& S, const Epi& E) {
    const int tid = threadIdx.x, wid = __builtin_amdgcn_readfirstlane(tid >> 6), lane = tid & 63, wr = wid >> 2, wc = wid & 3, fr = lane & 15, fq = lane >> 4;
    const int K = g.K, nt = K / BK;
    unsigned voffA[2], voffB[2];
#pragma unroll
    for (int i = 0; i < 2; ++i) { int R, C; stage_rc(tid * 16 + i * 8192, R, C); const int Rb = Epi::PERM ? ((R & ~31) + perm32(R & 31)) : R;
        voffA[i] = (unsigned)(R * K + C) * 2u; voffB[i] = (unsigned)(Rb * K + C) * 2u; }
    const size_t kstep = (size_t)(BK * 2);
    const size_t hstep = (size_t)HALF * K * 2;
    const size_t tstep = 2 * hstep;
    const unsigned ldsw = (unsigned)wid * 1024u;
    const int aoff = lds_byte(wr * 64 + fr, fq * 8), boff = lds_byte(wc * 32 + fr, fq * 8);
#define PG8_SA(b, h) (((b) * 2 + (h)) * HTB)
#define PG8_SB(b, h) ((4 + (b) * 2 + (h)) * HTB)
#define PG8_STAGE(bufoff, gbase, voff) do { _Pragma("unroll") for (int _i = 0; _i < 2; ++_i) \
        __builtin_amdgcn_global_load_lds((const unsigned*)((const char*)(gbase) + (voff)[_i]), (PG8_LAS unsigned*)(lds + (bufoff) + ldsw + _i * 8192), 16, 0, 0); } while (0)
#define PG8_LDA(dst, b, h) do { _Pragma("unroll") for (int m = 0; m < 4; ++m) _Pragma("unroll") for (int k = 0; k < 2; ++k) dst[m][k] = *(const PG8_LAS bf16x8*)(lds + PG8_SA(b, h) + aoff + m * 2048 + k * 1024); } while (0)
#define PG8_LDB(dst, b, h) do { _Pragma("unroll") for (int n = 0; n < 2; ++n) _Pragma("unroll") for (int k = 0; k < 2; ++k) dst[n][k] = *(const PG8_LAS bf16x8*)(lds + PG8_SB(b, h) + boff + n * 2048 + k * 1024); } while (0)
#define PG8_MMA(ai, bj, At, Bt) do { __builtin_amdgcn_s_setprio(1); _Pragma("unroll") for (int m = 0; m < 4; ++m) _Pragma("unroll") for (int n = 0; n < 2; ++n) _Pragma("unroll") for (int k = 0; k < 2; ++k) \
        acc[ai][bj][m][n] = __builtin_amdgcn_mfma_f32_16x16x32_bf16(Bt[n][k], At[m][k], acc[ai][bj][m][n], 0, 0, 0); __builtin_amdgcn_s_setprio(0); } while (0)
#define PG8_WAIT_V(n) asm volatile("s_waitcnt vmcnt(" #n ")" ::: "memory")
#define PG8_WAIT_L(n) asm volatile("s_waitcnt lgkmcnt(" #n ")" ::: "memory")
#define PG8_BAR __builtin_amdgcn_s_barrier()
#define PG8_SCHED __builtin_amdgcn_sched_barrier(0)
    Unit cur, nxt; int ui = 0;
    if (!S.next(0, cur)) return;
    f32x4 acc[2][2][4][2];
#pragma unroll
    for (int a = 0; a < 2; ++a)
#pragma unroll
        for (int b = 0; b < 2; ++b)
#pragma unroll
            for (int m = 0; m < 4; ++m)
#pragma unroll
                for (int n = 0; n < 2; ++n) acc[a][b][m][n] = (f32x4){0.f, 0.f, 0.f, 0.f};
    bf16x8 At[4][2], B0[2][2], B1[2][2];
    const char* cA = (const char*)g.A + (size_t)cur.pm * tstep; const char* cB = (const char*)g.Bt + (size_t)cur.pn * tstep;
    S.a_ready(cur);
    if constexpr (SP2) {
        PG8_STAGE(PG8_SB(0, 0), cB, voffB); PG8_STAGE(PG8_SB(0, 1), cB + hstep, voffB); PG8_STAGE(PG8_SA(0, 0), cA, voffA); PG8_STAGE(PG8_SA(0, 1), cA + hstep, voffA);
        if (wr == 1) PG8_BAR;
        PG8_WAIT_V(2); PG8_BAR;
        PG8_STAGE(PG8_SB(1, 0), cB + kstep, voffB); PG8_STAGE(PG8_SA(1, 0), cA + kstep, voffA); PG8_STAGE(PG8_SB(1, 1), cB + hstep + kstep, voffB);
        PG8_WAIT_V(6); PG8_BAR;
    } else {
        PG8_STAGE(PG8_SB(0, 0), cB, voffB); PG8_STAGE(PG8_SA(0, 0), cA, voffA); PG8_STAGE(PG8_SB(0, 1), cB + hstep, voffB); PG8_STAGE(PG8_SA(0, 1), cA + hstep, voffA);
        if (wr == 1) PG8_BAR;
        PG8_WAIT_V(4); PG8_BAR;
        PG8_STAGE(PG8_SB(1, 0), cB + kstep, voffB); PG8_STAGE(PG8_SA(1, 0), cA + kstep, voffA); PG8_STAGE(PG8_SB(1, 1), cB + hstep + kstep, voffB);
        PG8_WAIT_V(6); PG8_BAR;
    }
    for (;;) {
        const bool has_next = S.next(ui + 1, nxt);
        const char* nA = has_next ? (const char*)g.A + (size_t)nxt.pm * tstep : cA; const char* nB = has_next ? (const char*)g.Bt + (size_t)nxt.pn * tstep : cB;
        for (int t = 0; t < nt; t += 2) {
            const bool last = (t == nt - 2);
            const char* a1 = cA + (size_t)(t + 1) * kstep;
            const char* a2 = last ? nA : cA + (size_t)(t + 2) * kstep; const char* b2 = last ? nB : cB + (size_t)(t + 2) * kstep;
            const char* a3 = a2 + kstep; const char* b3 = b2 + kstep;
            if (last && has_next) S.a_ready(nxt);
            if constexpr (SP2) {
            PG8_LDB(B0, 0, 0); PG8_LDB(B1, 0, 1); PG8_SCHED; PG8_LDA(At, 0, 0); PG8_STAGE(PG8_SA(1, 1), a1 + hstep, voffA);
            PG8_WAIT_V(8); PG8_WAIT_L(0); PG8_BAR; PG8_MMA(0, 0, At, B0); PG8_MMA(0, 1, At, B1); PG8_BAR; PG8_SCHED;
            PG8_LDA(At, 0, 1); PG8_STAGE(PG8_SB(0, 0), b2, voffB); PG8_STAGE(PG8_SB(0, 1), b2 + hstep, voffB); PG8_STAGE(PG8_SA(0, 0), a2, voffA);
            PG8_WAIT_V(8); PG8_WAIT_L(0); PG8_BAR; PG8_MMA(1, 0, At, B0); PG8_MMA(1, 1, At, B1); PG8_BAR; PG8_SCHED;
            PG8_LDB(B0, 1, 0); PG8_LDB(B1, 1, 1); PG8_SCHED; PG8_LDA(At, 1, 0); PG8_STAGE(PG8_SA(0, 1), a2 + hstep, voffA);
            PG8_WAIT_V(8); PG8_WAIT_L(0); PG8_BAR; PG8_MMA(0, 0, At, B0); PG8_MMA(0, 1, At, B1); PG8_BAR; PG8_SCHED;
            PG8_LDA(At, 1, 1); PG8_STAGE(PG8_SB(1, 0), b3, voffB); PG8_STAGE(PG8_SB(1, 1), b3 + hstep, voffB); PG8_STAGE(PG8_SA(1, 0), a3, voffA);
            PG8_WAIT_V(8); PG8_WAIT_L(0); PG8_BAR; PG8_MMA(1, 0, At, B0); PG8_MMA(1, 1, At, B1); PG8_BAR; PG8_SCHED;
            } else {
            PG8_LDB(B0, 0, 0); PG8_SCHED; PG8_LDA(At, 0, 0); PG8_STAGE(PG8_SA(1, 1), a1 + hstep, voffA);
            PG8_WAIT_L(8); PG8_BAR; PG8_WAIT_L(0); PG8_MMA(0, 0, At, B0); PG8_BAR; PG8_SCHED;
            PG8_LDB(B1, 0, 1); PG8_STAGE(PG8_SB(0, 0), b2, voffB);
            PG8_BAR; PG8_WAIT_L(0); PG8_MMA(0, 1, At, B1); PG8_BAR;
            PG8_LDA(At, 0, 1); PG8_STAGE(PG8_SA(0, 0), a2, voffA);
            PG8_BAR; PG8_WAIT_L(0); PG8_MMA(1, 0, At, B0); PG8_BAR; PG8_SCHED;
            PG8_STAGE(PG8_SB(0, 1), b2 + hstep, voffB);
            PG8_WAIT_V(6); PG8_BAR; PG8_MMA(1, 1, At, B1); PG8_BAR;
            PG8_LDB(B0, 1, 0); PG8_SCHED; PG8_LDA(At, 1, 0); PG8_STAGE(PG8_SA(0, 1), a2 + hstep, voffA);
            PG8_WAIT_L(8); PG8_BAR; PG8_WAIT_L(0); PG8_MMA(0, 0, At, B0); PG8_BAR; PG8_SCHED;
            PG8_LDB(B1, 1, 1); PG8_STAGE(PG8_SB(1, 0), b3, voffB);
            PG8_BAR; PG8_WAIT_L(0); PG8_MMA(0, 1, At, B1); PG8_BAR;
            PG8_LDA(At, 1, 1); PG8_STAGE(PG8_SA(1, 0), a3, voffA);
            PG8_BAR; PG8_WAIT_L(0); PG8_MMA(1, 0, At, B0); PG8_BAR; PG8_SCHED;
            PG8_STAGE(PG8_SB(1, 1), b3 + hstep, voffB);
            PG8_WAIT_V(6); PG8_BAR; PG8_MMA(1, 1, At, B1); PG8_BAR;
            }
        }
        if constexpr (ALIGN_EPI) { if (wr == 0) PG8_BAR; }
        if constexpr (!Epi::AFTER_DRAIN) { E(acc, cur, wr, wc, fr, fq); S.done(cur); }
        if (!has_next) break;
#pragma unroll
        for (int a = 0; a < 2; ++a)
#pragma unroll
            for (int b = 0; b < 2; ++b)
#pragma unroll
                for (int m = 0; m < 4; ++m)
#pragma unroll
                    for (int n = 0; n < 2; ++n) acc[a][b][m][n] = (f32x4){0.f, 0.f, 0.f, 0.f};
        cur = nxt; cA = nA; cB = nB; ++ui;
        if constexpr (ALIGN_EPI) { if (wr == 1) PG8_BAR; }
    }
    PG8_WAIT_V(0);
    if constexpr (!ALIGN_EPI) { if (wr == 0) PG8_BAR; }
    PG8_BAR;
    if constexpr (Epi::AFTER_DRAIN) { E.fused(acc, cur, wr, wc, fr, fq, lds, wid, lane); S.done(cur); }
#undef PG8_SA
#undef PG8_SB
#undef PG8_STAGE
#undef PG8_LDA
#undef PG8_LDB
#undef PG8_MMA
#undef PG8_WAIT_V
#undef PG8_WAIT_L
#undef PG8_BAR
#undef PG8_SCHED
}
}

#define LAS __attribute__((address_space(3)))
typedef unsigned short bf16;
typedef unsigned u32x4 __attribute__((ext_vector_type(4)));
typedef unsigned u32x2 __attribute__((ext_vector_type(2)));
typedef float f32x4 __attribute__((ext_vector_type(4)));
typedef short bf16x8 __attribute__((ext_vector_type(8)));
typedef float f32x2 __attribute__((ext_vector_type(2)));
constexpr int DM = 1024, NBATCH = 16, SEQ = 2048, MTOK = NBATCH * SEQ, NH = 16;
constexpr int N_IN = 8320, RW_COLS = 4224, PA = 4352, PB = 4096, MIXW = 2048;
constexpr float RMS_EPS = 1e-5f, GN_EPS = 64e-5f;
constexpr size_t MiB = 1u << 20;
constexpr size_t WS_CTL = 0, WS_PART = 1 * MiB, WS_WTIN = 3 * MiB, WS_WTOUT = 20 * MiB, WS_WUPT = 24 * MiB, WS_AUPT = 24 * MiB + 256 * 1024, WS_LSE = 25 * MiB,
                 WS_MIX = 32 * MiB, WS_P = 160 * MiB, WS_XB = 432 * MiB, WS_END = 496 * MiB;
constexpr int LDS_BYTES = 147456;
constexpr int NWAVES = 8, NTHR = 512;

struct Ptrs {
    const float *x, *norm_w, *w_in, *mu, *w0, *w_up, *a0, *a_up, *k_k, *k_a, *r_k, *ln_w, *ln_b, *w_out, *fin_w;
    float* out; float* part; float* lse;
    bf16 *wtin, *wtout, *wupT, *aupT, *mix, *P, *xb, *o1, *o2, *o3;
};

__device__ __forceinline__ unsigned f2bf(float f) { unsigned u = __builtin_bit_cast(unsigned, f); return (u + 0x7fffu + ((u >> 16) & 1u)) >> 16; }
typedef __bf16 bf16x2_t __attribute__((ext_vector_type(2)));
__device__ __forceinline__ unsigned pk2(float lo, float hi) { const f32x2 v = (f32x2){lo, hi}; const bf16x2_t bq = __builtin_convertvector(v, bf16x2_t); return __builtin_bit_cast(unsigned, bq); }
__device__ __forceinline__ float bflo(unsigned w) { return __builtin_bit_cast(float, w << 16); }
__device__ __forceinline__ float bfhi(unsigned w) { return __builtin_bit_cast(float, w & 0xffff0000u); }
__device__ __forceinline__ float wave_sum(float v) {
#pragma unroll
    for (int o = 1; o < 64; o <<= 1) v += __shfl_xor(v, o);
    return v;
}
__device__ __forceinline__ float silu(float g) { return g * __builtin_amdgcn_rcpf(1.f + __expf(-g)); }

__device__ __forceinline__ void p0_transpose_item(const float* W, int K, int N, bf16* WT, int split, LAS float* scr, int item, int lane) {
    const int nblk = N / 32, kb = item / nblk, nb = item % nblk, k0 = 64 * kb, n0 = 32 * nb;
    const int row_off = (n0 >= split) ? 128 : 0;
#pragma unroll 8
    for (int i = 0; i < 32; ++i) { const int kk = 2 * i + (lane >> 5); scr[kk * 33 + (lane & 31)] = W[(size_t)(k0 + kk) * N + n0 + (lane & 31)]; }
    asm volatile("s_waitcnt lgkmcnt(0)" ::: "memory");
    const int c = lane & 7;
#pragma unroll
    for (int j = 0; j < 4; ++j) { const int n = (lane >> 3) + 8 * j; const LAS float* s = scr + (8 * c) * 33 + n;
        u32x4 o; o.x = pk2(s[0 * 33], s[1 * 33]); o.y = pk2(s[2 * 33], s[3 * 33]); o.z = pk2(s[4 * 33], s[5 * 33]); o.w = pk2(s[6 * 33], s[7 * 33]);
        *(u32x4*)(WT + (size_t)(row_off + n0 + n) * K + k0 + 8 * c) = o; }
    asm volatile("s_waitcnt lgkmcnt(0)" ::: "memory");
}
__device__ __forceinline__ void p0_prologue(LAS unsigned char* lds, const Ptrs& P, int tid, bool zero_mix) {
    const int wave = __builtin_amdgcn_readfirstlane(tid >> 6), lane = tid & 63;
    LAS float* scr = (LAS float*)(lds + wave * 16384);
    const int gw = blockIdx.x * NWAVES + wave, NGW = gridDim.x * NWAVES;
    constexpr int I_IN = (DM / 64) * (N_IN / 32), I_OUT = (MIXW / 64) * (DM / 32), I_UP = DM / 32;
    constexpr int NITEMS = I_IN + I_OUT + 2 * I_UP;
    for (int it = gw; it < NITEMS; it += NGW) {
        int r = it;
        if (r < I_IN) { p0_transpose_item(P.w_in, DM, N_IN, P.wtin, RW_COLS, scr, r, lane); continue; } r -= I_IN;
        if (r < I_OUT) { p0_transpose_item(P.w_out, MIXW, DM, P.wtout, 1 << 30, scr, r, lane); continue; } r -= I_OUT;
        if (r < I_UP) { p0_transpose_item(P.w_up, 64, DM, P.wupT, 1 << 30, scr, r, lane); continue; } r -= I_UP;
        p0_transpose_item(P.a_up, 64, DM, P.aupT, 1 << 30, scr, r, lane);
    }
    { const int gt = blockIdx.x * NTHR + tid, NGT = gridDim.x * NTHR; u32x4* z = (u32x4*)(P.wtin + (size_t)RW_COLS * DM);
      for (int i = gt; i < 128 * DM * 2 / 16; i += NGT) z[i] = (u32x4){0u, 0u, 0u, 0u};
      if (zero_mix) { u32x4* zm = (u32x4*)P.mix; for (size_t i = gt; i < (size_t)MTOK * MIXW * 2 / 16; i += NGT) zm[i] = (u32x4){0u, 0u, 0u, 0u}; } }
    for (int m = gw; m < MTOK; m += NGW) {
        const f32x4* xr = (const f32x4*)(P.x + (size_t)m * DM) + lane; const f32x4* wr = (const f32x4*)P.norm_w + lane;
        f32x4 v[4]; float s = 0.f;
#pragma unroll
        for (int j = 0; j < 4; ++j) { v[j] = xr[64 * j]; s += (v[j].x * v[j].x + v[j].y * v[j].y) + (v[j].z * v[j].z + v[j].w * v[j].w); }
        const float rstd = 1.f / sqrtf(wave_sum(s) * (1.f / DM) + RMS_EPS);
        unsigned long long* o8 = (unsigned long long*)(P.xb + (size_t)m * DM) + lane;
#pragma unroll
        for (int j = 0; j < 4; ++j) { const f32x4 w = wr[64 * j];
            o8[64 * j] = (unsigned long long)pk2(v[j].x * rstd * w.x, v[j].y * rstd * w.y) | ((unsigned long long)pk2(v[j].z * rstd * w.z, v[j].w * rstd * w.w) << 32); }
    }
}

namespace rw {
constexpr int T = 32, NCH = SEQ / T;
constexpr size_t SEC = (size_t)256 * 2048 * 64;
constexpr int O_DEC = 0, O_BV = 8192, O_K = 16384, O_R = 24576, O_AV = 32768, BUF = 40960;
constexpr int L_B = 0, L_V = 2 * BUF, L_Y = L_V + 3 * 8192, L_ST = L_Y + 2 * 8192, WLS = 144, ST_W = 16 * WLS, L_BON = L_ST + 4 * 2 * ST_W, L_END = L_BON + 3 * T * 4;
static_assert(L_END <= LDS_BYTES, "rwkv LDS");
template <int CTRL> __device__ __forceinline__ float dpp_add(float x) {
    const int y = __builtin_amdgcn_update_dpp(0, __builtin_bit_cast(int, x), CTRL, 0xf, 0xf, false);
    return x + __builtin_bit_cast(float, y);
}
__device__ __forceinline__ float allreduce16(float x) {
    x = dpp_add<0xB1>(x);
    x = dpp_add<0x4E>(x);
    x = dpp_add<0x141>(x);
    x = dpp_add<0x140>(x);
    return x;
}
__device__ __forceinline__ float allreduce8(float x) {
    x = dpp_add<0xB1>(x); x = dpp_add<0x4E>(x); x = dpp_add<0x141>(x);
    return x;
}
__device__ __forceinline__ void lerp8(const u32x4 cur, const u32x4 prv, const f32x4 m0, const f32x4 m1, float (&v)[8]) {
#pragma unroll
    for (int i = 0; i < 4; ++i) { const float cl = bflo(cur[i]), ch = bfhi(cur[i]), pl = bflo(prv[i]), ph = bfhi(prv[i]);
        const float ma = (i < 2) ? m0[2 * i] : m1[2 * i - 4], mb = (i < 2) ? m0[2 * i + 1] : m1[2 * i - 3];
        v[2 * i] = cl + (pl - cl) * ma; v[2 * i + 1] = ch + (ph - ch) * mb; }
}
}

__device__ __forceinline__ void rwkv_phase(LAS unsigned char* lds, const Ptrs& P, int tid) {
    using namespace rw;
    const int wv = __builtin_amdgcn_readfirstlane(tid >> 6), lane = tid & 63, fr = lane & 15, fq = lane >> 4;
    const bf16* Pb = P.P;
    const float* mu = P.mu; const float* g_w0 = P.w0; const float* g_a0 = P.a0; const float* g_kk = P.k_k; const float* g_ka = P.k_a; const float* g_rk = P.r_k;
    const float* g_lw = P.ln_w; const float* g_lb = P.ln_b; bf16* mix = P.mix;
    const int pw = wv & 3;
    const int ptt = lane >> 3, c8 = (lane & 7) * 8;
    const int trow = pw * 8 + ptt;
    LAS unsigned char* stw = lds + L_ST + pw * 2 * ST_W; LAS unsigned char* sta = stw + ST_W;
    for (int bh = blockIdx.x; bh < NBATCH * NH; bh += gridDim.x) {
        const int b = bh >> 4, h = bh & 15;
        const bf16* pR = Pb + (size_t)bh * 2048 * 64; const bf16* pK = pR + SEC; const bf16* pV = pR + 2 * SEC; const bf16* pG = pR + 3 * SEC;
        const bf16* pL = Pb + 4 * SEC + (size_t)b * 2048 * 128;
        bf16x8 bw[4][2], ba[4][2];
        if (wv >= 4) {
#pragma unroll
            for (int nt = 0; nt < 4; ++nt)
#pragma unroll
                for (int ks = 0; ks < 2; ++ks) { bw[nt][ks] = *(const bf16x8*)(P.wupT + (size_t)(h * 64 + nt * 16 + fr) * 64 + ks * 32 + fq * 8);
                                                 ba[nt][ks] = *(const bf16x8*)(P.aupT + (size_t)(h * 64 + nt * 16 + fr) * 64 + ks * 32 + fq * 8); }
        }
        f32x2 S2[2][4];
#pragma unroll
        for (int i = 0; i < 2; ++i)
#pragma unroll
            for (int q = 0; q < 4; ++q) S2[i][q] = (f32x2){0.f, 0.f};
        for (int c = -1; c <= NCH; ++c) {
            if (wv < 4) {
                if (c >= 0 && c < NCH) {
                    __builtin_amdgcn_s_setprio(3);
                    const int rg = lane >> 3, kg = lane & 7;
                    const LAS float* bb = (const LAS float*)(lds + L_B + (c & 1) * BUF) + kg * 8;
                    const LAS float* pv = (const LAS float*)(lds + L_V + (c % 3) * 8192) + wv * 16 + rg * 2;
                    LAS float* py = (LAS float*)(lds + L_Y + (c & 1) * 8192) + wv * 16 + rg * 2;
                    const bool hi4 = (kg & 4) != 0; const int yrow = (kg >> 2) & 1;
#define RW_LD8(dst, off, tt) do { dst[0] = *(const LAS f32x4*)(bb + (off) / 4 + (tt) * 64); dst[1] = *(const LAS f32x4*)(bb + (off) / 4 + (tt) * 64 + 4); } while (0)
                    f32x4 n_dec[2], n_bv[2], n_kk[2], n_rr[2], n_av[2]; f32x2 n_vv;
                    RW_LD8(n_dec, O_DEC, 0); RW_LD8(n_bv, O_BV, 0); RW_LD8(n_kk, O_K, 0); RW_LD8(n_rr, O_R, 0); RW_LD8(n_av, O_AV, 0); n_vv = *(const LAS f32x2*)pv;
#pragma unroll 2
                    for (int t = 0; t < T; ++t) {
                        f32x2 de[4], bv[4], kk[4], rr[4], av[4];
#pragma unroll
                        for (int q = 0; q < 2; ++q) {
                            de[2 * q] = (f32x2){n_dec[q][0], n_dec[q][1]}; de[2 * q + 1] = (f32x2){n_dec[q][2], n_dec[q][3]};
                            bv[2 * q] = (f32x2){n_bv[q][0], n_bv[q][1]}; bv[2 * q + 1] = (f32x2){n_bv[q][2], n_bv[q][3]};
                            kk[2 * q] = (f32x2){n_kk[q][0], n_kk[q][1]}; kk[2 * q + 1] = (f32x2){n_kk[q][2], n_kk[q][3]};
                            rr[2 * q] = (f32x2){n_rr[q][0], n_rr[q][1]}; rr[2 * q + 1] = (f32x2){n_rr[q][2], n_rr[q][3]};
                            av[2 * q] = (f32x2){n_av[q][0], n_av[q][1]}; av[2 * q + 1] = (f32x2){n_av[q][2], n_av[q][3]};
                        }
                        const f32x2 vv = n_vv;
                        const int tn = (t + 1 < T) ? t + 1 : t;
                        RW_LD8(n_dec, O_DEC, tn); RW_LD8(n_bv, O_BV, tn); RW_LD8(n_kk, O_K, tn); RW_LD8(n_rr, O_R, tn); RW_LD8(n_av, O_AV, tn); n_vv = *(const LAS f32x2*)(pv + tn * 64);
                        float sa[2];
#pragma unroll
                        for (int i = 0; i < 2; ++i) { const f32x2 q = (S2[i][0] * av[0] + S2[i][1] * av[1]) + (S2[i][2] * av[2] + S2[i][3] * av[3]); sa[i] = q.x + q.y; }
#pragma unroll
                        for (int i = 0; i < 2; ++i) sa[i] = allreduce8(sa[i]);
#pragma unroll
                        for (int i = 0; i < 2; ++i) {
                            const f32x2 s2 = (f32x2){sa[i], sa[i]}, v2 = (f32x2){vv[i], vv[i]};
#pragma unroll
                            for (int q = 0; q < 4; ++q) S2[i][q] = S2[i][q] * de[q] + s2 * bv[q] + v2 * kk[q];
                        }
                        float y[2];
#pragma unroll
                        for (int i = 0; i < 2; ++i) { const f32x2 q = (S2[i][0] * rr[0] + S2[i][1] * rr[1]) + (S2[i][2] * rr[2] + S2[i][3] * rr[3]); y[i] = q.x + q.y; }
                        const float e0 = dpp_add<0x141>(y[0]), e1 = dpp_add<0x141>(y[1]);
                        float w = hi4 ? e1 : e0;
                        w = dpp_add<0xB1>(w); w = dpp_add<0x4E>(w);
                        if ((kg & 3) == 0) py[t * 64 + yrow] = w;
                    }
#undef RW_LD8
                    __builtin_amdgcn_s_setprio(0);
                }
            } else {
                const u32x4 zz = (u32x4){0u, 0u, 0u, 0u};
                u32x4 cR = zz, cK = zz, cV = zz, cW = zz, cA = zz, qR = zz, qK = zz, qV = zz, qW = zz, qA = zz;
                if (c + 1 < NCH) {
                    const int t = (c + 1) * T + trow;
                    const bf16* sR = pR + (size_t)t * 64 + c8; const bf16* sK = pK + (size_t)t * 64 + c8; const bf16* sV = pV + (size_t)t * 64 + c8;
                    const bf16* sW = pL + (size_t)t * 128 + c8; const bf16* sA = sW + 64;
                    cR = *(const u32x4*)sR; cK = *(const u32x4*)sK; cV = *(const u32x4*)sV; cW = *(const u32x4*)sW; cA = *(const u32x4*)sA;
                    if (t > 0) { qR = *(const u32x4*)(sR - 64); qK = *(const u32x4*)(sK - 64); qV = *(const u32x4*)(sV - 64); qW = *(const u32x4*)(sW - 128); qA = *(const u32x4*)(sA - 128); }
                }
                if (c >= 1) {
                    const int cp = c - 1, t = cp * T + trow, o = trow * 64 + c8;
                    const LAS float* aY = (const LAS float*)(lds + L_Y + (cp & 1) * 8192); const LAS float* aV = (const LAS float*)(lds + L_V + (cp % 3) * 8192);
                    const u32x4 g = *(const u32x4*)(pG + (size_t)t * 64 + c8);
                    const f32x4 lw0 = *(const f32x4*)(g_lw + h * 64 + c8), lw1 = *(const f32x4*)(g_lw + h * 64 + c8 + 4);
                    const f32x4 lb0 = *(const f32x4*)(g_lb + h * 64 + c8), lb1 = *(const f32x4*)(g_lb + h * 64 + c8 + 4);
                    const f32x4 y0 = *(const LAS f32x4*)(aY + o), y1 = *(const LAS f32x4*)(aY + o + 4), v0 = *(const LAS f32x4*)(aV + o), v1 = *(const LAS f32x4*)(aV + o + 4);
                    const float bon = ((const LAS float*)(lds + L_BON))[(cp % 3) * T + trow];
                    const float s = allreduce8((y0.x + y0.y) + (y0.z + y0.w) + (y1.x + y1.y) + (y1.z + y1.w));
                    const float mean = s * (1.f / 64.f);
                    const f32x4 d0 = y0 - mean, d1 = y1 - mean;
                    const float q = allreduce8((d0.x * d0.x + d0.y * d0.y) + (d0.z * d0.z + d0.w * d0.w) + (d1.x * d1.x + d1.y * d1.y) + (d1.z * d1.z + d1.w * d1.w));
                    const float rstd = 1.f / sqrtf(q * (1.f / 64.f) + GN_EPS);
                    const f32x4 e0 = d0 * rstd * lw0 + lb0 + bon * v0, e1 = d1 * rstd * lw1 + lb1 + bon * v1;
                    u32x4 ov;
                    ov.x = pk2(e0.x * silu(bflo(g.x)), e0.y * silu(bfhi(g.x))); ov.y = pk2(e0.z * silu(bflo(g.y)), e0.w * silu(bfhi(g.y)));
                    ov.z = pk2(e1.x * silu(bflo(g.z)), e1.y * silu(bfhi(g.z))); ov.w = pk2(e1.z * silu(bflo(g.w)), e1.w * silu(bfhi(g.w)));
                    *(u32x4*)(mix + ((size_t)b * SEQ + t) * MIXW + h * 64 + c8) = ov;
                }
                if (c + 1 < NCH) {
                    const int cn = c + 1, t = cn * T + trow, o = trow * 64 + c8;
                    LAS float* B = (LAS float*)(lds + L_B + (cn & 1) * BUF);
                    LAS float* aV = (LAS float*)(lds + L_V + (cn % 3) * 8192);
                    const int hc = h * 64 + c8;
                    float v[8];
                    lerp8(cR, qR, *(const f32x4*)(mu + hc), *(const f32x4*)(mu + hc + 4), v);
                    *(LAS f32x4*)(B + O_R / 4 + o) = (f32x4){v[0], v[1], v[2], v[3]}; *(LAS f32x4*)(B + O_R / 4 + o + 4) = (f32x4){v[4], v[5], v[6], v[7]};
                    const f32x4 r0 = (f32x4){v[0], v[1], v[2], v[3]}, r1 = (f32x4){v[4], v[5], v[6], v[7]};
                    lerp8(cV, qV, *(const f32x4*)(mu + 2048 + hc), *(const f32x4*)(mu + 2048 + hc + 4), v);
                    *(LAS f32x4*)(aV + o) = (f32x4){v[0], v[1], v[2], v[3]}; *(LAS f32x4*)(aV + o + 4) = (f32x4){v[4], v[5], v[6], v[7]};
                    lerp8(cW, qW, *(const f32x4*)(mu + 3072 + c8), *(const f32x4*)(mu + 3072 + c8 + 4), v);
#pragma unroll
                    for (int i = 0; i < 8; ++i) v[i] = 1.f - 2.f / (1.f + __expf(2.f * v[i]));
                    { u32x4 ow; ow.x = pk2(v[0], v[1]); ow.y = pk2(v[2], v[3]); ow.z = pk2(v[4], v[5]); ow.w = pk2(v[6], v[7]); *(LAS u32x4*)(stw + ptt * WLS + c8 * 2) = ow; }
                    lerp8(cA, qA, *(const f32x4*)(mu + 3136 + c8), *(const f32x4*)(mu + 3136 + c8 + 4), v);
                    { u32x4 ow; ow.x = pk2(v[0], v[1]); ow.y = pk2(v[2], v[3]); ow.z = pk2(v[4], v[5]); ow.w = pk2(v[6], v[7]); *(LAS u32x4*)(sta + ptt * WLS + c8 * 2) = ow; }
                    lerp8(cK, qK, *(const f32x4*)(mu + 1024 + hc), *(const f32x4*)(mu + 1024 + hc + 4), v);
                    const f32x4 k0 = (f32x4){v[0], v[1], v[2], v[3]}, k1 = (f32x4){v[4], v[5], v[6], v[7]};
                    {
                        bf16x8 aw[2], aa[2];
#pragma unroll
                        for (int ks = 0; ks < 2; ++ks) { aw[ks] = *(const LAS bf16x8*)(stw + fr * WLS + (ks * 32 + fq * 8) * 2); aa[ks] = *(const LAS bf16x8*)(sta + fr * WLS + (ks * 32 + fq * 8) * 2); }
#pragma unroll
                        for (int nt = 0; nt < 4; ++nt) {
                            f32x4 accw = (f32x4){0.f, 0.f, 0.f, 0.f}, acca = (f32x4){0.f, 0.f, 0.f, 0.f};
#pragma unroll
                            for (int ks = 0; ks < 2; ++ks) { accw = __builtin_amdgcn_mfma_f32_16x16x32_bf16(aw[ks], bw[nt][ks], accw, 0, 0, 0);
                                                             acca = __builtin_amdgcn_mfma_f32_16x16x32_bf16(aa[ks], ba[nt][ks], acca, 0, 0, 0); }
                            if (fq < 2) {
#pragma unroll
                                for (int j = 0; j < 4; ++j) { const int oo = (pw * 8 + fq * 4 + j) * 64 + nt * 16 + fr; B[O_DEC / 4 + oo] = accw[j]; B[O_BV / 4 + oo] = acca[j]; }
                            }
                        }
                    }
                    {
                        const f32x4 wr0 = *(const LAS f32x4*)(B + O_DEC / 4 + o), wr1 = *(const LAS f32x4*)(B + O_DEC / 4 + o + 4), ar0 = *(const LAS f32x4*)(B + O_BV / 4 + o), ar1 = *(const LAS f32x4*)(B + O_BV / 4 + o + 4);
                        const f32x4 w00 = *(const f32x4*)(g_w0 + hc), w01 = *(const f32x4*)(g_w0 + hc + 4), a00 = *(const f32x4*)(g_a0 + hc), a01 = *(const f32x4*)(g_a0 + hc + 4);
                        const f32x4 kk0 = *(const f32x4*)(g_kk + hc), kk1 = *(const f32x4*)(g_kk + hc + 4), ka0 = *(const f32x4*)(g_ka + hc), ka1 = *(const f32x4*)(g_ka + hc + 4);
                        const f32x4 rk0 = *(const f32x4*)(g_rk + hc), rk1 = *(const f32x4*)(g_rk + hc + 4);
                        f32x4 dec0, dec1, a0v, a1v;
#pragma unroll
                        for (int i = 0; i < 4; ++i) {
                            { const float z = -(w00[i] + wr0[i]); const float sp = fmaxf(z, 0.f) + __logf(1.f + __expf(-fabsf(z))); dec0[i] = __expf(-__expf(-sp - 0.5f)); a0v[i] = 1.f / (1.f + __expf(-(a00[i] + ar0[i]))); }
                            { const float z = -(w01[i] + wr1[i]); const float sp = fmaxf(z, 0.f) + __logf(1.f + __expf(-fabsf(z))); dec1[i] = __expf(-__expf(-sp - 0.5f)); a1v[i] = 1.f / (1.f + __expf(-(a01[i] + ar1[i]))); }
                        }
                        f32x4 n0 = k0 * kk0, n1 = k1 * kk1;
                        const float ss = allreduce8((n0.x * n0.x + n0.y * n0.y) + (n0.z * n0.z + n0.w * n0.w) + (n1.x * n1.x + n1.y * n1.y) + (n1.z * n1.z + n1.w * n1.w));
                        const float inv = 1.f / fmaxf(sqrtf(ss), 1e-12f);
                        n0 = n0 * inv; n1 = n1 * inv;
                        const f32x4 kp0 = k0 * (1.f + (a0v - 1.f) * ka0), kp1 = k1 * (1.f + (a1v - 1.f) * ka1);
                        const f32x4 bq0 = r0 * kp0 * rk0, bq1 = r1 * kp1 * rk1;
                        const float bon = allreduce8((bq0.x + bq0.y) + (bq0.z + bq0.w) + (bq1.x + bq1.y) + (bq1.z + bq1.w));
                        *(LAS f32x4*)(B + O_DEC / 4 + o) = dec0; *(LAS f32x4*)(B + O_DEC / 4 + o + 4) = dec1;
                        *(LAS f32x4*)(B + O_K / 4 + o) = kp0; *(LAS f32x4*)(B + O_K / 4 + o + 4) = kp1;
                        *(LAS f32x4*)(B + O_AV / 4 + o) = -n0; *(LAS f32x4*)(B + O_AV / 4 + o + 4) = -n1;
                        *(LAS f32x4*)(B + O_BV / 4 + o) = n0 * a0v; *(LAS f32x4*)(B + O_BV / 4 + o + 4) = n1 * a1v;
                        if ((lane & 7) == 0) ((LAS float*)(lds + L_BON))[(cn % 3) * T + trow] = bon;
                    }
                }
            }
            __syncthreads();
        }
    }
}

namespace att { constexpr int KST = 144, NSL = 3, VST = NSL * 256 + 16, L_K = 0, L_V = NSL * 128 * KST; static_assert(L_V + 64 * VST <= LDS_BYTES, "att LDS"); constexpr size_t SEC = (size_t)256 * 2048 * 64; }

struct AttCtx { const bf16* pQ; const bf16* pK; const bf16* pV; const bf16* pG; bf16* po1; bf16* po2; float* plse; bf16* mix; int bh, b, h, i0, qi, ks0, kkey0, kpc, vpc, vkp, fr, fq; };
__device__ __forceinline__ void att_load(const AttCtx& X, int g, u32x4& rk0, u32x4& rk1, u32x4& rv0, u32x4& rv1, bf16x8& rq0, bf16x8& rq1) {
    const int p = g >> 4, u = g & 15, sh = 2 * p, r = u >> (4 - sh), n = u & ((16 >> sh) - 1), lb = n * 128;
    rk0 = *(const u32x4*)(X.pK + (size_t)(((lb + X.kkey0) << sh) + r) * 64 + X.kpc * 8); rk1 = *(const u32x4*)(X.pK + (size_t)(((lb + 64 + X.kkey0) << sh) + r) * 64 + X.kpc * 8);
    rv0 = *(const u32x4*)(X.pV + (size_t)(((lb + 2 * X.vkp) << sh) + r) * 64 + X.vpc * 8); rv1 = *(const u32x4*)(X.pV + (size_t)(((lb + 2 * X.vkp + 1) << sh) + r) * 64 + X.vpc * 8);
    const size_t tq = (size_t)(((lb + X.qi) << sh) + r); rq0 = *(const bf16x8*)(X.pQ + tq * 64 + X.fq * 8); rq1 = *(const bf16x8*)(X.pQ + tq * 64 + 32 + X.fq * 8);
}
__device__ __forceinline__ void att_unit(LAS unsigned char* lds, const AttCtx& X, int g, u32x4& rk0, u32x4& rk1, u32x4& rv0, u32x4& rv1, bf16x8& rq0, bf16x8& rq1) {
    using namespace att;
    const float NEG = -__builtin_inff();
    const int fr = X.fr, fq = X.fq, qi = X.qi, ks0 = X.ks0;
    const int p = g >> 4, u = g & 15, sh = 2 * p, r = u >> (4 - sh), n = u & ((16 >> sh) - 1);
    const int scur = g % 3, sprev = (g + 2) % 3;
    *(LAS u32x4*)(lds + L_K + (scur * 128 + X.kkey0) * KST + X.kpc * 16) = rk0;
    *(LAS u32x4*)(lds + L_K + (scur * 128 + 64 + X.kkey0) * KST + X.kpc * 16) = rk1;
#pragma unroll
    for (int m = 0; m < 4; ++m) {
        const unsigned lo = (rv0[m] & 0xffffu) | (rv1[m] << 16), hi = (rv0[m] >> 16) | (rv1[m] & 0xffff0000u);
        *(LAS unsigned*)(lds + L_V + (X.vpc * 8 + 2 * m) * VST + (scur * 128 + 2 * X.vkp) * 2) = lo;
        *(LAS unsigned*)(lds + L_V + (X.vpc * 8 + 2 * m + 1) * VST + (scur * 128 + 2 * X.vkp) * 2) = hi;
    }
    const bf16x8 qf0 = rq0, qf1 = rq1;
    __syncthreads();
    if (g + 2 < 48) att_load(X, g + 2, rk0, rk1, rv0, rv1, rq0, rq1);
    const size_t tokq = (size_t)(((n * 128 + qi) << sh) + r);
    f32x4 st[10];
#pragma unroll
    for (int kt = 0; kt < 10; ++kt) {
        const int kb = ks0 + kt * 16, pos = ((kb >> 7) ? scur : sprev) * 128 + (kb & 127);
        const LAS unsigned char* kp = lds + L_K + (pos + fr) * KST + fq * 16;
        f32x4 acc = (f32x4){0.f, 0.f, 0.f, 0.f};
        acc = __builtin_amdgcn_mfma_f32_16x16x32_bf16(*(const LAS bf16x8*)kp, qf0, acc, 0, 0, 0);
        acc = __builtin_amdgcn_mfma_f32_16x16x32_bf16(*(const LAS bf16x8*)(kp + 64), qf1, acc, 0, 0, 0);
        st[kt] = acc;
    }
    const int lo = (n == 0 && qi < 128) ? 128 : qi;
    const int dl = ks0 + 4 * fq - lo; const unsigned span = (unsigned)(qi + 128 - lo);
    float m = NEG;
#pragma unroll
    for (int kt = 0; kt < 10; ++kt)
#pragma unroll
        for (int j = 0; j < 4; ++j) {
            const bool valid = (unsigned)(dl + kt * 16 + j) <= span;
            const float s = valid ? st[kt][j] : NEG;
            st[kt][j] = s; m = fmaxf(m, s);
        }
    m = fmaxf(m, __shfl_xor(m, 16)); m = fmaxf(m, __shfl_xor(m, 32));
    const float C = 0.125f * 1.4426950408889634f, mc = m * C;
    float ls = 0.f;
#pragma unroll
    for (int kt = 0; kt < 10; ++kt)
#pragma unroll
        for (int j = 0; j < 4; ++j) { const float pe = __builtin_amdgcn_exp2f(st[kt][j] * C - mc); st[kt][j] = pe; ls += pe; }
    ls += __shfl_xor(ls, 16); ls += __shfl_xor(ls, 32);
    f32x4 oacc[4];
#pragma unroll
    for (int dt = 0; dt < 4; ++dt) oacc[dt] = (f32x4){0.f, 0.f, 0.f, 0.f};
#pragma unroll
    for (int s5 = 0; s5 < 5; ++s5) {
        u32x4 pw; pw.x = pk2(st[2 * s5][0], st[2 * s5][1]); pw.y = pk2(st[2 * s5][2], st[2 * s5][3]);
        pw.z = pk2(st[2 * s5 + 1][0], st[2 * s5 + 1][1]); pw.w = pk2(st[2 * s5 + 1][2], st[2 * s5 + 1][3]);
        const bf16x8 pb = __builtin_bit_cast(bf16x8, pw);
        const int kb0 = ks0 + 32 * s5, kb1 = kb0 + 16;
        const int pos0 = ((kb0 >> 7) ? scur : sprev) * 128 + (kb0 & 127) + 4 * fq, pos1 = ((kb1 >> 7) ? scur : sprev) * 128 + (kb1 & 127) + 4 * fq;
#pragma unroll
        for (int dt = 0; dt < 4; ++dt) {
            const LAS unsigned char* vp = lds + L_V + (dt * 16 + fr) * VST;
            const u32x2 lo2 = *(const LAS u32x2*)(vp + pos0 * 2), hi2 = *(const LAS u32x2*)(vp + pos1 * 2);
            const u32x4 aw = (u32x4){lo2.x, lo2.y, hi2.x, hi2.y};
            oacc[dt] = __builtin_amdgcn_mfma_f32_16x16x32_bf16(__builtin_bit_cast(bf16x8, aw), pb, oacc[dt], 0, 0, 0);
        }
    }
    const float inv = __builtin_amdgcn_rcpf(ls);
    const size_t row = (size_t)X.bh * 2048 + tokq;
    if (p < 2) {
        bf16* OP = ((p == 0) ? X.po1 : X.po2) + row * 64 + 4 * fq;
#pragma unroll
        for (int dt = 0; dt < 4; ++dt) {
            u32x2 ow; ow.x = pk2(oacc[dt][0] * inv, oacc[dt][1] * inv); ow.y = pk2(oacc[dt][2] * inv, oacc[dt][3] * inv);
            *(u32x2*)(OP + dt * 16) = ow;
        }
        if (fq == 0) X.plse[(size_t)p * MTOK * 16 + row] = m * 0.125f + __logf(ls);
    } else {
        const float l1 = X.plse[row], l2 = X.plse[(size_t)MTOK * 16 + row], l3 = m * 0.125f + __logf(ls);
        const float mx = fmaxf(l1, fmaxf(l2, l3));
        float e1 = __expf(l1 - mx), e2 = __expf(l2 - mx), e3 = __expf(l3 - mx);
        const float winv = __builtin_amdgcn_rcpf(e1 + e2 + e3); e1 *= winv; e2 *= winv; e3 *= winv * inv;
        bf16* mrow = X.mix + ((size_t)X.b * SEQ + tokq) * MIXW + 1024 + X.h * 64 + 4 * fq;
#pragma unroll
        for (int dt = 0; dt < 4; ++dt) {
            const u32x2 a1 = *(const u32x2*)(X.po1 + row * 64 + dt * 16 + 4 * fq), a2 = *(const u32x2*)(X.po2 + row * 64 + dt * 16 + 4 * fq);
            const u32x2 gt = *(const u32x2*)(X.pG + tokq * 64 + dt * 16 + 4 * fq);
            u32x2 ow;
            ow.x = pk2((e1 * bflo(a1.x) + e2 * bflo(a2.x) + e3 * oacc[dt][0]) * silu(bflo(gt.x)), (e1 * bfhi(a1.x) + e2 * bfhi(a2.x) + e3 * oacc[dt][1]) * silu(bfhi(gt.x)));
            ow.y = pk2((e1 * bflo(a1.y) + e2 * bflo(a2.y) + e3 * oacc[dt][2]) * silu(bflo(gt.y)), (e1 * bfhi(a1.y) + e2 * bfhi(a2.y) + e3 * oacc[dt][3]) * silu(bfhi(gt.y)));
            *(u32x2*)(mrow + dt * 16) = ow;
        }
    }
}

__device__ __forceinline__ void attn_phase(LAS unsigned char* lds, const Ptrs& P, int tid) {
    using namespace att;
    const int wv = __builtin_amdgcn_readfirstlane(tid >> 6), lane = tid & 63;
    for (int i = tid; i < 64 * VST / 16; i += NTHR) *(LAS u32x4*)(lds + L_V + i * 16) = (u32x4){0u, 0u, 0u, 0u};
    __syncthreads();
    AttCtx X;
    X.po1 = P.o1; X.po2 = P.o2; X.plse = P.lse; X.mix = P.mix;
    X.fr = lane & 15; X.fq = lane >> 4; X.i0 = wv * 16; X.qi = wv * 16 + X.fr; X.ks0 = wv * 16 < 96 ? wv * 16 : 96;
    X.kkey0 = tid >> 3; X.kpc = tid & 7; X.vpc = tid >> 6; X.vkp = tid & 63;
    for (int bh = blockIdx.x; bh < NBATCH * NH; bh += gridDim.x) {
        X.bh = bh; X.b = bh >> 4; X.h = bh & 15;
        X.pQ = P.P + (size_t)bh * 2048 * 64; X.pK = X.pQ + SEC; X.pV = X.pQ + 2 * SEC; X.pG = X.pQ + 3 * SEC;
        u32x4 ak0, ak1, av0, av1, bk0, bk1, bv0, bv1; bf16x8 aq0, aq1, bq0, bq1;
        att_load(X, 0, ak0, ak1, av0, av1, aq0, aq1);
        att_load(X, 1, bk0, bk1, bv0, bv1, bq0, bq1);
        for (int g = 0; g < 48; g += 2) {
            att_unit(lds, X, g, ak0, ak1, av0, av1, aq0, aq1);
            att_unit(lds, X, g + 1, bk0, bk1, bv0, bv1, bq0, bq1);
        }
        __syncthreads();
    }
}

__device__ __forceinline__ void final_norm(const Ptrs& P, int tid) {
    const int wave = tid >> 6, lane = tid & 63;
    const int gw = blockIdx.x * NWAVES + wave, NGW = gridDim.x * NWAVES;
    for (int m = gw; m < MTOK; m += NGW) {
        float ps = (lane < 16) ? P.part[(size_t)m * 16 + lane] : 0.f;
        ps += __shfl_xor(ps, 1); ps += __shfl_xor(ps, 2); ps += __shfl_xor(ps, 4); ps += __shfl_xor(ps, 8);
        const float ss = __shfl(ps, 0);
        const float rstd = 1.f / sqrtf(ss * (1.f / DM) + RMS_EPS);
        f32x4* o = (f32x4*)(P.out + (size_t)m * DM) + lane; const f32x4* w = (const f32x4*)P.fin_w + lane;
#pragma unroll
        for (int j = 0; j < 4; ++j) { const f32x4 v = o[64 * j]; o[64 * j] = v * rstd * w[64 * j]; }
    }
}

#define XB_TMO      128
#define XB_XCNT(j)  (256  + 64 * (j))
#define XB_XSUB(j)  (1280 + 64 * (j))
#define XB_XGEN(j)  (2304 + 64 * (j))
#define XB_TOP      3328
#define XB_TOPGEN   3392
#define XCD_BAR_WORDS 3456
#define XB_SPIN_CAP (1u << 18)

__device__ __forceinline__ unsigned xb_ld(unsigned* p)              { return __hip_atomic_load(p, __ATOMIC_RELAXED, __HIP_MEMORY_SCOPE_AGENT); }
__device__ __forceinline__ unsigned xb_add(unsigned* p, unsigned v) { return __hip_atomic_fetch_add(p, v, __ATOMIC_RELAXED, __HIP_MEMORY_SCOPE_AGENT); }
__device__ __forceinline__ unsigned xb_xcc_id() { return (unsigned)__builtin_amdgcn_s_getreg((3 << 11) | 20) & 0xFu; }
#define XB_SPIN(cond, bar) do { unsigned _sp = 0; while (cond) { __builtin_amdgcn_s_sleep(1); \
    if ((++_sp & 255u) == 0u) { if (xb_ld(&(bar)[XB_TMO])) break; if (_sp > XB_SPIN_CAP) { atomicAdd(&(bar)[XB_TMO], 1u); break; } } } } while (0)

struct XcdBarrier {
    unsigned* bar; unsigned x;
    volatile LAS unsigned* st;
};

__device__ __forceinline__ XcdBarrier xcd_barrier_post(unsigned* bar, volatile LAS unsigned* st) {
    XcdBarrier b; b.bar = bar; b.x = xb_xcc_id(); b.st = st;
    if (threadIdx.x == 0) (void)xb_add(&bar[XB_XCNT(b.x)], 1u);
    return b;
}
__device__ __forceinline__ void xcd_barrier_complete(unsigned* bar, unsigned x, unsigned& nloc, unsigned& nx) {
    const unsigned G = gridDim.x * gridDim.y * gridDim.z;
    unsigned sum, cnt, mine, sp = 0u;
    for (;;) {
        sum = 0u; cnt = 0u; mine = 0u;
#pragma unroll
        for (unsigned j = 0; j < 16; ++j) { const unsigned c = xb_ld(&bar[XB_XCNT(j)]); sum += c; cnt += (c > 0u) ? 1u : 0u; mine = (j == x) ? c : mine; }
        if (sum == G) break;
        __builtin_amdgcn_s_sleep(1);
        if ((++sp & 255u) == 0u) { if (xb_ld(&bar[XB_TMO])) break; if (sp > XB_SPIN_CAP) { atomicAdd(&bar[XB_TMO], 1u); break; } }
    }
    nloc = mine > 0u ? mine : 1u; nx = cnt > 0u ? cnt : 1u;
}

__device__ __forceinline__ void xcd_barrier(const XcdBarrier& b) {
    asm volatile("s_waitcnt vmcnt(0)" ::: "memory");
    __syncthreads();
    if (threadIdx.x == 0) {
        unsigned* bar = b.bar;
        __builtin_amdgcn_s_waitcnt(0);
        unsigned nloc = b.st[0], nx = b.st[1];
        if (nloc == 0u) { xcd_barrier_complete(bar, b.x, nloc, nx); b.st[0] = nloc; b.st[1] = nx; }
        const unsigned old = xb_add(&bar[XB_XSUB(b.x)], 1u);
        const unsigned gen = old / nloc;
        if (old + 1u == (gen + 1u) * nloc) {
            __builtin_amdgcn_fence(__ATOMIC_RELEASE, "agent");
            asm volatile("s_waitcnt vmcnt(0)" ::: "memory");
            const unsigned og = xb_add(&bar[XB_TOP], 1u);
            const unsigned tg = og / nx;
            if (og + 1u == (tg + 1u) * nx) xb_add(&bar[XB_TOPGEN], 1u);
            else XB_SPIN(xb_ld(&bar[XB_TOPGEN]) == tg, bar);
            __builtin_amdgcn_fence(__ATOMIC_ACQUIRE, "agent");
            xb_add(&bar[XB_XGEN(b.x)], 1u);
            asm volatile("s_waitcnt vmcnt(0)" ::: "memory");
        } else {
            XB_SPIN(xb_ld(&bar[XB_XGEN(b.x)]) == gen, bar);
            __builtin_amdgcn_fence(__ATOMIC_ACQUIRE, "agent");
            asm volatile("s_waitcnt vmcnt(0)" ::: "memory");
        }
    }
    __syncthreads();
}

struct Args { const float* in[15]; float* out; unsigned char* ws; int mask; int sync; };
#ifndef MK_MULTI
#define MK_MULTI 0
#endif
#ifndef MK_REP
#define MK_REP 0
#endif
#ifndef MK_MASK
#define MK_MASK 0x7f
#endif
__global__ void __launch_bounds__(NTHR, 2) fwd_kernel(Args a) {
    extern __shared__ __attribute__((aligned(16))) unsigned char lds_[];
    LAS unsigned char* lds = (LAS unsigned char*)lds_;
    cg::grid_group grid = cg::this_grid();
    const int tid = threadIdx.x;
    Ptrs P;
    P.x = a.in[0]; P.norm_w = a.in[1]; P.w_in = a.in[2]; P.mu = a.in[3]; P.w0 = a.in[4]; P.w_up = a.in[5]; P.a0 = a.in[6]; P.a_up = a.in[7];
    P.k_k = a.in[8]; P.k_a = a.in[9]; P.r_k = a.in[10]; P.ln_w = a.in[11]; P.ln_b = a.in[12]; P.w_out = a.in[13]; P.fin_w = a.in[14];
    P.out = a.out; unsigned char* ws = a.ws;
    P.part = (float*)(ws + WS_PART); P.lse = (float*)(ws + WS_LSE);
    P.wtin = (bf16*)(ws + WS_WTIN); P.wtout = (bf16*)(ws + WS_WTOUT); P.wupT = (bf16*)(ws + WS_WUPT); P.aupT = (bf16*)(ws + WS_AUPT);
    P.mix = (bf16*)(ws + WS_MIX); P.P = (bf16*)(ws + WS_P); P.xb = (bf16*)(ws + WS_XB);
    P.o1 = (bf16*)a.out; P.o2 = (bf16*)a.out + (size_t)MTOK * DM; P.o3 = (bf16*)(ws + WS_XB);
    const int mask = a.mask;
    volatile LAS unsigned* xst = (volatile LAS unsigned*)(lds + LDS_BYTES - 64);
    if (tid < 16) xst[tid] = 0u;
    __syncthreads();
    XcdBarrier xbar; xbar.bar = (unsigned*)(ws + WS_CTL) + 4096; xbar.x = 0; xbar.st = xst;
    if (a.sync) xbar = xcd_barrier_post((unsigned*)(ws + WS_CTL) + 4096, xst);
#define SEAM() do { if (a.sync) xcd_barrier(xbar); } while (0)
#define SEAM_CG() do { if (a.sync == 2) grid.sync(); else if (a.sync) xcd_barrier(xbar); } while (0)
    if (mask & 1) p0_prologue(lds, P, tid, (mask & 0x80) != 0);
    SEAM_CG();
    if (mask & 2) {
        pg8::Gemm g{P.xb, P.wtin, MTOK, PA, DM}; pg8::StaticOrder S; S.init(MTOK, PA, gridDim.x, (int)blockIdx.x);
        pg8::EpiHM<1> E{P.P};
        pg8::gemm_phase<pg8::EpiHM<1>, pg8::StaticOrder, true, true>(lds, g, S, E);
    }
    SEAM();
    if (mask & 4) for (int rep = 0; rep < ((MK_REP & 4) ? 2 : 1); ++rep) rwkv_phase(lds, P, tid);
    SEAM();
    if (mask & 8) {
        pg8::Gemm g{P.xb, P.wtin + (size_t)PA * DM, MTOK, PB, DM}; pg8::StaticOrder S; S.init(MTOK, PB, gridDim.x, (int)blockIdx.x);
        pg8::EpiHM<0> E{P.P};
        pg8::gemm_phase<pg8::EpiHM<0>, pg8::StaticOrder, true, true>(lds, g, S, E);
    }
    SEAM();
    if (mask & 16) for (int rep = 0; rep < ((MK_REP & 16) ? 2 : 1); ++rep) attn_phase(lds, P, tid);
    SEAM();
    if (mask & 32) {
        pg8::Gemm g{P.mix, P.wtout, MTOK, DM, MIXW}; pg8::StaticOrder S; S.init(MTOK, DM, gridDim.x, (int)blockIdx.x);
        pg8::EpiResF32 E{P.x, P.out, P.part, DM};
        pg8::gemm_phase<pg8::EpiResF32, pg8::StaticOrder, true, true>(lds, g, S, E);
    }
    SEAM();
    if (mask & 64) final_norm(P, tid);
}

extern "C" void kernel_launch(void* const* d_in, const int* in_sizes, int n_in, void* d_out, int out_size, void* d_ws, size_t ws_size, hipStream_t stream) {
    static int grid = 0;
    if (grid == 0) {
        if (n_in != 15 || in_sizes[0] != MTOK * DM || out_size != MTOK * DM || ws_size < WS_END) {
            fprintf(stderr, "kernel_launch: unexpected shapes / workspace (n_in %d, ws %zu, need %zu); nothing launched\n", n_in, ws_size, (size_t)WS_END); grid = -1; return; }
        int dev = 0, cus = 0, per_cu = 0;
        if (hipGetDevice(&dev) != hipSuccess || hipDeviceGetAttribute(&cus, hipDeviceAttributeMultiprocessorCount, dev) != hipSuccess) { grid = -1; return; }
        if (hipFuncSetAttribute((const void*)fwd_kernel, hipFuncAttributeMaxDynamicSharedMemorySize, LDS_BYTES) != hipSuccess) { fprintf(stderr, "kernel_launch: hipFuncSetAttribute failed\n"); grid = -1; return; }
        if (hipOccupancyMaxActiveBlocksPerMultiprocessor(&per_cu, (const void*)fwd_kernel, NTHR, LDS_BYTES) != hipSuccess || per_cu < 1) { fprintf(stderr, "kernel_launch: occupancy query says %d blocks per CU\n", per_cu); grid = -1; return; }
        grid = cus;
    }
    if (grid < 0) return;
    if (hipMemsetAsync((char*)d_ws + WS_CTL, 0, 64 * 1024, stream) != hipSuccess) { fprintf(stderr, "kernel_launch: hipMemsetAsync failed\n"); return; }
    Args a{};
    for (int i = 0; i < 15; ++i) a.in[i] = (const float*)d_in[i];
    a.out = (float*)d_out; a.ws = (unsigned char*)d_ws;
#if MK_MULTI
    for (int ph = 0; ph < 7; ++ph) {
        a.mask = (1 << ph) & (MK_MASK); if (ph == 0) a.mask |= (MK_MASK & 0x80); a.sync = 0;
        if (!(a.mask & 0x7f)) continue;
        hipLaunchKernelGGL(fwd_kernel, dim3(grid), dim3(NTHR), LDS_BYTES, stream, a);
    }
#else
    a.mask = MK_MASK; a.sync = 1;
    void* args[] = {&a};
    hipError_t e = hipLaunchCooperativeKernel((void*)fwd_kernel, dim3(grid), dim3(NTHR), args, LDS_BYTES, stream);
    if (e != hipSuccess) fprintf(stderr, "cooperative launch failed: %s (grid %d)\n", hipGetErrorString(e), grid);
#endif
}
```
